# Optimizing an MI355X kernel written in HIP

```python
import jax, jax.numpy as jnp
from jax import lax
import numpy as np

D_MODEL = 1024
BATCH = 8
SEQ = 4096
DEPTH = 2

GRID_W = 64
N_GROUPS = 4
GROUP_W = D_MODEL // N_GROUPS
NA_HEADS = 4
NA_HEAD_DIM = GROUP_W // NA_HEADS
WIN_H = 8
WIN_W = 16
RWKV_HEADS = 4
RWKV_HEAD_DIM = GROUP_W // RWKV_HEADS
DECAY_LORA = 32
AAA_LORA = 32
GATE_LORA = 64
LN_X_EPS = 64e-5
POOL_GROUPS = 4
POOL_CH = GROUP_W // POOL_GROUPS
POOL_WINDOWS = (2, 4, 8, 16)
CONV_K = 3
FFN_DIM = 7 * D_MODEL // 2
N_EXPERTS = 8
TOP_K = 2
EXPERT_FFN = 7 * D_MODEL // 2
MOE_BLOCK = 256
N_DENSE = (DEPTH + 1) // 2
N_MOE = DEPTH // 2
RMS_EPS = 1e-6
RW_SHIFT_W = 3 * GROUP_W + DECAY_LORA + AAA_LORA
IN_W = 3 * GROUP_W + RW_SHIFT_W + GATE_LORA + GROUP_W + 3 * GROUP_W

kernel_name = 'hybrid_parallel_groups_encoder'


def rms_norm(x, g):
    xf = x.astype(jnp.float32)
    y = xf * lax.rsqrt(jnp.mean(xf * xf, axis=-1, keepdims=True) + RMS_EPS)
    return (y * g.astype(jnp.float32)).astype(x.dtype)


def neighbourhood_attention(q, k, v, rpb):
    bsz, t, _ = q.shape
    rows = t // GRID_W
    kh = min(WIN_H, rows)

    def to_grid(u):
        return u.reshape(bsz, rows, GRID_W, NA_HEADS, NA_HEAD_DIM).transpose(1, 0, 3, 2, 4)

    qg = to_grid(q) * (NA_HEAD_DIM ** -0.5)
    kg = to_grid(k)
    vg = to_grid(v)
    col = jnp.arange(GRID_W)
    col_start = jnp.clip(col - WIN_W // 2, 0, GRID_W - WIN_W)
    col_idx = col_start[:, None] + jnp.arange(WIN_W)[None, :]
    col_rel = col_idx - col[:, None] + (WIN_W - 1)
    row = jnp.arange(rows)
    row_start = jnp.clip(row - kh // 2, 0, rows - kh)

    def one_row(args):
        r, rs, q_r = args
        k_nb = lax.dynamic_slice_in_dim(kg, rs, kh, axis=0)[:, :, :, col_idx]
        v_nb = lax.dynamic_slice_in_dim(vg, rs, kh, axis=0)[:, :, :, col_idx]
        s = jnp.einsum('bhqd,ibhqjd->bhqij', q_r, k_nb).astype(jnp.float32)
        row_rel = rs + jnp.arange(kh) - r + (WIN_H - 1)
        bias = rpb[:, row_rel][:, :, col_rel]
        s = s + jnp.transpose(bias, (0, 2, 1, 3)).astype(jnp.float32)[None]
        p = jax.nn.softmax(s.reshape(bsz, NA_HEADS, GRID_W, kh * WIN_W), axis=-1)
        p = p.reshape(bsz, NA_HEADS, GRID_W, kh, WIN_W).astype(v.dtype)
        return jnp.einsum('bhqij,ibhqjd->bhqd', p, v_nb)

    out = lax.map(one_row, (row, row_start, qg))
    return out.transpose(1, 0, 3, 2, 4).reshape(bsz, t, NA_HEADS * NA_HEAD_DIM)


def rwkv7_step(S, inp):
    r, w, k, v, a_vec, b_vec = inp
    sa = jnp.einsum('...ij,...j->...i', S, a_vec)
    S = S * w[..., None, :] + sa[..., :, None] * b_vec[..., None, :] + v[..., :, None] * k[..., None, :]
    return S, jnp.einsum('...ij,...j->...i', S, r)


def rwkv7_bidirectional(zr, lg, mu, w0, w2, a0, a2, k_k, k_a, r_k, lnx_w, lnx_b, g2):
    bsz, t, _ = zr.shape
    G, H, N = GROUP_W, RWKV_HEADS, RWKV_HEAD_DIM
    z_prev = jnp.pad(zr, ((0, 0), (1, 0), (0, 0)))[:, :-1]
    z_next = jnp.pad(zr, ((0, 0), (0, 1), (0, 0)))[:, 1:]
    zd = zr[None] + mu[:, None, None, :] * (jnp.stack([z_prev, z_next]) - zr[None])
    r = zd[..., :G]
    k = zd[..., G:2 * G]
    v = zd[..., 2 * G:3 * G]
    lw = zd[..., 3 * G:3 * G + DECAY_LORA]
    la = zd[..., 3 * G + DECAY_LORA:]
    w = -jax.nn.softplus(-(w0[:, None, None, :] + jnp.einsum('ebtl,elc->ebtc', jnp.tanh(lw), w2))) - 0.5
    decay = jnp.exp(-jnp.exp(w.astype(jnp.float32)))
    a = jax.nn.sigmoid(a0[:, None, None, :] + jnp.einsum('ebtl,elc->ebtc', la, a2))

    def heads(u):
        return u.astype(jnp.float32).reshape(2, bsz, t, H, N)

    r, k, v, decay, a = heads(r), heads(k), heads(v), heads(decay), heads(a)
    kk = k * k_k.astype(jnp.float32).reshape(H, N)
    kk = kk * lax.rsqrt(jnp.maximum(jnp.sum(kk * kk, axis=-1, keepdims=True), 1e-12))
    k = k * (1.0 + (a - 1.0) * k_a.astype(jnp.float32).reshape(H, N))

    def to_time(u):
        return jnp.moveaxis(jnp.stack([u[0], jnp.flip(u[1], axis=1)]), 2, 0)

    xs = (to_time(r), to_time(decay), to_time(k), to_time(v), to_time(-kk), to_time(kk * a))
    S0 = jnp.zeros((2, bsz, H, N, N), jnp.float32)
    _, ys = lax.scan(rwkv7_step, S0, xs)
    ys = jnp.moveaxis(ys, 0, 2)
    y = ys[0] + jnp.flip(ys[1], axis=1)
    mean = jnp.mean(y, axis=-1, keepdims=True)
    var = jnp.mean(jnp.square(y - mean), axis=-1, keepdims=True)
    y = (y - mean) * lax.rsqrt(var + LN_X_EPS) * lnx_w.astype(jnp.float32).reshape(H, N) \
        + lnx_b.astype(jnp.float32).reshape(H, N)
    r0 = zr[..., :G].astype(jnp.float32).reshape(bsz, t, H, N)
    k0 = zr[..., G:2 * G].astype(jnp.float32).reshape(bsz, t, H, N)
    v0 = zr[..., 2 * G:3 * G].astype(jnp.float32).reshape(bsz, t, H, N)
    y = y + jnp.sum(r0 * k0 * r_k.astype(jnp.float32), axis=-1, keepdims=True) * v0
    g = (jax.nn.sigmoid(lg) @ g2).astype(jnp.float32)
    return (y.reshape(bsz, t, G) * g).astype(zr.dtype)


def multiscale_pool(u, pool_w, pool_scale):
    bsz, t, _ = u.shape
    ug = u.reshape(bsz, t, POOL_GROUPS, POOL_CH).astype(jnp.float32)
    cs = jnp.pad(jnp.cumsum(ug, axis=1), ((0, 0), (1, 0), (0, 0), (0, 0)))
    pos = jnp.arange(t)[:, None]
    win = jnp.array(POOL_WINDOWS, jnp.int32)[None, :]
    lo = jnp.clip(pos - win // 2, 0, t)
    hi = jnp.clip(pos - win // 2 + win, 0, t)
    grp = jnp.arange(POOL_GROUPS)[None, :]
    mean = (cs[:, hi, grp] - cs[:, lo, grp]) / (hi - lo).astype(jnp.float32)[None, :, :, None]
    d = (mean - ug).astype(u.dtype)
    y = jnp.einsum('btgc,gcd->btgd', d, pool_w) * pool_scale.reshape(POOL_GROUPS, POOL_CH)
    return y.reshape(bsz, t, POOL_GROUPS * POOL_CH)


def short_gated_conv(zc, conv_w):
    b_gate = zc[..., :GROUP_W]
    c_gate = zc[..., GROUP_W:2 * GROUP_W]
    hin = zc[..., 2 * GROUP_W:]
    u = lax.conv_general_dilated(c_gate * hin, conv_w[:, None, :].astype(zc.dtype), window_strides=(1,),
                                 padding=((CONV_K // 2, CONV_K // 2),),
                                 dimension_numbers=('NWC', 'WIO', 'NWC'), feature_group_count=GROUP_W)
    return b_gate * u


def hybrid_mixer(h, w_in, w_out, rpb, mu, w0, w2, a0, a2, k_k, k_a, r_k, lnx_w, lnx_b, g2,
                 pool_w, pool_scale, conv_w):
    G = GROUP_W
    z = h @ w_in
    o = 0
    za = z[..., o:o + 3 * G]; o += 3 * G
    zr = z[..., o:o + RW_SHIFT_W]; o += RW_SHIFT_W
    lg = z[..., o:o + GATE_LORA]; o += GATE_LORA
    zp = z[..., o:o + G]; o += G
    zc = z[..., o:]
    y_a = neighbourhood_attention(za[..., :G], za[..., G:2 * G], za[..., 2 * G:], rpb)
    y_b = rwkv7_bidirectional(zr, lg, mu, w0, w2, a0, a2, k_k, k_a, r_k, lnx_w, lnx_b, g2)
    y_c = multiscale_pool(zp, pool_w, pool_scale)
    y_d = short_gated_conv(zc, conv_w)
    return jnp.concatenate([y_a, y_b, y_c, y_d], axis=-1) @ w_out


def swiglu(h, w1, w3, w2):
    return (jax.nn.silu(h @ w1) * (h @ w3)) @ w2


def moe_swiglu(h, router_w, w1, w3, w2):
    bsz, t, d = h.shape
    n = bsz * t
    xf = h.reshape(n, d)
    logits = (xf @ router_w).astype(jnp.float32)
    top_val, top_idx = lax.top_k(logits, TOP_K)
    gates = jax.nn.softmax(top_val, axis=-1)
    m = n * TOP_K
    flat_e = top_idx.reshape(m)
    flat_tok = jnp.arange(m, dtype=jnp.int32) // TOP_K
    flat_g = gates.reshape(m)
    order = jnp.argsort(flat_e)
    se = flat_e[order]
    counts = jnp.bincount(flat_e, length=N_EXPERTS)
    group_start = jnp.cumsum(counts) - counts
    padded = (counts + MOE_BLOCK - 1) // MOE_BLOCK * MOE_BLOCK
    padded_end = jnp.cumsum(padded)
    padded_start = padded_end - padded
    dest = padded_start[se] + (jnp.arange(m) - group_start[se])
    n_blocks = (m + N_EXPERTS * MOE_BLOCK + MOE_BLOCK - 1) // MOE_BLOCK
    p_rows = n_blocks * MOE_BLOCK
    buf_tok = jnp.zeros((p_rows,), jnp.int32).at[dest].set(flat_tok[order])
    buf_g = jnp.zeros((p_rows,), jnp.float32).at[dest].set(flat_g[order])
    block_e = jnp.minimum(jnp.searchsorted(padded_end, jnp.arange(n_blocks) * MOE_BLOCK, side='right'),
                          N_EXPERTS - 1)
    xb = xf[buf_tok].reshape(n_blocks, MOE_BLOCK, d)

    def expert_block(args):
        xblk, e = args
        return (jax.nn.silu(xblk @ w1[e]) * (xblk @ w3[e])) @ w2[e]

    yb = lax.map(expert_block, (xb, block_e)).reshape(p_rows, d)
    out = jnp.zeros((n, d), h.dtype).at[buf_tok].add(yb * buf_g[:, None].astype(yb.dtype))
    return out.reshape(bsz, t, d)


def setup_inputs(seed: int = 0) -> dict:
    key = jax.random.key(seed)
    keys = iter(jax.random.split(key, 32))

    def nrm(shape, std):
        return std * jax.random.normal(next(keys), shape, jnp.float32)

    def unif(shape, lo, hi):
        return jax.random.uniform(next(keys), shape, jnp.float32, lo, hi)

    G, L = GROUP_W, DEPTH
    return {
        'x': nrm((BATCH, SEQ, D_MODEL), 1.0),
        'c': nrm((BATCH, D_MODEL), 1.0),
        'ada_w': nrm((L, D_MODEL, 6 * D_MODEL), 0.5 * D_MODEL ** -0.5),
        'ada_b': nrm((L, 6 * D_MODEL), 0.02),
        'norm_g': 1.0 + nrm((L, 4, D_MODEL), 0.05),
        'w_in': nrm((L, D_MODEL, IN_W), D_MODEL ** -0.5),
        'w_out': nrm((L, N_GROUPS * G, D_MODEL), (N_GROUPS * G) ** -0.5),
        'na_rpb': nrm((L, NA_HEADS, 2 * WIN_H - 1, 2 * WIN_W - 1), 0.05),
        'rw_mu': unif((L, 2, RW_SHIFT_W), 0.0, 1.0),
        'rw_w0': unif((L, 2, G), -6.0, -1.0),
        'rw_w2': nrm((L, 2, DECAY_LORA, G), 0.5 * DECAY_LORA ** -0.5),
        'rw_a0': nrm((L, 2, G), 0.1),
        'rw_a2': nrm((L, 2, AAA_LORA, G), 0.5 * AAA_LORA ** -0.5),
        'rw_k_k': 0.85 + nrm((L, G), 0.05),
        'rw_k_a': 1.0 + nrm((L, G), 0.05),
        'rw_r_k': nrm((L, RWKV_HEADS, RWKV_HEAD_DIM), 0.1),
        'rw_lnx_w': 1.0 + nrm((L, G), 0.05),
        'rw_lnx_b': nrm((L, G), 0.02),
        'rw_g2': nrm((L, GATE_LORA, G), GATE_LORA ** -0.5),
        'pool_w': nrm((L, POOL_GROUPS, POOL_CH, POOL_CH), POOL_CH ** -0.5),
        'pool_scale': 1.0 + nrm((L, G), 0.1),
        'conv_w': nrm((L, CONV_K, G), CONV_K ** -0.5),
        'ffn_w1': nrm((N_DENSE, D_MODEL, FFN_DIM), D_MODEL ** -0.5),
        'ffn_w3': nrm((N_DENSE, D_MODEL, FFN_DIM), D_MODEL ** -0.5),
        'ffn_w2': nrm((N_DENSE, FFN_DIM, D_MODEL), FFN_DIM ** -0.5),
        'router_w': nrm((N_MOE, D_MODEL, N_EXPERTS), D_MODEL ** -0.5),
        'moe_w1': nrm((N_MOE, N_EXPERTS, D_MODEL, EXPERT_FFN), D_MODEL ** -0.5),
        'moe_w3': nrm((N_MOE, N_EXPERTS, D_MODEL, EXPERT_FFN), D_MODEL ** -0.5),
        'moe_w2': nrm((N_MOE, N_EXPERTS, EXPERT_FFN, D_MODEL), EXPERT_FFN ** -0.5),
    }


def reference(x, c, ada_w, ada_b, norm_g, w_in, w_out, na_rpb, rw_mu, rw_w0, rw_w2, rw_a0, rw_a2,
              rw_k_k, rw_k_a, rw_r_k, rw_lnx_w, rw_lnx_b, rw_g2, pool_w, pool_scale, conv_w,
              ffn_w1, ffn_w3, ffn_w2, router_w, moe_w1, moe_w3, moe_w2):
    for l in range(DEPTH):
        mod = jax.nn.silu(c) @ ada_w[l] + ada_b[l]
        sh_m, sc_m, gt_m, sh_f, sc_f, gt_f = jnp.split(mod[:, None, :], 6, axis=-1)
        h = rms_norm(x, norm_g[l, 0]) * (1.0 + sc_m) + sh_m
        y = hybrid_mixer(h, w_in[l], w_out[l], na_rpb[l], rw_mu[l], rw_w0[l], rw_w2[l], rw_a0[l], rw_a2[l],
                         rw_k_k[l], rw_k_a[l], rw_r_k[l], rw_lnx_w[l], rw_lnx_b[l], rw_g2[l],
                         pool_w[l], pool_scale[l], conv_w[l])
        x = x + gt_m * rms_norm(y, norm_g[l, 1])
        h = rms_norm(x, norm_g[l, 2]) * (1.0 + sc_f) + sh_f
        if l % 2 == 0:
            y = swiglu(h, ffn_w1[l // 2], ffn_w3[l // 2], ffn_w2[l // 2])
        else:
            y = moe_swiglu(h, router_w[l // 2], moe_w1[l // 2], moe_w3[l // 2], moe_w2[l // 2])
        x = x + gt_f * rms_norm(y, norm_g[l, 3])
    return x
```

```cpp
#include <hip/hip_runtime.h>
#include <cstdio>
#include <cstdint>

#ifndef MK_N_LAUNCHES
#define MK_N_LAUNCHES 0
#endif

#define GAS __attribute__((address_space(1)))
#define LAS __attribute__((address_space(3)))
typedef unsigned short bf16;
typedef float f32x4 __attribute__((ext_vector_type(4)));
typedef float f32x2 __attribute__((ext_vector_type(2)));
typedef unsigned u32x4 __attribute__((ext_vector_type(4)));
typedef unsigned u32x2 __attribute__((ext_vector_type(2)));
typedef short bf16x8 __attribute__((ext_vector_type(8)));
typedef __bf16 bfx2 __attribute__((ext_vector_type(2)));

constexpr int BATCH = 8, T = 4096, D = 1024, M = BATCH * T;
constexpr int GRID_W = 64, GW = 256;
constexpr int INW = 2688, ZW = 2816;
constexpr int FF = 3584, NE = 8;
constexpr int ZQ = 0, ZK = 256, ZV = 512, ZR = 768, ZLG = 1600, ZP = 1664, ZCB = 1920, ZCC = 2176, ZCH = 2432;
constexpr int RWS = 832;
constexpr float RMS_EPS = 1e-6f, LNX_EPS = 64e-5f;
constexpr int MOE_ROWS = 2 * M + NE * 256, MOE_BLKS = MOE_ROWS / 256;
constexpr int NPART = 3, PART_BLKS = MOE_BLKS / NPART;

namespace pg8 {
typedef unsigned short bf16_t;
constexpr int BM = 256, BK = 64, HALF = 128, HTB = HALF * BK * 2, STAGE_BYTES = 8 * HTB, NXCD = 8, WGM = 8;
__host__ __device__ __forceinline__ int lds_byte(int r, int c) { const int st = (r >> 4) * 2 + (c >> 5), rr = r & 15, cc = c & 31, ob = rr * 64 + cc * 2; return st * 1024 + (ob ^ (((ob >> 9) & 1) << 5)); }
__host__ __device__ __forceinline__ void stage_rc(int b, int& R, int& C) { const int st = b / 1024, sb = b % 1024, swz = sb ^ (((sb >> 9) & 1) << 5); R = (st >> 1) * 16 + swz / 64; C = (st & 1) * 32 + (swz % 64) / 2; }
__host__ __device__ __forceinline__ int perm32(int rho) { const int n = rho >> 4, i = rho & 15; return 8 * (i >> 2) + 4 * n + (i & 3); }

struct Unit { int pm, pn; };
struct Gemm { const bf16_t* A; const bf16_t* Bt; int M, N, K; const int* rowtok; };

struct StaticOrder {
    int nM, nN, nwg, G, c;
    __device__ void init(int M_, int N_, int G_, int c_) { nM = M_ / BM; nN = N_ / BM; nwg = nM * nN; G = G_; c = c_; }
    __device__ bool next(int i, Unit& u) const {
        const long L = (long)i * G + c; if (L >= nwg) return false;
        int wgid = (int)L; { const int q = nwg / NXCD, r = nwg % NXCD, xcd = wgid % NXCD, off = wgid / NXCD; wgid = (xcd < r ? xcd * (q + 1) : r * (q + 1) + (xcd - r) * q) + off; }
        const int nig = WGM * nN, gid = wgid / nig, fm = gid * WGM, gsz = (nM - fm) < WGM ? (nM - fm) : WGM;
        u.pm = fm + ((wgid % nig) % gsz); u.pn = (wgid % nig) / gsz; return true;
    }
    __device__ __forceinline__ size_t b_off(const Unit& u, size_t tstep) const { return (size_t)u.pn * tstep; }
    __device__ __forceinline__ int a_blk(const Unit& u) const { return u.pm; }
};
struct MoeOrder : StaticOrder {
    const int* blk_e; int pm0, apm0; size_t estride;
    __device__ __forceinline__ size_t b_off(const Unit& u, size_t tstep) const { return (size_t)blk_e[pm0 + u.pm] * estride + (size_t)u.pn * tstep; }
    __device__ __forceinline__ int a_blk(const Unit& u) const { return apm0 + u.pm; }
};

__device__ __forceinline__ unsigned cvt_pk_bf16(float lo, float hi) { unsigned r; asm volatile("v_cvt_pk_bf16_f32 %0, %1, %2" : "=v"(r) : "v"(lo), "v"(hi)); return r; }

struct EpiBf16 {
    static constexpr bool PERM = true;
    bf16_t* O; int ldc;
    __device__ __forceinline__ void operator()(const f32x4 (&acc)[2][2][4][2], const Unit& u, int wr, int wc, int fr, int fq) const {
        const int row0 = u.pm * BM + wr * 64 + fr; const int col0 = u.pn * BM + wc * 32 + 8 * fq;
#pragma unroll
        for (int ai = 0; ai < 2; ++ai)
#pragma unroll
            for (int m = 0; m < 4; ++m) { bf16_t* rowp = O + (size_t)(row0 + ai * HALF + m * 16) * ldc + col0;
#pragma unroll
                for (int bj = 0; bj < 2; ++bj) { const f32x4 v0 = acc[ai][bj][m][0], v1 = acc[ai][bj][m][1];
                    u32x4 w; w.x = cvt_pk_bf16(v0[0], v0[1]); w.y = cvt_pk_bf16(v0[2], v0[3]); w.z = cvt_pk_bf16(v1[0], v1[1]); w.w = cvt_pk_bf16(v1[2], v1[3]);
                    *(u32x4*)(rowp + bj * HALF) = w; } }
    }
};
struct EpiSwiGLU {
    static constexpr bool PERM = true;
    bf16_t* O; int ldc;
    __device__ __forceinline__ void operator()(const f32x4 (&acc)[2][2][4][2], const Unit& u, int wr, int wc, int fr, int fq) const {
        const int row0 = u.pm * BM + wr * 64 + fr; const int col0 = u.pn * HALF + wc * 32 + 8 * fq;
#pragma unroll
        for (int ai = 0; ai < 2; ++ai)
#pragma unroll
            for (int m = 0; m < 4; ++m) { bf16_t* rowp = O + (size_t)(row0 + ai * HALF + m * 16) * ldc + col0;
                float h[8];
#pragma unroll
                for (int n = 0; n < 2; ++n)
#pragma unroll
                    for (int x = 0; x < 4; ++x) { const float a = acc[ai][0][m][n][x], b = acc[ai][1][m][n][x]; h[4 * n + x] = a * b * __builtin_amdgcn_rcpf(1.0f + __expf(-a)); }
                u32x4 w; w.x = cvt_pk_bf16(h[0], h[1]); w.y = cvt_pk_bf16(h[2], h[3]); w.z = cvt_pk_bf16(h[4], h[5]); w.w = cvt_pk_bf16(h[6], h[7]);
                *(u32x4*)rowp = w; }
    }
};

template <class Epi, class Sched, bool GATHER>
__device__ __forceinline__ void gemm_phase(LAS unsigned char* lds, const Gemm g, const Sched& S, const Epi& E) {
    int tid_ = threadIdx.x; asm volatile("" : "+v"(tid_));
    const int tid = tid_, wid = __builtin_amdgcn_readfirstlane(tid >> 6), lane = tid & 63, wr = wid >> 2, wc = wid & 3, fr = lane & 15, fq = lane >> 4;
    const int K = g.K, nt = K / BK;
    const size_t kstep = (size_t)(BK * 2);
    const size_t hstep = (size_t)HALF * K * 2;
    const size_t tstep = 2 * hstep;
    unsigned voffB[2], voffA0[2];
#pragma unroll
    for (int i = 0; i < 2; ++i) { int R, C; stage_rc(tid * 16 + i * 8192, R, C); const int Rb = Epi::PERM ? ((R & ~31) + perm32(R & 31)) : R;
        voffA0[i] = (unsigned)(R * K + C) * 2u; voffB[i] = (unsigned)(Rb * K + C) * 2u; }
    const unsigned ldsw = (unsigned)wid * 1024u;
    const int aoff = lds_byte(wr * 64 + fr, fq * 8), boff = lds_byte(wc * 32 + fr, fq * 8);
#define PG8_SA(b, h) (((b) * 2 + (h)) * HTB)
#define PG8_SB(b, h) ((4 + (b) * 2 + (h)) * HTB)
#define PG8_STAGE(bufoff, gbase, voff) do { _Pragma("unroll") for (int _i = 0; _i < 2; ++_i) \
        __builtin_amdgcn_global_load_lds((const unsigned*)((const char*)(gbase) + (voff)[_i]), (LAS unsigned*)(lds + (bufoff) + ldsw + _i * 8192), 16, 0, 0); } while (0)
#define PG8_LDA(dst, b, h) do { _Pragma("unroll") for (int m = 0; m < 4; ++m) _Pragma("unroll") for (int k = 0; k < 2; ++k) dst[m][k] = *(const LAS bf16x8*)(lds + PG8_SA(b, h) + aoff + m * 2048 + k * 1024); } while (0)
#define PG8_LDB(dst, b, h) do { _Pragma("unroll") for (int n = 0; n < 2; ++n) _Pragma("unroll") for (int k = 0; k < 2; ++k) dst[n][k] = *(const LAS bf16x8*)(lds + PG8_SB(b, h) + boff + n * 2048 + k * 1024); } while (0)
#define PG8_MMA(ai, bj, At, Bt) do { __builtin_amdgcn_s_setprio(1); _Pragma("unroll") for (int m = 0; m < 4; ++m) _Pragma("unroll") for (int n = 0; n < 2; ++n) _Pragma("unroll") for (int k = 0; k < 2; ++k) \
        acc[ai][bj][m][n] = __builtin_amdgcn_mfma_f32_16x16x32_bf16(Bt[n][k], At[m][k], acc[ai][bj][m][n], 0, 0, 0); __builtin_amdgcn_s_setprio(0); } while (0)
#define PG8_WAIT_V(n) asm volatile("s_waitcnt vmcnt(" #n ")" ::: "memory")
#define PG8_WAIT_L(n) asm volatile("s_waitcnt lgkmcnt(" #n ")" ::: "memory")
#define PG8_BAR __builtin_amdgcn_s_barrier()
#define PG8_SCHED __builtin_amdgcn_sched_barrier(0)
#define PG8_AOFFS(dst, u) do { if constexpr (GATHER) { const int _rb = S.a_blk(u) * BM; int _t2 = tid; asm volatile("" : "+v"(_t2)); \
            _Pragma("unroll") for (int _h = 0; _h < 2; ++_h) _Pragma("unroll") for (int _i = 0; _i < 2; ++_i) { int _R, _C; stage_rc(_t2 * 16 + _i * 8192, _R, _C); \
            dst[_h][_i] = (unsigned)(g.rowtok[_rb + _h * HALF + _R] * K + _C) * 2u; } } } while (0)
#define PG8_STAGEA(bufoff, gbase, h, NX) do { _Pragma("unroll") for (int _i = 0; _i < 2; ++_i) { \
        const unsigned _o = GATHER ? (((NX) && last) ? vAn[h][_i] : vA[h][_i]) : (voffA0[_i] + (unsigned)((h) * hstep)); \
        __builtin_amdgcn_global_load_lds((const unsigned*)((const char*)(gbase) + _o), (LAS unsigned*)(lds + (bufoff) + ldsw + _i * 8192), 16, 0, 0); } } while (0)
#define PG8_ABASE(u) ((const char*)g.A + (GATHER ? (size_t)0 : (size_t)S.a_blk(u) * tstep))
    Unit cur, nxt; int ui = 0;
    if (!S.next(0, cur)) return;
    f32x4 acc[2][2][4][2];
#pragma unroll
    for (int a = 0; a < 2; ++a)
#pragma unroll
        for (int b = 0; b < 2; ++b)
#pragma unroll
            for (int m = 0; m < 4; ++m)
#pragma unroll
                for (int n = 0; n < 2; ++n) acc[a][b][m][n] = (f32x4){0.f, 0.f, 0.f, 0.f};
    bf16x8 At[4][2], B0[2][2], B1[2][2];
    unsigned vA[2][2], vAn[2][2]; const bool last = false;
    PG8_AOFFS(vA, cur);
    const char* cA = PG8_ABASE(cur); const char* cB = (const char*)g.Bt + S.b_off(cur, tstep);
    PG8_STAGE(PG8_SB(0, 0), cB, voffB); PG8_STAGE(PG8_SB(0, 1), cB + hstep, voffB); PG8_STAGEA(PG8_SA(0, 0), cA, 0, false); PG8_STAGEA(PG8_SA(0, 1), cA, 1, false);
    if (wr == 1) PG8_BAR;
    PG8_WAIT_V(2); PG8_BAR;
    PG8_STAGE(PG8_SB(1, 0), cB + kstep, voffB); PG8_STAGEA(PG8_SA(1, 0), cA + kstep, 0, false); PG8_STAGE(PG8_SB(1, 1), cB + hstep + kstep, voffB);
    PG8_WAIT_V(6); PG8_BAR;
    for (;;) {
        const bool has_next = S.next(ui + 1, nxt);
        const char* nA = cA; const char* nB = cB;
        if (has_next) { nA = PG8_ABASE(nxt); nB = (const char*)g.Bt + S.b_off(nxt, tstep); PG8_AOFFS(vAn, nxt); }
        else if constexpr (GATHER) {
#pragma unroll
            for (int h = 0; h < 2; ++h)
#pragma unroll
                for (int i = 0; i < 2; ++i) vAn[h][i] = vA[h][i]; }
        for (int t = 0; t < nt; t += 2) {
            const bool last = (t == nt - 2);
            const char* a1 = cA + (size_t)(t + 1) * kstep;
            const char* a2 = last ? nA : cA + (size_t)(t + 2) * kstep; const char* b2 = last ? nB : cB + (size_t)(t + 2) * kstep;
            const char* a3 = a2 + kstep; const char* b3 = b2 + kstep;
            PG8_LDB(B0, 0, 0); PG8_LDB(B1, 0, 1); PG8_SCHED; PG8_LDA(At, 0, 0); PG8_STAGEA(PG8_SA(1, 1), a1, 1, false);
            PG8_WAIT_V(8); PG8_WAIT_L(0); PG8_BAR; PG8_MMA(0, 0, At, B0); PG8_MMA(0, 1, At, B1); PG8_BAR; PG8_SCHED;
            PG8_LDA(At, 0, 1); PG8_STAGE(PG8_SB(0, 0), b2, voffB); PG8_STAGE(PG8_SB(0, 1), b2 + hstep, voffB); PG8_STAGEA(PG8_SA(0, 0), a2, 0, true);
            PG8_WAIT_V(8); PG8_WAIT_L(0); PG8_BAR; PG8_MMA(1, 0, At, B0); PG8_MMA(1, 1, At, B1); PG8_BAR; PG8_SCHED;
            PG8_LDB(B0, 1, 0); PG8_LDB(B1, 1, 1); PG8_SCHED; PG8_LDA(At, 1, 0); PG8_STAGEA(PG8_SA(0, 1), a2, 1, true);
            PG8_WAIT_V(8); PG8_WAIT_L(0); PG8_BAR; PG8_MMA(0, 0, At, B0); PG8_MMA(0, 1, At, B1); PG8_BAR; PG8_SCHED;
            PG8_LDA(At, 1, 1); PG8_STAGE(PG8_SB(1, 0), b3, voffB); PG8_STAGE(PG8_SB(1, 1), b3 + hstep, voffB); PG8_STAGEA(PG8_SA(1, 0), a3, 0, true);
            PG8_WAIT_V(8); PG8_WAIT_L(0); PG8_BAR; PG8_MMA(1, 0, At, B0); PG8_MMA(1, 1, At, B1); PG8_BAR; PG8_SCHED;
        }
        if (wr == 0) PG8_BAR;
        E(acc, cur, wr, wc, fr, fq);
        if (!has_next) break;
#pragma unroll
        for (int a = 0; a < 2; ++a)
#pragma unroll
            for (int b = 0; b < 2; ++b)
#pragma unroll
                for (int m = 0; m < 4; ++m)
#pragma unroll
                    for (int n = 0; n < 2; ++n) acc[a][b][m][n] = (f32x4){0.f, 0.f, 0.f, 0.f};
        cur = nxt; cA = nA; cB = nB; ++ui;
        if constexpr (GATHER) {
#pragma unroll
        for (int h = 0; h < 2; ++h)
#pragma unroll
            for (int i = 0; i < 2; ++i) vA[h][i] = vAn[h][i]; }
        if (wr == 1) PG8_BAR;
    }
    PG8_WAIT_V(0);
    PG8_BAR;
#undef PG8_SA
#undef PG8_SB
#undef PG8_STAGE
#undef PG8_LDA
#undef PG8_LDB
#undef PG8_MMA
#undef PG8_WAIT_V
#undef PG8_WAIT_L
#undef PG8_BAR
#undef PG8_SCHED
#undef PG8_AOFFS
#undef PG8_STAGEA
#undef PG8_ABASE
}
}

constexpr size_t MiB = 1u << 20;
constexpr size_t WS_CTL = 0, CTL_ZERO_BYTES = 64 * 1024;
constexpr size_t WS_MOD = 1 * MiB;
constexpr size_t WS_TOPI = 2 * MiB;
constexpr size_t WS_GATE = 2 * MiB + 512 * 1024;
constexpr size_t WS_DEST = 3 * MiB;
constexpr size_t WS_ROWTOK = 3 * MiB + 512 * 1024;
constexpr size_t WS_WGCNT = 4 * MiB;
constexpr size_t WS_MOEINFO = 4 * MiB + 64 * 1024;
constexpr size_t WS_WIN = 8 * MiB;
constexpr size_t WS_WOUT = 20 * MiB;
constexpr size_t WS_W13 = 24 * MiB;
constexpr size_t WS_W2 = 38 * MiB;
constexpr size_t WS_H = 48 * MiB;
constexpr size_t ARENA = 112 * MiB;
constexpr size_t WS_Z = ARENA;
constexpr size_t WS_YCAT = ARENA + 176 * MiB;
constexpr size_t WS_SCAN = ARENA + 240 * MiB;
constexpr size_t WS_Y = ARENA;
constexpr size_t WS_HID = ARENA + 64 * MiB;
constexpr size_t WS_WM13 = ARENA;
constexpr size_t WS_WM2 = ARENA + 112 * MiB;
constexpr size_t WS_YB = ARENA + 168 * MiB;
constexpr size_t WS_HIDM = ARENA + 300 * MiB;
constexpr size_t WS_END = ARENA + 454 * MiB;
static_assert(WS_SCAN + (size_t)2 * 8 * 4 * T * 384 * 2 <= WS_END && WS_HID + (size_t)M * FF * 2 <= WS_END && WS_HIDM + (size_t)PART_BLKS * 256 * FF * 2 <= WS_END, "ws map");
static_assert(WS_YB + (size_t)MOE_ROWS * D * 2 <= WS_HIDM && WS_WM2 + (size_t)NE * D * FF * 2 <= WS_YB, "ws map 2");

constexpr int LDS_BYTES = 163840;
constexpr int SCR_BYTES = 163840 - 512;
constexpr int MISC_OFF = SCR_BYTES;
constexpr int NWAVES = 8;

#define LDS_WAIT() asm volatile("s_waitcnt lgkmcnt(0)" ::: "memory")
#define VM_WAIT() asm volatile("s_waitcnt vmcnt(0)" ::: "memory")
__device__ __forceinline__ unsigned f2bf(float f) { unsigned u = __builtin_bit_cast(unsigned, f); return (u + 0x7fffu + ((u >> 16) & 1u)) >> 16; }
__device__ __forceinline__ unsigned pk2(float lo, float hi) { return f2bf(lo) | (f2bf(hi) << 16); }
__device__ __forceinline__ float bf2f(unsigned b) { return __builtin_bit_cast(float, b << 16); }
__device__ __forceinline__ float bflo(unsigned u) { return __builtin_bit_cast(float, u << 16); }
__device__ __forceinline__ float bfhi(unsigned u) { return __builtin_bit_cast(float, u & 0xffff0000u); }
__device__ __forceinline__ float wave_sum(float v) {
#pragma unroll
    for (int o = 1; o < 64; o <<= 1) v += __shfl_xor(v, o);
    return v;
}
__device__ __forceinline__ float row16_sum(float v) {
    v += __builtin_bit_cast(float, __builtin_amdgcn_update_dpp(0, __builtin_bit_cast(int, v), 0x128, 0xf, 0xf, false));
    v += __builtin_bit_cast(float, __builtin_amdgcn_update_dpp(0, __builtin_bit_cast(int, v), 0x124, 0xf, 0xf, false));
    v += __builtin_bit_cast(float, __builtin_amdgcn_update_dpp(0, __builtin_bit_cast(int, v), 0x122, 0xf, 0xf, false));
    v += __builtin_bit_cast(float, __builtin_amdgcn_update_dpp(0, __builtin_bit_cast(int, v), 0x121, 0xf, 0xf, false));
    return v;
}
__device__ __forceinline__ float sigmoidf_(float x) { return 1.0f / (1.0f + __expf(-x)); }

#define XB_TMO      128
#define XB_XCNT(j)  (256  + 64 * (j))
#define XB_XSUB(j)  (1280 + 64 * (j))
#define XB_XGEN(j)  (2304 + 64 * (j))
#define XB_TOP      3328
#define XB_TOPGEN   3392
#define XCD_BAR_WORDS 3456
#define XB_SPIN_CAP (1u << 22)
__device__ __forceinline__ unsigned xb_ld(unsigned* p)              { return __hip_atomic_load(p, __ATOMIC_RELAXED, __HIP_MEMORY_SCOPE_AGENT); }
__device__ __forceinline__ unsigned xb_add(unsigned* p, unsigned v) { return __hip_atomic_fetch_add(p, v, __ATOMIC_RELAXED, __HIP_MEMORY_SCOPE_AGENT); }
__device__ __forceinline__ unsigned xb_xcc_id() { return (unsigned)__builtin_amdgcn_s_getreg((3 << 11) | 20) & 0xFu; }
#define XB_SPIN(cond, bar) do { unsigned _sp = 0; while (cond) { __builtin_amdgcn_s_sleep(1); \
    if ((++_sp & 255u) == 0u) { if (xb_ld(&(bar)[XB_TMO])) break; if (_sp > XB_SPIN_CAP) { atomicAdd(&(bar)[XB_TMO], 1u); break; } } } } while (0)
struct XcdBarrier { unsigned* bar; unsigned x; volatile LAS unsigned* st; };
__device__ __forceinline__ XcdBarrier xcd_barrier_post(unsigned* bar, volatile LAS unsigned* st) {
    XcdBarrier b; b.bar = bar; b.x = xb_xcc_id(); b.st = st;
    if (threadIdx.x == 0) (void)xb_add(&bar[XB_XCNT(b.x)], 1u);
    return b;
}
__device__ __forceinline__ void xcd_barrier_complete(unsigned* bar, unsigned x, unsigned& nloc, unsigned& nx) {
    const unsigned G = gridDim.x * gridDim.y * gridDim.z;
    unsigned sum, cnt, mine, sp = 0u;
    for (;;) {
        sum = 0u; cnt = 0u; mine = 0u;
#pragma unroll
        for (unsigned j = 0; j < 16; ++j) { const unsigned c = xb_ld(&bar[XB_XCNT(j)]); sum += c; cnt += (c > 0u) ? 1u : 0u; mine = (j == x) ? c : mine; }
        if (sum == G) break;
        __builtin_amdgcn_s_sleep(1);
        if ((++sp & 255u) == 0u) { if (xb_ld(&bar[XB_TMO])) break; if (sp > XB_SPIN_CAP) { atomicAdd(&bar[XB_TMO], 1u); break; } }
    }
    nloc = mine > 0u ? mine : 1u; nx = cnt > 0u ? cnt : 1u;
}
__device__ __forceinline__ void xcd_barrier(const XcdBarrier& b) {
    asm volatile("s_waitcnt vmcnt(0)" ::: "memory");
    __syncthreads();
    if (threadIdx.x == 0) {
        unsigned* bar = b.bar;
        __builtin_amdgcn_s_waitcnt(0);
        unsigned nloc = b.st[0], nx = b.st[1];
        if (nloc == 0u) { xcd_barrier_complete(bar, b.x, nloc, nx); b.st[0] = nloc; b.st[1] = nx; }
        const unsigned old = xb_add(&bar[XB_XSUB(b.x)], 1u);
        const unsigned gen = old / nloc;
        if (old + 1u == (gen + 1u) * nloc) {
            __builtin_amdgcn_fence(__ATOMIC_RELEASE, "agent");
            asm volatile("s_waitcnt vmcnt(0)" ::: "memory");
            const unsigned og = xb_add(&bar[XB_TOP], 1u);
            const unsigned tg = og / nx;
            if (og + 1u == (tg + 1u) * nx) xb_add(&bar[XB_TOPGEN], 1u);
            else XB_SPIN(xb_ld(&bar[XB_TOPGEN]) == tg, bar);
            __builtin_amdgcn_fence(__ATOMIC_ACQUIRE, "agent");
            xb_add(&bar[XB_XGEN(b.x)], 1u);
            asm volatile("s_waitcnt vmcnt(0)" ::: "memory");
        } else {
            XB_SPIN(xb_ld(&bar[XB_XGEN(b.x)]) == gen, bar);
            __builtin_amdgcn_fence(__ATOMIC_ACQUIRE, "agent");
            asm volatile("s_waitcnt vmcnt(0)" ::: "memory");
        }
    }
    __syncthreads();
}

struct Args { const float* in[29]; float* out; unsigned char* ws; int ph_lo, ph_hi; };
enum { IN_X = 0, IN_C, IN_ADAW, IN_ADAB, IN_NORMG, IN_WIN, IN_WOUT, IN_RPB, IN_MU, IN_W0, IN_W2L, IN_A0, IN_A2L, IN_KK, IN_KA, IN_RK, IN_LNW, IN_LNB, IN_G2,
       IN_POOLW, IN_POOLS, IN_CONVW, IN_FW1, IN_FW3, IN_FW2, IN_ROUTER, IN_MW1, IN_MW3, IN_MW2 };

__device__ __forceinline__ void transpose_item(const float* W, int K, int N, bf16* WT, int drow0, int k0, int n0, LAS float* scr, int lane) {
#pragma unroll 8
    for (int i = 0; i < 32; ++i) { const int kk = 2 * i + (lane >> 5); scr[kk * 33 + (lane & 31)] = W[(size_t)(k0 + kk) * N + n0 + (lane & 31)]; }
    LDS_WAIT(); asm volatile("" ::: "memory");
    const int c = lane & 7;
#pragma unroll
    for (int j = 0; j < 4; ++j) { const int n = (lane >> 3) + 8 * j; const LAS float* s = scr + (8 * c) * 33 + n;
        u32x4 o; o.x = pk2(s[0 * 33], s[1 * 33]); o.y = pk2(s[2 * 33], s[3 * 33]); o.z = pk2(s[4 * 33], s[5 * 33]); o.w = pk2(s[6 * 33], s[7 * 33]);
        *(u32x4*)(WT + (size_t)(drow0 + n) * K + k0 + 8 * c) = o; }
    LDS_WAIT(); asm volatile("" ::: "memory");
}
template <int MODE> __device__ __forceinline__ void transpose_mat(const float* W, int K, int N, bf16* WT, int gw, int NGW, LAS float* scr, int lane) {
    const int nblk = N / 32, nitems = (K / 64) * nblk;
    for (int it = gw; it < nitems; it += NGW) { const int kb = it / nblk, nb = it % nblk, n0 = 32 * nb;
        const int drow0 = MODE == 0 ? n0 : (256 * (n0 >> 7) + (n0 & 127) + (MODE == 2 ? 128 : 0));
        transpose_item(W, K, N, WT, drow0, 64 * kb, n0, scr, lane); }
}

__device__ __forceinline__ void ld_row_f32(const float* p, int lane, f32x4 (&v)[4]) {
#pragma unroll
    for (int j = 0; j < 4; ++j) v[j] = *(const f32x4*)(p + 4 * lane + 256 * j);
}
__device__ __forceinline__ void ld_row_bf16(const bf16* p, int lane, f32x4 (&v)[4]) {
#pragma unroll
    for (int j = 0; j < 4; ++j) { const u32x2 u = *(const u32x2*)(p + 4 * lane + 256 * j); v[j] = (f32x4){bflo(u.x), bfhi(u.x), bflo(u.y), bfhi(u.y)}; }
}
__device__ __forceinline__ void st_row_bf16(bf16* p, int lane, const f32x4 (&v)[4]) {
#pragma unroll
    for (int j = 0; j < 4; ++j) { u32x2 u; u.x = pk2(v[j][0], v[j][1]); u.y = pk2(v[j][2], v[j][3]); *(u32x2*)(p + 4 * lane + 256 * j) = u; }
}
__device__ __forceinline__ void st_row_f32(float* p, int lane, const f32x4 (&v)[4]) {
#pragma unroll
    for (int j = 0; j < 4; ++j) *(f32x4*)(p + 4 * lane + 256 * j) = v[j];
}
__device__ __forceinline__ float row_rstd(const f32x4 (&v)[4]) {
    float s = 0.f;
#pragma unroll
    for (int j = 0; j < 4; ++j) s += (v[j][0] * v[j][0] + v[j][1] * v[j][1]) + (v[j][2] * v[j][2] + v[j][3] * v[j][3]);
    return 1.0f / sqrtf(wave_sum(s) * (1.0f / D) + RMS_EPS);
}
__device__ __forceinline__ void modulate(const f32x4 (&x)[4], float rstd, const float* g, const float* sc, const float* sh, int lane, f32x4 (&h)[4]) {
    f32x4 gv[4], scv[4], shv[4]; ld_row_f32(g, lane, gv); ld_row_f32(sc, lane, scv); ld_row_f32(sh, lane, shv);
#pragma unroll
    for (int j = 0; j < 4; ++j) h[j] = x[j] * rstd * gv[j] * (1.0f + scv[j]) + shv[j];
}

__device__ __forceinline__ const float* inp_ptr(const Args& a, int i) { asm volatile("" : "+s"(i)); return a.in[i]; }
#define INP(i) inp_ptr(args, (i))
#define mod_l (MOD + (size_t)l * 8 * 6 * D)
#define PHASE_PROLOGUE \
    int tid_l = threadIdx.x; asm volatile("" : "+v"(tid_l)); const int tid = tid_l, lane = tid & 63, wave = __builtin_amdgcn_readfirstlane(tid >> 6), gw = vcu * NWAVES + wave; (void)lane; (void)wave; (void)gw; (void)tid; \
    unsigned char* ws = ws0; asm volatile("" : "+s"(ws)); float* X = args.out; asm volatile("" : "+s"(X)); \
    float* const MOD = (float*)(ws + WS_MOD); bf16* const H = (bf16*)(ws + WS_H); float* const YS = (float*)(ws + WS_H); bf16* const Z = (bf16*)(ws + WS_Z); bf16* const YCAT = (bf16*)(ws + WS_YCAT); \
    bf16* const SCAN = (bf16*)(ws + WS_SCAN); bf16* const Y = (bf16*)(ws + WS_Y); bf16* const HID = (bf16*)(ws + WS_HID); int* const TOPI = (int*)(ws + WS_TOPI); float* const GATE = (float*)(ws + WS_GATE); \
    int* const DEST = (int*)(ws + WS_DEST); int* const ROWTOK = (int*)(ws + WS_ROWTOK); int* const WGCNT = (int*)(ws + WS_WGCNT); int* const MOEINFO = (int*)(ws + WS_MOEINFO); \
    (void)X; (void)MOD; (void)H; (void)YS; (void)Z; (void)YCAT; (void)SCAN; (void)Y; (void)HID; (void)TOPI; (void)GATE; (void)DEST; (void)ROWTOK; (void)WGCNT; (void)MOEINFO;
#ifndef PH_MASK
#define PH_MASK 0xffff
#endif
#define PHEN(i) (((PH_MASK) >> (i)) & 1)
#ifndef SUB_MASK
#define SUB_MASK 7
#endif
#define SUBEN(i) (((SUB_MASK) >> (i)) & 1)
#define IN(k) (lo <= (k) && (k) < hi)
#define SEAM(k) do { if (MK_N_LAUNCHES == 1 && IN((k) + 1)) xcd_barrier(bar); } while (0)
template <int l> __device__ __forceinline__ void layer_phases(const Args& args, unsigned char* const ws0, LAS unsigned char* lds, const int vcu, const int G, const int bx, const int NGW, const int lo, const int hi, const XcdBarrier& bar) {
        const int P = 2 + 16 * l;
        if (PHEN(2) && IN(P + 0)) {
            PHASE_PROLOGUE
            pg8::Gemm g{H, (const bf16*)(ws + WS_WIN) + (size_t)l * ZW * D, M, ZW, D, nullptr}; pg8::StaticOrder S; S.init(M, ZW, G, bx);
            pg8::EpiBf16 E{Z, ZW};
            pg8::gemm_phase<pg8::EpiBf16, pg8::StaticOrder, false>(lds, g, S, E);
            SEAM(P + 0);
        }
        if (PHEN(3) && IN(P + 1)) {
            PHASE_PROLOGUE
            if (SUBEN(0)) {
                constexpr int KST = 144;
                LAS unsigned char* Ks = lds; LAS unsigned char* Vs = lds + 512 * KST;
                LAS float* part = (LAS float*)lds;
                const float* rpb = INP(IN_RPB) + (size_t)l * 4 * 15 * 31;
                for (int u = vcu; u < BATCH * 64 * 4; u += G) {
                    const int hh = u & 3, r = (u >> 2) & 63, b = u >> 8;
                    const int rs = min(max(r - 4, 0), 56);
                    for (int i = tid; i < 512 * 8 * 2; i += NWAVES * 64) { const int kv = i >> 12, key = (i >> 3) & 511, c8 = i & 7;
                        const bf16* src = Z + (size_t)(b * T + rs * 64 + key) * ZW + (kv ? ZV : ZK) + hh * 64 + c8 * 8;
                        *(LAS u32x4*)((kv ? Vs : Ks) + key * KST + c8 * 16) = *(const u32x4*)src; }
                    const int q = lane, wi = wave;
                    const int cs = min(max(q - 8, 0), 48);
                    float qv[64];
                    { const bf16* qp = Z + (size_t)(b * T + r * 64 + q) * ZW + ZQ + hh * 64;
#pragma unroll
                      for (int c8 = 0; c8 < 8; ++c8) { const u32x4 w = *(const u32x4*)(qp + c8 * 8);
                          qv[c8 * 8 + 0] = bflo(w.x) * 0.125f; qv[c8 * 8 + 1] = bfhi(w.x) * 0.125f; qv[c8 * 8 + 2] = bflo(w.y) * 0.125f; qv[c8 * 8 + 3] = bfhi(w.y) * 0.125f;
                          qv[c8 * 8 + 4] = bflo(w.z) * 0.125f; qv[c8 * 8 + 5] = bfhi(w.z) * 0.125f; qv[c8 * 8 + 6] = bflo(w.w) * 0.125f; qv[c8 * 8 + 7] = bfhi(w.w) * 0.125f; } }
                    __syncthreads();
                    float mx = -1e30f, ls = 0.f;
                    const float* bias = rpb + (size_t)hh * 15 * 31 + (rs + wi - r + 7) * 31 + (cs - q + 15);
                    float ov[64];
#pragma unroll
                    for (int d = 0; d < 64; ++d) ov[d] = 0.f;
#pragma unroll 1
                    for (int j = 0; j < 16; ++j) { const LAS unsigned char* kp = Ks + ((wi * 64 + cs + j) * KST); const LAS unsigned char* vp = Vs + ((wi * 64 + cs + j) * KST);
                        float s = bias[j];
#pragma unroll
                        for (int c8 = 0; c8 < 8; ++c8) { const u32x4 w = *(const LAS u32x4*)(kp + c8 * 16);
                            s += qv[c8 * 8 + 0] * bflo(w.x) + qv[c8 * 8 + 1] * bfhi(w.x) + qv[c8 * 8 + 2] * bflo(w.y) + qv[c8 * 8 + 3] * bfhi(w.y)
                               + qv[c8 * 8 + 4] * bflo(w.z) + qv[c8 * 8 + 5] * bfhi(w.z) + qv[c8 * 8 + 6] * bflo(w.w) + qv[c8 * 8 + 7] * bfhi(w.w); }
                        const float mn = fmaxf(mx, s), f = __expf(mx - mn), pr = __expf(s - mn); mx = mn; ls = ls * f + pr;
#pragma unroll
                        for (int c8 = 0; c8 < 8; ++c8) { const u32x4 w = *(const LAS u32x4*)(vp + c8 * 16);
                            ov[c8 * 8 + 0] = ov[c8 * 8 + 0] * f + pr * bflo(w.x); ov[c8 * 8 + 1] = ov[c8 * 8 + 1] * f + pr * bfhi(w.x); ov[c8 * 8 + 2] = ov[c8 * 8 + 2] * f + pr * bflo(w.y); ov[c8 * 8 + 3] = ov[c8 * 8 + 3] * f + pr * bfhi(w.y);
                            ov[c8 * 8 + 4] = ov[c8 * 8 + 4] * f + pr * bflo(w.z); ov[c8 * 8 + 5] = ov[c8 * 8 + 5] * f + pr * bfhi(w.z); ov[c8 * 8 + 6] = ov[c8 * 8 + 6] * f + pr * bflo(w.w); ov[c8 * 8 + 7] = ov[c8 * 8 + 7] * f + pr * bfhi(w.w); } }
                    __syncthreads();
                    { LAS float* pp = part + (wi * 64 + q) * 66;
#pragma unroll
                      for (int d = 0; d < 64; ++d) pp[d] = ov[d];
                      pp[64] = mx; pp[65] = ls; }
                    __syncthreads();
                    { float mw[8], gm = -1e30f;
#pragma unroll
                      for (int w = 0; w < 8; ++w) { mw[w] = part[(w * 64 + q) * 66 + 64]; gm = fmaxf(gm, mw[w]); }
                      float den = 0.f, o8[8];
#pragma unroll
                      for (int d = 0; d < 8; ++d) o8[d] = 0.f;
#pragma unroll
                      for (int w = 0; w < 8; ++w) { const float f = __expf(mw[w] - gm); den += f * part[(w * 64 + q) * 66 + 65];
#pragma unroll
                          for (int d = 0; d < 8; ++d) o8[d] += f * part[(w * 64 + q) * 66 + wi * 8 + d]; }
                      const float inv = 1.0f / den;
                      u32x4 o; o.x = pk2(o8[0] * inv, o8[1] * inv); o.y = pk2(o8[2] * inv, o8[3] * inv); o.z = pk2(o8[4] * inv, o8[5] * inv); o.w = pk2(o8[6] * inv, o8[7] * inv);
                      *(u32x4*)(YCAT + (size_t)(b * T + r * 64 + q) * D + hh * 64 + wi * 8) = o; }
                    __syncthreads();
                }
            }
            if (SUBEN(1)) {
                LAS float* dl = (LAS float*)lds;
                const int ch = tid & 255, hf = tid >> 8, gq = ch >> 6, win = 2 << gq;
                float pw[64];
                { const float* p = INP(IN_POOLW) + (size_t)l * 4 * 64 * 64 + (size_t)gq * 64 * 64 + (ch & 63);
#pragma unroll
                  for (int c = 0; c < 64; ++c) pw[c] = p[c * 64]; }
                const float pscale = INP(IN_POOLS)[l * GW + ch];
                const float cw0 = INP(IN_CONVW)[(size_t)l * 3 * GW + ch], cw1 = INP(IN_CONVW)[(size_t)l * 3 * GW + GW + ch], cw2 = INP(IN_CONVW)[(size_t)l * 3 * GW + 2 * GW + ch];
                for (int it = vcu; it < M / 32; it += G) {
                    const int b = it >> 7, t0 = (it & 127) * 32;
                    for (int k = 0; k < 16; ++k) { const int tt = hf + 2 * k, t = t0 + tt;
                        const int lo_ = max(t - win / 2, 0), hi_ = min(t - win / 2 + win, T);
                        float s = 0.f;
                        for (int tp = lo_; tp < hi_; ++tp) s += bf2f(Z[(size_t)(b * T + tp) * ZW + ZP + ch]);
                        const float uu = bf2f(Z[(size_t)(b * T + t) * ZW + ZP + ch]);
                        dl[tt * 256 + ch] = s / (float)(hi_ - lo_) - uu; }
                    __syncthreads();
                    for (int k = 0; k < 16; ++k) { const int tt = hf + 2 * k, t = t0 + tt;
                        const LAS float* dr = dl + tt * 256 + gq * 64;
                        float a = 0.f;
#pragma unroll
                        for (int c = 0; c < 64; ++c) a += dr[c] * pw[c];
                        YCAT[(size_t)(b * T + t) * D + 512 + ch] = (bf16)f2bf(a * pscale);
                        const bf16* zc = Z + (size_t)(b * T + t) * ZW;
                        float u0 = 0.f, u2 = 0.f;
                        if (t > 0) u0 = bf2f(zc[-ZW + ZCC + ch]) * bf2f(zc[-ZW + ZCH + ch]);
                        if (t < T - 1) u2 = bf2f(zc[ZW + ZCC + ch]) * bf2f(zc[ZW + ZCH + ch]);
                        const float u1 = bf2f(zc[ZCC + ch]) * bf2f(zc[ZCH + ch]);
                        YCAT[(size_t)(b * T + t) * D + 768 + ch] = (bf16)f2bf(bf2f(zc[ZCB + ch]) * (cw0 * u0 + cw1 * u1 + cw2 * u2)); }
                    __syncthreads();
                }
            }
            if (SUBEN(2)) {
                LAS float* lat = (LAS float*)lds;
                const int e = tid >> 8, c = tid & 255, hh = c >> 6, j = c & 63;
                float w2c[32], a2c[32];
                { const float* w2p = INP(IN_W2L); const float* a2p = INP(IN_A2L);
#pragma unroll
                for (int q = 0; q < 32; ++q) { w2c[q] = w2p[((size_t)(l * 2 + e) * 32 + q) * GW + c]; a2c[q] = a2p[((size_t)(l * 2 + e) * 32 + q) * GW + c]; } }
                const float w0c = INP(IN_W0)[(size_t)(l * 2 + e) * GW + c], a0c = INP(IN_A0)[(size_t)(l * 2 + e) * GW + c];
                const float kkc = INP(IN_KK)[(size_t)l * GW + c], kac = INP(IN_KA)[(size_t)l * GW + c];
                const float* mu_all = INP(IN_MU); const float* mu = mu_all + (size_t)(l * 2 + e) * RWS;
                const float mur = mu[c], muk = mu[256 + c], muv = mu[512 + c];
                for (int it = vcu; it < M / 16; it += G) {
                    const int b = it >> 8, t0 = (it & 255) * 16;
                    for (int i = tid; i < 2048; i += NWAVES * 64) { const int ee = i >> 10, tt = (i >> 6) & 15, q = i & 63, t = t0 + tt;
                        const float zc = bf2f(Z[(size_t)(b * T + t) * ZW + ZR + 768 + q]);
                        const int ts = ee ? t + 1 : t - 1;
                        const float zs = (ts >= 0 && ts < T) ? bf2f(Z[(size_t)(b * T + ts) * ZW + ZR + 768 + q]) : 0.f;
                        const float zd = zc + mu_all[(size_t)(l * 2 + ee) * RWS + 768 + q] * (zs - zc);
                        lat[i] = q < 32 ? tanhf(zd) : zd; }
                    __syncthreads();
                    for (int tt = 0; tt < 16; ++tt) { const int t = t0 + tt, ts = e ? t + 1 : t - 1; const bool ok = (ts >= 0 && ts < T);
                        const bf16* zc = Z + (size_t)(b * T + t) * ZW + ZR; const bf16* zs = Z + (size_t)(b * T + ts) * ZW + ZR;
                        const float r0 = bf2f(zc[c]), k0 = bf2f(zc[256 + c]), v0 = bf2f(zc[512 + c]);
                        const float rs_ = ok ? bf2f(zs[c]) : 0.f, ks_ = ok ? bf2f(zs[256 + c]) : 0.f, vs_ = ok ? bf2f(zs[512 + c]) : 0.f;
                        const float rr = r0 + mur * (rs_ - r0), kk0 = k0 + muk * (ks_ - k0), vv = v0 + muv * (vs_ - v0);
                        const LAS float* lt = lat + (e * 16 + tt) * 64;
                        float wp = w0c, ap = a0c;
#pragma unroll
                        for (int q = 0; q < 32; ++q) { wp += lt[q] * w2c[q]; ap += lt[32 + q] * a2c[q]; }
                        const float nx = -wp;
                        const float sp = fmaxf(nx, 0.f) + log1pf(__expf(-fabsf(nx)));
                        const float wl = -sp - 0.5f;
                        const float omd = -expm1f(-__expf(wl));
                        const float av = sigmoidf_(ap);
                        float kk = kk0 * kkc; const float ss = wave_sum(kk * kk);
                        kk *= 1.0f / sqrtf(fmaxf(ss, 1e-12f));
                        const float kmod = kk0 * (1.0f + (av - 1.0f) * kac);
                        bf16* o = SCAN + ((size_t)((e * 8 + b) * 4 + hh) * T + t) * 384 + j;
                        o[0] = (bf16)f2bf(rr); o[64] = (bf16)f2bf(omd); o[128] = (bf16)f2bf(kmod); o[192] = (bf16)f2bf(vv); o[256] = (bf16)f2bf(-kk); o[320] = (bf16)f2bf(kk * av); }
                    __syncthreads();
                }
            }
            SEAM(P + 1);
        }
        if (PHEN(4) && IN(P + 2)) {
            PHASE_PROLOGUE
            if (wave < 4) {
                const int u = bx * 4 + wave;
                if (u < 1024) {
                    const int chain = u >> 4, rg = u & 15, e = chain >> 5;
                    const int il = lane >> 4, jq = lane & 15, irow = rg * 4 + il;
                    const bf16* base = SCAN + (size_t)chain * T * 384;
                    float* ys = YS + ((size_t)(e * 8 + ((chain >> 2) & 7)) * T) * 256 + (chain & 3) * 64 + irow;
                    float S0 = 0.f, S1 = 0.f, S2 = 0.f, S3 = 0.f;
#define SC_LOAD(Q, V, blk) do { _Pragma("unroll") for (int _s = 0; _s < 8; ++_s) { const int _st = (blk) * 8 + _s; const int _t = e ? (T - 1 - _st) : _st; const bf16* _p = base + (size_t)_t * 384; \
        Q[_s][0] = *(const u32x2*)(_p + 4 * jq); Q[_s][1] = *(const u32x2*)(_p + 64 + 4 * jq); Q[_s][2] = *(const u32x2*)(_p + 128 + 4 * jq); Q[_s][3] = *(const u32x2*)(_p + 256 + 4 * jq); Q[_s][4] = *(const u32x2*)(_p + 320 + 4 * jq); \
        V[_s] = _p[192 + irow]; } } while (0)
#define SC_STEP(Q, V, blk) do { _Pragma("unroll") for (int _s = 0; _s < 8; ++_s) { const int _st = (blk) * 8 + _s; const int _t = e ? (T - 1 - _st) : _st; \
        const u32x2 r4 = Q[_s][0], d4 = Q[_s][1], k4 = Q[_s][2], a4 = Q[_s][3], b4 = Q[_s][4]; const float v = bf2f(V[_s]); \
        float sa = S0 * bflo(a4.x) + S1 * bfhi(a4.x) + S2 * bflo(a4.y) + S3 * bfhi(a4.y); sa = row16_sum(sa); \
        S0 = S0 - S0 * bflo(d4.x) + sa * bflo(b4.x) + v * bflo(k4.x); S1 = S1 - S1 * bfhi(d4.x) + sa * bfhi(b4.x) + v * bfhi(k4.x); \
        S2 = S2 - S2 * bflo(d4.y) + sa * bflo(b4.y) + v * bflo(k4.y); S3 = S3 - S3 * bfhi(d4.y) + sa * bfhi(b4.y) + v * bfhi(k4.y); \
        float y = S0 * bflo(r4.x) + S1 * bfhi(r4.x) + S2 * bflo(r4.y) + S3 * bfhi(r4.y); y = row16_sum(y); \
        if (jq == 0) ys[(size_t)_t * 256] = y; } } while (0)
                    u32x2 qa[8][5], qb[8][5]; unsigned short va[8], vb[8];
                    SC_LOAD(qa, va, 0);
                    for (int blk = 0; blk < T / 8; blk += 2) {
                        SC_LOAD(qb, vb, blk + 1);
                        SC_STEP(qa, va, blk);
                        if (blk + 2 < T / 8) SC_LOAD(qa, va, blk + 2);
                        SC_STEP(qb, vb, blk + 1);
                    }
#undef SC_LOAD
#undef SC_STEP
                }
            }
            SEAM(P + 2);
        }
        if (PHEN(5) && IN(P + 3)) {
            PHASE_PROLOGUE
            LAS float* sg = (LAS float*)lds;
            const int c = tid & 255, hf = tid >> 8;
            float g2c[64];
            { const float* g2p = INP(IN_G2);
#pragma unroll
            for (int q = 0; q < 64; ++q) g2c[q] = g2p[((size_t)l * 64 + q) * GW + c]; }
            const float lw = INP(IN_LNW)[(size_t)l * GW + c], lb = INP(IN_LNB)[(size_t)l * GW + c], rk = INP(IN_RK)[(size_t)l * GW + c];
            for (int it = vcu; it < M / 16; it += G) {
                const int m0 = it * 16;
                for (int i = tid; i < 1024; i += NWAVES * 64) sg[i] = sigmoidf_(bf2f(Z[(size_t)(m0 + (i >> 6)) * ZW + ZLG + (i & 63)]));
                __syncthreads();
                for (int k = 0; k < 8; ++k) { const int tt = hf * 8 + k, m = m0 + tt;
                    const float y = YS[(size_t)m * 256 + c] + YS[(size_t)(M + m) * 256 + c];
                    const float mean = wave_sum(y) * (1.0f / 64.0f); const float dv = y - mean;
                    const float var = wave_sum(dv * dv) * (1.0f / 64.0f);
                    float yn = dv * (1.0f / sqrtf(var + LNX_EPS)) * lw + lb;
                    const bf16* zc = Z + (size_t)m * ZW + ZR;
                    const float r0 = bf2f(zc[c]), k0 = bf2f(zc[256 + c]), v0 = bf2f(zc[512 + c]);
                    yn += wave_sum(r0 * k0 * rk) * v0;
                    const LAS float* sr = sg + tt * 64;
                    float gg = 0.f;
#pragma unroll
                    for (int q = 0; q < 64; ++q) gg += sr[q] * g2c[q];
                    YCAT[(size_t)m * D + 256 + c] = (bf16)f2bf(yn * gg); }
                __syncthreads();
            }
            SEAM(P + 3);
        }
        if (PHEN(6) && IN(P + 4)) {
            PHASE_PROLOGUE
            pg8::Gemm g{YCAT, (const bf16*)(ws + WS_WOUT) + (size_t)l * D * D, M, D, D, nullptr}; pg8::StaticOrder S; S.init(M, D, G, bx);
            pg8::EpiBf16 E{Y, D};
            pg8::gemm_phase<pg8::EpiBf16, pg8::StaticOrder, false>(lds, g, S, E);
            SEAM(P + 4);
        }
        if (PHEN(7) && IN(P + 5)) {
            PHASE_PROLOGUE
            LAS float* rw = (LAS float*)lds;
            LAS int* lcnt = (LAS int*)(lds + 32768);
            if (l == 1) { const float* rwp = INP(IN_ROUTER); for (int i = tid; i < D * NE; i += NWAVES * 64) rw[i] = rwp[i]; if (tid < 8) lcnt[tid] = 0; __syncthreads(); }
            const float* xsrc = (l == 0) ? INP(IN_X) : X; const float* ng = INP(IN_NORMG) + (size_t)l * 4 * D;
            for (int r = 0; r < 16; ++r) { const int m = bx * 128 + wave * 16 + r, b = m / T;
                const float* mod = mod_l + (size_t)b * 6 * D;
                f32x4 yv[4], xv[4], gv[4], gt[4], hv[4];
                ld_row_bf16(Y + (size_t)m * D, lane, yv); ld_row_f32(xsrc + (size_t)m * D, lane, xv);
                ld_row_f32(ng + 1 * D, lane, gv); ld_row_f32(mod + 2 * D, lane, gt);
                const float rs = row_rstd(yv);
#pragma unroll
                for (int j = 0; j < 4; ++j) xv[j] = xv[j] + gt[j] * (yv[j] * rs * gv[j]);
                st_row_f32(X + (size_t)m * D, lane, xv);
                modulate(xv, row_rstd(xv), ng + 2 * D, mod + 4 * D, mod + 3 * D, lane, hv);
                st_row_bf16(H + (size_t)m * D, lane, hv);
                if (l == 1) {
                    float lg[8];
#pragma unroll
                    for (int e = 0; e < 8; ++e) lg[e] = 0.f;
#pragma unroll
                    for (int j = 0; j < 4; ++j)
#pragma unroll
                        for (int x = 0; x < 4; ++x) { const LAS float* rr = rw + (4 * lane + 256 * j + x) * 8; const f32x4 w0 = *(const LAS f32x4*)rr, w1 = *(const LAS f32x4*)(rr + 4); const float hx = hv[j][x];
                            lg[0] += hx * w0[0]; lg[1] += hx * w0[1]; lg[2] += hx * w0[2]; lg[3] += hx * w0[3]; lg[4] += hx * w1[0]; lg[5] += hx * w1[1]; lg[6] += hx * w1[2]; lg[7] += hx * w1[3]; }
#pragma unroll
                    for (int e = 0; e < 8; ++e) lg[e] = wave_sum(lg[e]);
                    int i1 = 0; float v1 = lg[0];
#pragma unroll
                    for (int e = 1; e < 8; ++e) if (lg[e] > v1) { v1 = lg[e]; i1 = e; }
                    int i2 = -1; float v2 = -3.0e38f;
#pragma unroll
                    for (int e = 0; e < 8; ++e) if (e != i1 && lg[e] > v2) { v2 = lg[e]; i2 = e; }
                    if (lane == 0) { const float g2 = 1.0f / (1.0f + __expf(v1 - v2)); TOPI[2 * m] = i1; TOPI[2 * m + 1] = i2; GATE[2 * m] = 1.0f - g2; GATE[2 * m + 1] = g2;
                        __hip_atomic_fetch_add(lcnt + i1, 1, __ATOMIC_RELAXED, __HIP_MEMORY_SCOPE_WORKGROUP); __hip_atomic_fetch_add(lcnt + i2, 1, __ATOMIC_RELAXED, __HIP_MEMORY_SCOPE_WORKGROUP); }
                }
            }
            if (l == 1) { __syncthreads(); if (tid < 8) WGCNT[bx * 8 + tid] = lcnt[tid]; }
            SEAM(P + 5);
        }
        if (l == 0) {
            if (PHEN(8) && IN(P + 6)) {
            PHASE_PROLOGUE
                pg8::Gemm g{H, (const bf16*)(ws + WS_W13), M, 2 * FF, D, nullptr}; pg8::StaticOrder S; S.init(M, 2 * FF, G, bx);
                pg8::EpiSwiGLU E{HID, FF};
                pg8::gemm_phase<pg8::EpiSwiGLU, pg8::StaticOrder, false>(lds, g, S, E);
                SEAM(P + 6);
            }
            if (PHEN(9) && IN(P + 7)) {
            PHASE_PROLOGUE
                pg8::Gemm g{HID, (const bf16*)(ws + WS_W2), M, D, FF, nullptr}; pg8::StaticOrder S; S.init(M, D, G, bx);
                pg8::EpiBf16 E{Y, D};
                pg8::gemm_phase<pg8::EpiBf16, pg8::StaticOrder, false>(lds, g, S, E);
                SEAM(P + 7);
            }
            if (PHEN(10) && IN(P + 8)) {
            PHASE_PROLOGUE
                const float* ng = INP(IN_NORMG) + (size_t)l * 4 * D; const float* ng1 = INP(IN_NORMG) + 4 * D;
                for (int r = 0; r < 16; ++r) { const int m = bx * 128 + wave * 16 + r, b = m / T;
                    const float* mod = mod_l + (size_t)b * 6 * D; const float* mod1 = MOD + (size_t)(8 + b) * 6 * D;
                    f32x4 yv[4], xv[4], gv[4], gt[4], hv[4];
                    ld_row_bf16(Y + (size_t)m * D, lane, yv); ld_row_f32(X + (size_t)m * D, lane, xv);
                    ld_row_f32(ng + 3 * D, lane, gv); ld_row_f32(mod + 5 * D, lane, gt);
                    const float rs = row_rstd(yv);
#pragma unroll
                    for (int j = 0; j < 4; ++j) xv[j] = xv[j] + gt[j] * (yv[j] * rs * gv[j]);
                    st_row_f32(X + (size_t)m * D, lane, xv);
                    modulate(xv, row_rstd(xv), ng1, mod1 + D, mod1, lane, hv);
                    st_row_bf16(H + (size_t)m * D, lane, hv); }
                SEAM(P + 8);
            }
        } else {
            if (PHEN(11) && IN(P + 6)) {
            PHASE_PROLOGUE
                LAS int* sh = (LAS int*)lds;
                if (tid < 8) { int tot = 0, before = 0; for (int w = 0; w < G; ++w) { const int c = WGCNT[w * 8 + tid]; if (w < bx) before += c; tot += c; } sh[24 + tid] = tot; sh[tid] = before; sh[8 + tid] = 0; }
                __syncthreads();
                if (tid == 0) { int ps = 0; for (int e = 0; e < 8; ++e) { sh[16 + e] = ps; ps += (sh[24 + e] + 255) / 256 * 256; }
                    if (bx == 0) { MOEINFO[0] = ps / 256; int blk = 0; for (int e = 0; e < 8; ++e) { const int nb = (sh[24 + e] + 255) / 256; for (int q = 0; q < nb; ++q) MOEINFO[8 + blk++] = e; } for (; blk < MOE_BLKS; ++blk) MOEINFO[8 + blk] = 7; } }
                __syncthreads();
                if (tid < 256) { const int tok = bx * 128 + (tid >> 1), e = TOPI[bx * 256 + tid];
                    const int rank = __hip_atomic_fetch_add(sh + 8 + e, 1, __ATOMIC_RELAXED, __HIP_MEMORY_SCOPE_WORKGROUP); const int dest = sh[16 + e] + sh[e] + rank;
                    DEST[bx * 256 + tid] = dest; ROWTOK[dest] = tok; }
                if (bx < 8 && tid < 256) { const int e = bx, cnt = sh[24 + e], pe = sh[16 + e] + (cnt + 255) / 256 * 256; const int d = sh[16 + e] + cnt + tid; if (d < pe) ROWTOK[d] = 0; }
                __syncthreads();
                LAS float* scr = (LAS float*)(lds + wave * 16384);
                const float* mw1 = INP(IN_MW1); const float* mw3 = INP(IN_MW3); const float* mw2 = INP(IN_MW2);
                for (int e = 0; e < NE; ++e) {
                    transpose_mat<1>(mw1 + (size_t)e * D * FF, D, FF, (bf16*)(ws + WS_WM13) + (size_t)e * 2 * FF * D, gw, NGW, scr, lane);
                    transpose_mat<2>(mw3 + (size_t)e * D * FF, D, FF, (bf16*)(ws + WS_WM13) + (size_t)e * 2 * FF * D, gw, NGW, scr, lane);
                    transpose_mat<0>(mw2 + (size_t)e * FF * D, FF, D, (bf16*)(ws + WS_WM2) + (size_t)e * D * FF, gw, NGW, scr, lane);
                }
                SEAM(P + 6);
            }
            for (int part = 0; part < NPART; ++part) {
                const int pm0 = part * PART_BLKS;
                if (PHEN(12) && IN(P + 7 + 2 * part)) {
            PHASE_PROLOGUE
                    const int nblk = MOEINFO[0]; const int nb = min(max(nblk - pm0, 0), PART_BLKS);
                    pg8::Gemm g{H, (const bf16*)(ws + WS_WM13), nb * 256, 2 * FF, D, ROWTOK}; pg8::MoeOrder S; S.init(nb * 256, 2 * FF, G, bx); S.blk_e = MOEINFO + 8; S.pm0 = pm0; S.apm0 = pm0; S.estride = (size_t)2 * FF * D * 2;
                    pg8::EpiSwiGLU E{(bf16*)(ws + WS_HIDM), FF};
                    pg8::gemm_phase<pg8::EpiSwiGLU, pg8::MoeOrder, true>(lds, g, S, E);
                    SEAM(P + 7 + 2 * part);
                }
                if (PHEN(13) && IN(P + 8 + 2 * part)) {
            PHASE_PROLOGUE
                    const int nblk = MOEINFO[0]; const int nb = min(max(nblk - pm0, 0), PART_BLKS);
                    pg8::Gemm g{(const bf16*)(ws + WS_HIDM), (const bf16*)(ws + WS_WM2), nb * 256, D, FF, nullptr}; pg8::MoeOrder S; S.init(nb * 256, D, G, bx); S.blk_e = MOEINFO + 8; S.pm0 = pm0; S.apm0 = 0; S.estride = (size_t)D * FF * 2;
                    pg8::EpiBf16 E{(bf16*)(ws + WS_YB) + (size_t)pm0 * 256 * D, D};
                    pg8::gemm_phase<pg8::EpiBf16, pg8::MoeOrder, false>(lds, g, S, E);
                    SEAM(P + 8 + 2 * part);
                }
            }
            if (PHEN(14) && IN(P + 13)) {
            PHASE_PROLOGUE
                const bf16* YB = (const bf16*)(ws + WS_YB); const float* ng = INP(IN_NORMG) + (size_t)l * 4 * D;
                for (int r = 0; r < 16; ++r) { const int m = bx * 128 + wave * 16 + r, b = m / T;
                    const float* mod = mod_l + (size_t)b * 6 * D;
                    const int d0 = DEST[2 * m], d1 = DEST[2 * m + 1]; const float g0 = GATE[2 * m], g1 = GATE[2 * m + 1];
                    f32x4 y0[4], y1[4], xv[4], gv[4], gt[4];
                    ld_row_bf16(YB + (size_t)d0 * D, lane, y0); ld_row_bf16(YB + (size_t)d1 * D, lane, y1); ld_row_f32(X + (size_t)m * D, lane, xv);
                    ld_row_f32(ng + 3 * D, lane, gv); ld_row_f32(mod + 5 * D, lane, gt);
#pragma unroll
                    for (int j = 0; j < 4; ++j) y0[j] = g0 * y0[j] + g1 * y1[j];
                    const float rs = row_rstd(y0);
#pragma unroll
                    for (int j = 0; j < 4; ++j) xv[j] = xv[j] + gt[j] * (y0[j] * rs * gv[j]);
                    st_row_f32(X + (size_t)m * D, lane, xv); }
            }
        }
}
__global__ void __launch_bounds__(NWAVES * 64, 2) skel_fwd(Args args) {
    extern __shared__ __attribute__((aligned(16))) unsigned char lds_raw[];
    LAS unsigned char* lds = (LAS unsigned char*)lds_raw;
    volatile LAS unsigned* MISC = (volatile LAS unsigned*)(lds + MISC_OFF);
    const int tid0 = threadIdx.x;
    const int G = gridDim.x, bx = blockIdx.x;
    const int vcu = (G % 8 == 0) ? (bx % 8) * (G / 8) + bx / 8 : bx;
    const int NGW = G * NWAVES;
    unsigned char* const ws0 = args.ws;
    unsigned* ctl = (unsigned*)(ws0 + WS_CTL);
    for (int u = tid0; u < 128; u += NWAVES * 64) ((LAS unsigned*)(lds + MISC_OFF))[u] = 0u;
    __syncthreads();
    XcdBarrier bar; bar.bar = ctl; bar.x = 0; bar.st = nullptr;
    if (MK_N_LAUNCHES == 1) bar = xcd_barrier_post(ctl, MISC + 8);
    const int lo = args.ph_lo, hi = args.ph_hi;


    if (PHEN(0) && IN(0)) {
            PHASE_PROLOGUE
        LAS float* scr = (LAS float*)(lds + wave * 16384);
        for (int l = 0; l < 2; ++l) {
            transpose_mat<0>(INP(IN_WIN) + (size_t)l * D * INW, D, INW, (bf16*)(ws + WS_WIN) + (size_t)l * ZW * D, gw, NGW, scr, lane);
            transpose_mat<0>(INP(IN_WOUT) + (size_t)l * D * D, D, D, (bf16*)(ws + WS_WOUT) + (size_t)l * D * D, gw, NGW, scr, lane);
            bf16* pad = (bf16*)(ws + WS_WIN) + (size_t)l * ZW * D + (size_t)INW * D;
            for (int i = gw * 64 + lane; i < (ZW - INW) * D / 8; i += NGW * 64) *(u32x4*)(pad + (size_t)i * 8) = (u32x4){0u, 0u, 0u, 0u};
        }
        transpose_mat<1>(INP(IN_FW1), D, FF, (bf16*)(ws + WS_W13), gw, NGW, scr, lane);
        transpose_mat<2>(INP(IN_FW3), D, FF, (bf16*)(ws + WS_W13), gw, NGW, scr, lane);
        transpose_mat<0>(INP(IN_FW2), FF, D, (bf16*)(ws + WS_W2), gw, NGW, scr, lane);
        __syncthreads();
        {
            LAS float* sc = (LAS float*)lds;
            LAS float* red = (LAS float*)(lds + 32768);
            bool have = false;
            for (int it = vcu; it < 2 * 48; it += G) {
                if (!have) { const float* cin = INP(IN_C); for (int i = tid; i < BATCH * D; i += NWAVES * 64) { const float c = cin[i]; sc[i] = c / (1.0f + __expf(-c)); } __syncthreads(); have = true; }
                const int l = it / 48, n = (it % 48) * 128 + (tid & 127), kq = tid >> 7;
                const float* w = INP(IN_ADAW) + (size_t)l * D * 6 * D + n;
                float a[8];
#pragma unroll
                for (int b = 0; b < 8; ++b) a[b] = 0.f;
                for (int k = kq * 256; k < kq * 256 + 256; ++k) { const float wv = w[(size_t)k * 6 * D];
#pragma unroll
                    for (int b = 0; b < 8; ++b) a[b] += sc[b * D + k] * wv; }
#pragma unroll
                for (int b = 0; b < 8; ++b) red[(kq * 8 + b) * 128 + (tid & 127)] = a[b];
                __syncthreads();
                if (kq == 0) {
#pragma unroll
                    for (int b = 0; b < 8; ++b) { const int c = tid & 127; const float s = red[(0 * 8 + b) * 128 + c] + red[(1 * 8 + b) * 128 + c] + red[(2 * 8 + b) * 128 + c] + red[(3 * 8 + b) * 128 + c];
                        MOD[((size_t)l * 8 + b) * 6 * D + n] = s + INP(IN_ADAB)[(size_t)l * 6 * D + n]; } }
                __syncthreads();
            }
        }
        SEAM(0);
    }
    if (PHEN(1) && IN(1)) {
            PHASE_PROLOGUE
        const float* x_in = INP(IN_X); const float* ng0 = INP(IN_NORMG);
        for (int r = 0; r < 16; ++r) { const int m = bx * 128 + wave * 16 + r, b = m / T;
            f32x4 xv[4], hv[4]; ld_row_f32(x_in + (size_t)m * D, lane, xv);
            const float* mod = MOD + (size_t)(0 * 8 + b) * 6 * D;
            modulate(xv, row_rstd(xv), ng0, mod + D, mod, lane, hv);
            st_row_bf16(H + (size_t)m * D, lane, hv); }
        SEAM(1);
    }
    layer_phases<0>(args, ws0, lds, vcu, G, bx, NGW, lo, hi, bar);
    layer_phases<1>(args, ws0, lds, vcu, G, bx, NGW, lo, hi, bar);
#undef IN
#undef SEAM
}
constexpr int N_PHASES = 2 + 16 + 14;

extern "C" void kernel_launch(void* const* d_in, const int* in_sizes, int n_in, void* d_out, int out_size, void* d_ws, size_t ws_size, hipStream_t stream) {
    static int grid = 0;
    if (grid == 0) {
        if (n_in != 29 || out_size != M * D || ws_size < WS_END) { fprintf(stderr, "kernel_launch: unexpected shapes (n_in %d out %d ws %zu)\n", n_in, out_size, ws_size); grid = -1; return; }
        int dev = 0, cus = 0;
        if (hipGetDevice(&dev) != hipSuccess || hipDeviceGetAttribute(&cus, hipDeviceAttributeMultiprocessorCount, dev) != hipSuccess) { grid = -1; return; }
        if (hipFuncSetAttribute((const void*)skel_fwd, hipFuncAttributeMaxDynamicSharedMemorySize, LDS_BYTES) != hipSuccess) { fprintf(stderr, "kernel_launch: hipFuncSetAttribute failed\n"); grid = -1; return; }
        int per_cu = 0;
        if (hipOccupancyMaxActiveBlocksPerMultiprocessor(&per_cu, (const void*)skel_fwd, NWAVES * 64, LDS_BYTES) != hipSuccess || per_cu < 1) fprintf(stderr, "kernel_launch: occupancy query reports %d\n", per_cu);
        (void)hipGetLastError();
        grid = cus;
        if (grid != 256) { fprintf(stderr, "kernel_launch: built for 256 CUs, found %d\n", grid); grid = 256; }
    }
    if (grid < 0) return;
    (void)hipMemsetAsync((char*)d_ws + WS_CTL, 0, CTL_ZERO_BYTES, stream);
    Args a{};
    for (int i = 0; i < 29; ++i) a.in[i] = (const float*)d_in[i];
    a.out = (float*)d_out; a.ws = (unsigned char*)d_ws;
    if (MK_N_LAUNCHES == 1) {
        a.ph_lo = 0; a.ph_hi = N_PHASES;
        hipLaunchKernelGGL(skel_fwd, dim3(grid), dim3(NWAVES * 64), LDS_BYTES, stream, a);
    } else {
        static const int phases[] = {0, 1, 2, 3, 4, 5, 6, 7, 8, 9, 10, 18, 19, 20, 21, 22, 23, 24, 25, 26, 27, 28, 29, 30, 31};
        for (int p : phases) { a.ph_lo = p; a.ph_hi = p + 1; hipLaunchKernelGGL(skel_fwd, dim3(grid), dim3(NWAVES * 64), LDS_BYTES, stream, a); }
    }
}
```

```cpp
#include <hip/hip_runtime.h>
#include <cstdio>
#include <cstdint>

#ifndef MK_N_LAUNCHES
#define MK_N_LAUNCHES 1
#endif

#define GAS __attribute__((address_space(1)))
#define LAS __attribute__((address_space(3)))
typedef unsigned short bf16;
typedef float f32x4 __attribute__((ext_vector_type(4)));
typedef float f32x2 __attribute__((ext_vector_type(2)));
typedef unsigned u32x4 __attribute__((ext_vector_type(4)));
typedef unsigned u32x2 __attribute__((ext_vector_type(2)));
typedef short bf16x8 __attribute__((ext_vector_type(8)));
typedef __bf16 bfx2 __attribute__((ext_vector_type(2)));
typedef short s16x4 __attribute__((ext_vector_type(4)));
typedef int i32x8 __attribute__((ext_vector_type(8)));
typedef int i32x4 __attribute__((ext_vector_type(4)));

constexpr int BATCH = 8, T = 4096, D = 1024, M = BATCH * T;
constexpr int GRID_W = 64, GW = 256;
constexpr int INW = 2688, ZW = 2816;
constexpr int FF = 3584, NE = 8;
constexpr int ZQ = 0, ZK = 256, ZV = 512, ZR = 768, ZLG = 1600, ZP = 1664, ZCB = 1920, ZCC = 2176, ZCH = 2432;
constexpr int RWS = 832;
constexpr float RMS_EPS = 1e-6f, LNX_EPS = 64e-5f;
constexpr int MOE_ROWS = 2 * M + NE * 256, MOE_BLKS = MOE_ROWS / 256;
constexpr int NPART = 1, PART_BLKS = MOE_BLKS;
constexpr float SC_H8 = 8.f, SC_W13 = 32.f, SC_W2 = 64.f, SC_HID = 4.f;

namespace pg8 {
typedef unsigned short bf16_t;
constexpr int BM = 256, BK = 64, HALF = 128, HTB = HALF * BK * 2, STAGE_BYTES = 8 * HTB, NXCD = 8, WGM = 8;
__host__ __device__ __forceinline__ int lds_byte(int r, int c) { const int st = (r >> 4) * 2 + (c >> 5), rr = r & 15, cc = c & 31, ob = rr * 64 + cc * 2; return st * 1024 + (ob ^ (((ob >> 9) & 1) << 5)); }
__host__ __device__ __forceinline__ void stage_rc(int b, int& R, int& C) { const int st = b / 1024, sb = b % 1024, swz = sb ^ (((sb >> 9) & 1) << 5); R = (st >> 1) * 16 + swz / 64; C = (st & 1) * 32 + (swz % 64) / 2; }
__host__ __device__ __forceinline__ int perm32(int rho) { const int n = rho >> 4, i = rho & 15; return 8 * (i >> 2) + 4 * n + (i & 3); }

struct Unit { int pm, pn; };
struct Gemm { const bf16_t* A; const bf16_t* Bt; int M, N, K; const int* rowtok; int ld; };

struct StaticOrder {
    int nM, nN, nwg, G, c;
    __device__ void init(int M_, int N_, int G_, int c_) { nM = M_ / BM; nN = N_ / BM; nwg = nM * nN; G = G_; c = c_; }
    __device__ bool next(int i, Unit& u) const {
        const long L = (long)i * G + c; if (L >= nwg) return false;
        int wgid = (int)L; { const int q = nwg / NXCD, r = nwg % NXCD, xcd = wgid % NXCD, off = wgid / NXCD; wgid = (xcd < r ? xcd * (q + 1) : r * (q + 1) + (xcd - r) * q) + off; }
        const int nig = WGM * nN, gid = wgid / nig, fm = gid * WGM, gsz = (nM - fm) < WGM ? (nM - fm) : WGM;
        u.pm = fm + ((wgid % nig) % gsz); u.pn = (wgid % nig) / gsz; return true;
    }
    __device__ __forceinline__ size_t b_off(const Unit& u, size_t tstep) const { return (size_t)u.pn * tstep; }
    __device__ __forceinline__ int a_blk(const Unit& u) const { return u.pm; }
};
struct MoeOrder : StaticOrder {
    const int* blk_e; int pm0, apm0; size_t estride;
    __device__ __forceinline__ size_t b_off(const Unit& u, size_t tstep) const { return (size_t)blk_e[pm0 + u.pm] * estride + (size_t)u.pn * tstep; }
    __device__ __forceinline__ int a_blk(const Unit& u) const { return apm0 + u.pm; }
};

struct TailOrder {
    const int* blk_e; int pm0, unit; bool has; size_t estride;
    __device__ bool next(int i, Unit& u) const { if (i > 0 || !has) return false; u.pm = unit >> 2; u.pn = unit & 3; return true; }
    __device__ __forceinline__ size_t b_off(const Unit& u, size_t tstep) const { return (size_t)blk_e[pm0 + u.pm] * estride + (size_t)u.pn * tstep; }
    __device__ __forceinline__ int a_blk(const Unit& u) const { return u.pm; }
};
__device__ __forceinline__ unsigned cvt_pk_bf16(float lo, float hi) { unsigned r; asm volatile("v_cvt_pk_bf16_f32 %0, %1, %2" : "=v"(r) : "v"(lo), "v"(hi)); return r; }

struct EpiBf16 {
    static constexpr bool PERM = true;
    bf16_t* O; int ldc; float scale;
    __device__ __forceinline__ void operator()(const f32x4 (&acc)[2][2][4][2], const Unit& u, int wr, int wc, int fr, int fq) const {
        const int row0 = u.pm * BM + wr * 64 + fr; const int col0 = u.pn * BM + wc * 32 + 8 * fq;
#pragma unroll
        for (int ai = 0; ai < 2; ++ai)
#pragma unroll
            for (int m = 0; m < 4; ++m) { bf16_t* rowp = O + (size_t)(row0 + ai * HALF + m * 16) * ldc + col0;
#pragma unroll
                for (int bj = 0; bj < 2; ++bj) { const f32x4 v0 = acc[ai][bj][m][0] * scale, v1 = acc[ai][bj][m][1] * scale;
                    u32x4 w; w.x = cvt_pk_bf16(v0[0], v0[1]); w.y = cvt_pk_bf16(v0[2], v0[3]); w.z = cvt_pk_bf16(v1[0], v1[1]); w.w = cvt_pk_bf16(v1[2], v1[3]);
                    *(u32x4*)(rowp + bj * HALF) = w; } }
    }
};
struct EpiSwiGLU {
    static constexpr bool PERM = true;
    bf16_t* O; int ldc;
    __device__ __forceinline__ void operator()(const f32x4 (&acc)[2][2][4][2], const Unit& u, int wr, int wc, int fr, int fq) const {
        const int row0 = u.pm * BM + wr * 64 + fr; const int col0 = u.pn * HALF + wc * 32 + 8 * fq;
#pragma unroll
        for (int ai = 0; ai < 2; ++ai)
#pragma unroll
            for (int m = 0; m < 4; ++m) { bf16_t* rowp = O + (size_t)(row0 + ai * HALF + m * 16) * ldc + col0;
                float h[8];
#pragma unroll
                for (int n = 0; n < 2; ++n)
#pragma unroll
                    for (int x = 0; x < 4; ++x) { const float a = acc[ai][0][m][n][x], b = acc[ai][1][m][n][x]; h[4 * n + x] = a * b * __builtin_amdgcn_rcpf(1.0f + __expf(-a)); }
                u32x4 w; w.x = cvt_pk_bf16(h[0], h[1]); w.y = cvt_pk_bf16(h[2], h[3]); w.z = cvt_pk_bf16(h[4], h[5]); w.w = cvt_pk_bf16(h[6], h[7]);
                *(u32x4*)rowp = w; }
    }
};

__device__ __forceinline__ unsigned cvt4_fp8(float a, float b, float c, float d) {
    a = fminf(fmaxf(a, -448.f), 448.f); b = fminf(fmaxf(b, -448.f), 448.f); c = fminf(fmaxf(c, -448.f), 448.f); d = fminf(fmaxf(d, -448.f), 448.f);
    int r = 0; r = __builtin_amdgcn_cvt_pk_fp8_f32(a, b, r, false); r = __builtin_amdgcn_cvt_pk_fp8_f32(c, d, r, true); return (unsigned)r; }
struct EpiSwiGLU8 {
    static constexpr bool PERM = true;
    unsigned char* O; int ldc; float in_scale, out_scale;
    __device__ __forceinline__ void operator()(const f32x4 (&acc)[2][2][4][2], const Unit& u, int wr, int wc, int fr, int fq) const {
        const int row0 = u.pm * BM + wr * 64 + fr; const int col0 = u.pn * HALF + wc * 32 + 8 * fq;
#pragma unroll
        for (int ai = 0; ai < 2; ++ai)
#pragma unroll
            for (int m = 0; m < 4; ++m) { unsigned char* rowp = O + (size_t)(row0 + ai * HALF + m * 16) * ldc + col0;
                float h[8];
#pragma unroll
                for (int n = 0; n < 2; ++n)
#pragma unroll
                    for (int x = 0; x < 4; ++x) { const float a = acc[ai][0][m][n][x] * in_scale, b = acc[ai][1][m][n][x] * in_scale; h[4 * n + x] = out_scale * a * b * __builtin_amdgcn_rcpf(1.0f + __expf(-a)); }
                u32x2 w; w.x = cvt4_fp8(h[0], h[1], h[2], h[3]); w.y = cvt4_fp8(h[4], h[5], h[6], h[7]);
                *(u32x2*)rowp = w; }
    }
};

template <class Epi, class Sched, bool GATHER, bool FP8 = false>
__device__ __forceinline__ void gemm_phase(LAS unsigned char* lds, const Gemm g, const Sched& S, const Epi& E) {
    int tid_ = threadIdx.x; asm volatile("" : "+v"(tid_));
    const int tid = tid_, wid = __builtin_amdgcn_readfirstlane(tid >> 6), lane = tid & 63, wr = wid >> 2, wc = wid & 3, fr = lane & 15, fq = lane >> 4;
    const int K = g.ld ? g.ld : g.K, nt = g.K / BK;
    const size_t kstep = (size_t)(BK * 2);
    const size_t hstep = (size_t)HALF * K * 2;
    const size_t tstep = 2 * hstep;
    unsigned voffB[2], voffA0[2];
#pragma unroll
    for (int i = 0; i < 2; ++i) { int R, C; stage_rc(tid * 16 + i * 8192, R, C); const int Rb = Epi::PERM ? ((R & ~31) + perm32(R & 31)) : R;
        voffA0[i] = (unsigned)(R * K + C) * 2u; voffB[i] = (unsigned)(Rb * K + C) * 2u; }
    const unsigned ldsw = (unsigned)wid * 1024u;
    const int aoff = lds_byte(wr * 64 + fr, fq * 8), boff = lds_byte(wc * 32 + fr, fq * 8);
#define PG8_SA(b, h) (((b) * 2 + (h)) * HTB)
#define PG8_SB(b, h) ((4 + (b) * 2 + (h)) * HTB)
#define PG8_STAGE(bufoff, gbase, voff) do { _Pragma("unroll") for (int _i = 0; _i < 2; ++_i) \
        __builtin_amdgcn_global_load_lds((const unsigned*)((const char*)(gbase) + (voff)[_i]), (LAS unsigned*)(lds + (bufoff) + ldsw + _i * 8192), 16, 0, 0); } while (0)
#define PG8_LDA(dst, b, h) do { _Pragma("unroll") for (int m = 0; m < 4; ++m) dst[m] = __builtin_shufflevector(*(const LAS i32x4*)(lds + PG8_SA(b, h) + aoff + m * 2048), *(const LAS i32x4*)(lds + PG8_SA(b, h) + aoff + m * 2048 + 1024), 0, 1, 2, 3, 4, 5, 6, 7); } while (0)
#define PG8_LDB(dst, b, h) do { _Pragma("unroll") for (int n = 0; n < 2; ++n) dst[n] = __builtin_shufflevector(*(const LAS i32x4*)(lds + PG8_SB(b, h) + boff + n * 2048), *(const LAS i32x4*)(lds + PG8_SB(b, h) + boff + n * 2048 + 1024), 0, 1, 2, 3, 4, 5, 6, 7); } while (0)
#define PG8_MMA(ai, bj, At, Bt) do { __builtin_amdgcn_s_setprio(1); _Pragma("unroll") for (int m = 0; m < 4; ++m) _Pragma("unroll") for (int n = 0; n < 2; ++n) { \
        if constexpr (FP8) { asm volatile("v_mfma_scale_f32_16x16x128_f8f6f4 %0, %1, %2, %0, %3, %3 op_sel_hi:[0,0,0]" : "+v"(acc[ai][bj][m][n]) : "v"(Bt[n]), "v"(At[m]), "v"(sc1)); } \
        else { acc[ai][bj][m][n] = __builtin_amdgcn_mfma_f32_16x16x32_bf16(__builtin_bit_cast(bf16x8, __builtin_shufflevector(Bt[n], Bt[n], 0, 1, 2, 3)), __builtin_bit_cast(bf16x8, __builtin_shufflevector(At[m], At[m], 0, 1, 2, 3)), acc[ai][bj][m][n], 0, 0, 0); \
               acc[ai][bj][m][n] = __builtin_amdgcn_mfma_f32_16x16x32_bf16(__builtin_bit_cast(bf16x8, __builtin_shufflevector(Bt[n], Bt[n], 4, 5, 6, 7)), __builtin_bit_cast(bf16x8, __builtin_shufflevector(At[m], At[m], 4, 5, 6, 7)), acc[ai][bj][m][n], 0, 0, 0); } } \
        __builtin_amdgcn_s_setprio(0); } while (0)
#define PG8_WAIT_V(n) asm volatile("s_waitcnt vmcnt(" #n ")" ::: "memory")
#define PG8_WAIT_L(n) asm volatile("s_waitcnt lgkmcnt(" #n ")" ::: "memory")
#define PG8_BAR __builtin_amdgcn_s_barrier()
#define PG8_SCHED __builtin_amdgcn_sched_barrier(0)
#define PG8_AOFFS(dst, u) do { if constexpr (GATHER) { const int _rb = S.a_blk(u) * BM; int _t2 = tid; asm volatile("" : "+v"(_t2)); \
            _Pragma("unroll") for (int _h = 0; _h < 2; ++_h) _Pragma("unroll") for (int _i = 0; _i < 2; ++_i) { int _R, _C; stage_rc(_t2 * 16 + _i * 8192, _R, _C); \
            dst[_h][_i] = (unsigned)(g.rowtok[_rb + _h * HALF + _R] * K + _C) * 2u; } } } while (0)
#define PG8_STAGEA(bufoff, gbase, h, NX) do { _Pragma("unroll") for (int _i = 0; _i < 2; ++_i) { \
        const unsigned _o = GATHER ? (((NX) && last) ? vAn[h][_i] : vA[h][_i]) : (voffA0[_i] + (unsigned)((h) * hstep)); \
        __builtin_amdgcn_global_load_lds((const unsigned*)((const char*)(gbase) + _o), (LAS unsigned*)(lds + (bufoff) + ldsw + _i * 8192), 16, 0, 0); } } while (0)
#define PG8_ABASE(u) ((const char*)g.A + (GATHER ? (size_t)0 : (size_t)S.a_blk(u) * tstep))
    Unit cur, nxt; int ui = 0;
    if (!S.next(0, cur)) return;
    f32x4 acc[2][2][4][2];
#pragma unroll
    for (int a = 0; a < 2; ++a)
#pragma unroll
        for (int b = 0; b < 2; ++b)
#pragma unroll
            for (int m = 0; m < 4; ++m)
#pragma unroll
                for (int n = 0; n < 2; ++n) acc[a][b][m][n] = (f32x4){0.f, 0.f, 0.f, 0.f};
    i32x8 At[4], B0[2], B1[2]; const int sc1 = 0x7f7f7f7f; (void)sc1;
    unsigned vA[2][2], vAn[2][2]; const bool last = false;
    PG8_AOFFS(vA, cur);
    const char* cA = PG8_ABASE(cur); const char* cB = (const char*)g.Bt + S.b_off(cur, tstep);
    PG8_STAGE(PG8_SB(0, 0), cB, voffB); PG8_STAGE(PG8_SB(0, 1), cB + hstep, voffB); PG8_STAGEA(PG8_SA(0, 0), cA, 0, false); PG8_STAGEA(PG8_SA(0, 1), cA, 1, false);
    if (wr == 1) PG8_BAR;
    PG8_WAIT_V(2); PG8_BAR;
    PG8_STAGE(PG8_SB(1, 0), cB + kstep, voffB); PG8_STAGEA(PG8_SA(1, 0), cA + kstep, 0, false); PG8_STAGE(PG8_SB(1, 1), cB + hstep + kstep, voffB);
    PG8_WAIT_V(6); PG8_BAR;
    for (;;) {
        const bool has_next = S.next(ui + 1, nxt);
        const char* nA = cA; const char* nB = cB;
        if (has_next) { nA = PG8_ABASE(nxt); nB = (const char*)g.Bt + S.b_off(nxt, tstep); PG8_AOFFS(vAn, nxt); }
        else if constexpr (GATHER) {
#pragma unroll
            for (int h = 0; h < 2; ++h)
#pragma unroll
                for (int i = 0; i < 2; ++i) vAn[h][i] = vA[h][i]; }
        for (int t = 0; t < nt; t += 2) {
            const bool last = (t == nt - 2);
            const char* a1 = cA + (size_t)(t + 1) * kstep;
            const char* a2 = last ? nA : cA + (size_t)(t + 2) * kstep; const char* b2 = last ? nB : cB + (size_t)(t + 2) * kstep;
            const char* a3 = a2 + kstep; const char* b3 = b2 + kstep;
            PG8_LDB(B0, 0, 0); PG8_LDB(B1, 0, 1); PG8_SCHED; PG8_LDA(At, 0, 0); PG8_STAGEA(PG8_SA(1, 1), a1, 1, false);
            PG8_WAIT_V(8); PG8_WAIT_L(0); PG8_BAR; PG8_MMA(0, 0, At, B0); PG8_MMA(0, 1, At, B1); PG8_BAR; PG8_SCHED;
            PG8_LDA(At, 0, 1); PG8_STAGE(PG8_SB(0, 0), b2, voffB); PG8_STAGE(PG8_SB(0, 1), b2 + hstep, voffB); PG8_STAGEA(PG8_SA(0, 0), a2, 0, true);
            PG8_WAIT_V(8); PG8_WAIT_L(0); PG8_BAR; PG8_MMA(1, 0, At, B0); PG8_MMA(1, 1, At, B1); PG8_BAR; PG8_SCHED;
            PG8_LDB(B0, 1, 0); PG8_LDB(B1, 1, 1); PG8_SCHED; PG8_LDA(At, 1, 0); PG8_STAGEA(PG8_SA(0, 1), a2, 1, true);
            PG8_WAIT_V(8); PG8_WAIT_L(0); PG8_BAR; PG8_MMA(0, 0, At, B0); PG8_MMA(0, 1, At, B1); PG8_BAR; PG8_SCHED;
            PG8_LDA(At, 1, 1); PG8_STAGE(PG8_SB(1, 0), b3, voffB); PG8_STAGE(PG8_SB(1, 1), b3 + hstep, voffB); PG8_STAGEA(PG8_SA(1, 0), a3, 0, true);
            PG8_WAIT_V(8); PG8_WAIT_L(0); PG8_BAR; PG8_MMA(1, 0, At, B0); PG8_MMA(1, 1, At, B1); PG8_BAR; PG8_SCHED;
        }
        if (wr == 0) PG8_BAR;
        E(acc, cur, wr, wc, fr, fq);
        if (!has_next) break;
#pragma unroll
        for (int a = 0; a < 2; ++a)
#pragma unroll
            for (int b = 0; b < 2; ++b)
#pragma unroll
                for (int m = 0; m < 4; ++m)
#pragma unroll
                    for (int n = 0; n < 2; ++n) acc[a][b][m][n] = (f32x4){0.f, 0.f, 0.f, 0.f};
        cur = nxt; cA = nA; cB = nB; ++ui;
        if constexpr (GATHER) {
#pragma unroll
        for (int h = 0; h < 2; ++h)
#pragma unroll
            for (int i = 0; i < 2; ++i) vA[h][i] = vAn[h][i]; }
        if (wr == 1) PG8_BAR;
    }
    PG8_WAIT_V(0);
    PG8_BAR;
#undef PG8_SA
#undef PG8_SB
#undef PG8_STAGE
#undef PG8_LDA
#undef PG8_LDB
#undef PG8_MMA
#undef PG8_WAIT_V
#undef PG8_WAIT_L
#undef PG8_BAR
#undef PG8_SCHED
#undef PG8_AOFFS
#undef PG8_STAGEA
#undef PG8_ABASE
}
}

constexpr size_t MiB = 1u << 20;
constexpr size_t WS_CTL = 0, CTL_ZERO_BYTES = 64 * 1024;
constexpr size_t WS_MOD = 1 * MiB;
constexpr size_t WS_TOPI = 2 * MiB;
constexpr size_t WS_GATE = 2 * MiB + 512 * 1024;
constexpr size_t WS_DEST = 3 * MiB;
constexpr size_t WS_ROWTOK = 3 * MiB + 512 * 1024;
constexpr size_t WS_WGCNT = 4 * MiB;
constexpr size_t WS_MOEINFO = 4 * MiB + 64 * 1024;
constexpr size_t WS_SLAB = 8 * MiB;
constexpr size_t WS_WIN = 8 * MiB;
constexpr size_t WS_WOUT = 20 * MiB;
constexpr size_t WS_W13 = 24 * MiB;
constexpr size_t WS_W2 = 38 * MiB;
constexpr size_t WS_H = 48 * MiB;
constexpr size_t ARENA = 112 * MiB;
constexpr size_t WS_Z = ARENA;
constexpr size_t WS_YCAT = ARENA + 176 * MiB;
constexpr size_t WS_SCAN = ARENA + 240 * MiB;
constexpr size_t WS_CH = ARENA + 240 * MiB;
constexpr size_t WS_BONUS = ARENA + 432 * MiB;
constexpr size_t WS_SLG = ARENA + 448 * MiB;
constexpr size_t WS_Y = ARENA;
constexpr size_t WS_HID = ARENA + 64 * MiB;
constexpr size_t WS_WM13 = ARENA + 368 * MiB;
constexpr size_t WS_WM2 = ARENA + 424 * MiB;
constexpr size_t WS_YB = ARENA;
constexpr size_t WS_HIDM = ARENA + 132 * MiB;
constexpr size_t WS_END = ARENA + 454 * MiB;
static_assert(WS_SCAN + (size_t)2 * 8 * 4 * T * 384 * 2 <= WS_END && WS_HID + (size_t)M * FF * 2 <= WS_END && WS_HIDM + (size_t)PART_BLKS * 256 * FF <= WS_END, "ws map");
static_assert(WS_YB + (size_t)MOE_ROWS * D * 2 <= WS_HIDM && WS_HIDM + (size_t)PART_BLKS * 256 * FF <= WS_WM13 && WS_WM13 + (size_t)NE * 2 * FF * D <= WS_WM2 && WS_WM2 + (size_t)NE * D * FF <= WS_END && WS_CH + (size_t)4096 * 16384 * 2 <= WS_WM13, "ws map 2");

constexpr int LDS_BYTES = 163840;
constexpr int SCR_BYTES = 163840 - 512;
constexpr int MISC_OFF = SCR_BYTES;
constexpr int NWAVES = 8;

#define LDS_WAIT() asm volatile("s_waitcnt lgkmcnt(0)" ::: "memory")
#define VM_WAIT() asm volatile("s_waitcnt vmcnt(0)" ::: "memory")
__device__ __forceinline__ unsigned f2bf(float f) { return (unsigned)__builtin_bit_cast(unsigned short, (__bf16)f); }
__device__ __forceinline__ unsigned pk2(float lo, float hi) { bfx2 v; v[0] = (__bf16)lo; v[1] = (__bf16)hi; return __builtin_bit_cast(unsigned, v); }
__device__ __forceinline__ float bf2f(unsigned b) { return __builtin_bit_cast(float, b << 16); }
__device__ __forceinline__ float bflo(unsigned u) { return __builtin_bit_cast(float, u << 16); }
__device__ __forceinline__ float bfhi(unsigned u) { return __builtin_bit_cast(float, u & 0xffff0000u); }
__device__ __forceinline__ float row16_sum(float v);
__device__ __forceinline__ float wave_sum(float v) {
    const int r = __builtin_bit_cast(int, row16_sum(v));
    const float s0 = __builtin_bit_cast(float, __builtin_amdgcn_readlane(r, 0)), s1 = __builtin_bit_cast(float, __builtin_amdgcn_readlane(r, 16)),
                s2 = __builtin_bit_cast(float, __builtin_amdgcn_readlane(r, 32)), s3 = __builtin_bit_cast(float, __builtin_amdgcn_readlane(r, 48));
    return (s0 + s1) + (s2 + s3);
}
__device__ __forceinline__ float row16_sum(float v) {
    v += __builtin_bit_cast(float, __builtin_amdgcn_update_dpp(0, __builtin_bit_cast(int, v), 0x128, 0xf, 0xf, false));
    v += __builtin_bit_cast(float, __builtin_amdgcn_update_dpp(0, __builtin_bit_cast(int, v), 0x124, 0xf, 0xf, false));
    v += __builtin_bit_cast(float, __builtin_amdgcn_update_dpp(0, __builtin_bit_cast(int, v), 0x122, 0xf, 0xf, false));
    v += __builtin_bit_cast(float, __builtin_amdgcn_update_dpp(0, __builtin_bit_cast(int, v), 0x121, 0xf, 0xf, false));
    return v;
}
__device__ __forceinline__ float sigmoidf_(float x) { return __builtin_amdgcn_rcpf(1.0f + __expf(-x)); }

#define XB_TMO      128
#define XB_XCNT(j)  (256  + 64 * (j))
#define XB_XSUB(j)  (1280 + 64 * (j))
#define XB_XGEN(j)  (2304 + 64 * (j))
#define XB_TOP      3328
#define XB_TOPGEN   3392
#define XCD_BAR_WORDS 3456
#define XB_SPIN_CAP (1u << 22)
__device__ __forceinline__ unsigned xb_ld(unsigned* p)              { return __hip_atomic_load(p, __ATOMIC_RELAXED, __HIP_MEMORY_SCOPE_AGENT); }
__device__ __forceinline__ unsigned xb_add(unsigned* p, unsigned v) { return __hip_atomic_fetch_add(p, v, __ATOMIC_RELAXED, __HIP_MEMORY_SCOPE_AGENT); }
__device__ __forceinline__ unsigned xb_xcc_id() { return (unsigned)__builtin_amdgcn_s_getreg((3 << 11) | 20) & 0xFu; }
#define XB_SPIN(cond, bar) do { unsigned _sp = 0; while (cond) { __builtin_amdgcn_s_sleep(1); \
    if ((++_sp & 255u) == 0u) { if (xb_ld(&(bar)[XB_TMO])) break; if (_sp > XB_SPIN_CAP) { atomicAdd(&(bar)[XB_TMO], 1u); break; } } } } while (0)
struct XcdBarrier { unsigned* bar; unsigned x; volatile LAS unsigned* st; };
__device__ __forceinline__ XcdBarrier xcd_barrier_post(unsigned* bar, volatile LAS unsigned* st) {
    XcdBarrier b; b.bar = bar; b.x = xb_xcc_id(); b.st = st;
    if (threadIdx.x == 0) (void)xb_add(&bar[XB_XCNT(b.x)], 1u);
    return b;
}
__device__ __forceinline__ void xcd_barrier_complete(unsigned* bar, unsigned x, unsigned& nloc, unsigned& nx) {
    const unsigned G = gridDim.x * gridDim.y * gridDim.z;
    unsigned sum, cnt, mine, sp = 0u;
    for (;;) {
        sum = 0u; cnt = 0u; mine = 0u;
#pragma unroll
        for (unsigned j = 0; j < 16; ++j) { const unsigned c = xb_ld(&bar[XB_XCNT(j)]); sum += c; cnt += (c > 0u) ? 1u : 0u; mine = (j == x) ? c : mine; }
        if (sum == G) break;
        __builtin_amdgcn_s_sleep(1);
        if ((++sp & 255u) == 0u) { if (xb_ld(&bar[XB_TMO])) break; if (sp > XB_SPIN_CAP) { atomicAdd(&bar[XB_TMO], 1u); break; } }
    }
    nloc = mine > 0u ? mine : 1u; nx = cnt > 0u ? cnt : 1u;
}
__device__ __forceinline__ void xcd_barrier(const XcdBarrier& b) {
    asm volatile("s_waitcnt vmcnt(0)" ::: "memory");
    __syncthreads();
    if (threadIdx.x == 0) {
        unsigned* bar = b.bar;
        __builtin_amdgcn_s_waitcnt(0);
        unsigned nloc = b.st[0], nx = b.st[1];
        if (nloc == 0u) { xcd_barrier_complete(bar, b.x, nloc, nx); b.st[0] = nloc; b.st[1] = nx; }
        const unsigned old = xb_add(&bar[XB_XSUB(b.x)], 1u);
        const unsigned gen = old / nloc;
        if (old + 1u == (gen + 1u) * nloc) {
            __builtin_amdgcn_fence(__ATOMIC_RELEASE, "agent");
            asm volatile("s_waitcnt vmcnt(0)" ::: "memory");
            const unsigned og = xb_add(&bar[XB_TOP], 1u);
            const unsigned tg = og / nx;
            if (og + 1u == (tg + 1u) * nx) xb_add(&bar[XB_TOPGEN], 1u);
            else XB_SPIN(xb_ld(&bar[XB_TOPGEN]) == tg, bar);
            __builtin_amdgcn_fence(__ATOMIC_ACQUIRE, "agent");
            xb_add(&bar[XB_XGEN(b.x)], 1u);
            asm volatile("s_waitcnt vmcnt(0)" ::: "memory");
        } else {
            XB_SPIN(xb_ld(&bar[XB_XGEN(b.x)]) == gen, bar);
            __builtin_amdgcn_fence(__ATOMIC_ACQUIRE, "agent");
            asm volatile("s_waitcnt vmcnt(0)" ::: "memory");
        }
    }
    __syncthreads();
}

struct Args { const float* in[29]; float* out; unsigned char* ws; int ph_lo, ph_hi, sub, pad; };
enum { IN_X = 0, IN_C, IN_ADAW, IN_ADAB, IN_NORMG, IN_WIN, IN_WOUT, IN_RPB, IN_MU, IN_W0, IN_W2L, IN_A0, IN_A2L, IN_KK, IN_KA, IN_RK, IN_LNW, IN_LNB, IN_G2,
       IN_POOLW, IN_POOLS, IN_CONVW, IN_FW1, IN_FW3, IN_FW2, IN_ROUTER, IN_MW1, IN_MW3, IN_MW2 };

__device__ __forceinline__ void transpose_item(const float* W, int K, int N, bf16* WT, int drow0, int k0, int n0, LAS float* scr, int lane) {
#pragma unroll 8
    for (int i = 0; i < 32; ++i) { const int kk = 2 * i + (lane >> 5); scr[kk * 33 + (lane & 31)] = W[(size_t)(k0 + kk) * N + n0 + (lane & 31)]; }
    LDS_WAIT(); asm volatile("" ::: "memory");
    const int c = lane & 7;
#pragma unroll
    for (int j = 0; j < 4; ++j) { const int n = (lane >> 3) + 8 * j; const LAS float* s = scr + (8 * c) * 33 + n;
        u32x4 o; o.x = pk2(s[0 * 33], s[1 * 33]); o.y = pk2(s[2 * 33], s[3 * 33]); o.z = pk2(s[4 * 33], s[5 * 33]); o.w = pk2(s[6 * 33], s[7 * 33]);
        *(u32x4*)(WT + (size_t)(drow0 + n) * K + k0 + 8 * c) = o; }
    LDS_WAIT(); asm volatile("" ::: "memory");
}
__device__ __forceinline__ void transpose_item8(const float* W, int K, int N, unsigned char* WT, int drow0, int k0, int n0, LAS float* scr, int lane, float sc) {
#pragma unroll 8
    for (int i = 0; i < 32; ++i) { const int kk = 2 * i + (lane >> 5); scr[kk * 33 + (lane & 31)] = W[(size_t)(k0 + kk) * N + n0 + (lane & 31)]; }
    LDS_WAIT(); asm volatile("" ::: "memory");
    const int c = lane & 7;
#pragma unroll
    for (int j = 0; j < 4; ++j) { const int n = (lane >> 3) + 8 * j; const LAS float* s = scr + (8 * c) * 33 + n;
        u32x2 o; o.x = pg8::cvt4_fp8(s[0 * 33] * sc, s[1 * 33] * sc, s[2 * 33] * sc, s[3 * 33] * sc); o.y = pg8::cvt4_fp8(s[4 * 33] * sc, s[5 * 33] * sc, s[6 * 33] * sc, s[7 * 33] * sc);
        *(u32x2*)(WT + (size_t)(drow0 + n) * K + k0 + 8 * c) = o; }
    LDS_WAIT(); asm volatile("" ::: "memory");
}
template <int MODE> __device__ __forceinline__ void transpose_mat8(const float* W, int K, int N, unsigned char* WT, int gw, int NGW, LAS float* scr, int lane, float sc) {
    const int nblk = N / 32, nitems = (K / 64) * nblk;
    for (int it = gw; it < nitems; it += NGW) { const int kb = it / nblk, nb = it % nblk, n0 = 32 * nb;
        const int drow0 = MODE == 0 ? n0 : (256 * (n0 >> 7) + (n0 & 127) + (MODE == 2 ? 128 : 0));
        transpose_item8(W, K, N, WT, drow0, 64 * kb, n0, scr, lane, sc); }
}
template <int MODE> __device__ __forceinline__ void transpose_mat(const float* W, int K, int N, bf16* WT, int gw, int NGW, LAS float* scr, int lane) {
    const int nblk = N / 32, nitems = (K / 64) * nblk;
    for (int it = gw; it < nitems; it += NGW) { const int kb = it / nblk, nb = it % nblk, n0 = 32 * nb;
        const int drow0 = MODE == 0 ? n0 : (256 * (n0 >> 7) + (n0 & 127) + (MODE == 2 ? 128 : 0));
        transpose_item(W, K, N, WT, drow0, 64 * kb, n0, scr, lane); }
}

__device__ __forceinline__ void ld_row_f32(const float* p, int lane, f32x4 (&v)[4]) {
#pragma unroll
    for (int j = 0; j < 4; ++j) v[j] = *(const f32x4*)(p + 4 * lane + 256 * j);
}
__device__ __forceinline__ void ld_row_bf16(const bf16* p, int lane, f32x4 (&v)[4]) {
#pragma unroll
    for (int j = 0; j < 4; ++j) { const u32x2 u = *(const u32x2*)(p + 4 * lane + 256 * j); v[j] = (f32x4){bflo(u.x), bfhi(u.x), bflo(u.y), bfhi(u.y)}; }
}
__device__ __forceinline__ void ld_moe_row(const bf16* YB, const bf16* SLAB, int d, int lane, f32x4 (&v)[4]) {
    if (d < 256 * 256) { ld_row_bf16(YB + (size_t)d * D, lane, v); }
    else { const bf16* p = SLAB + (size_t)(d - 256 * 256) * D; ld_row_bf16(p, lane, v);
#pragma unroll 1
        for (int sl = 1; sl < 7; ++sl) { f32x4 t[4]; ld_row_bf16(p + (size_t)sl * 8 * 256 * D, lane, t);
#pragma unroll
            for (int j = 0; j < 4; ++j) v[j] = v[j] + t[j]; } }
}
__device__ __forceinline__ void st_row_bf16(bf16* p, int lane, const f32x4 (&v)[4]) {
#pragma unroll
    for (int j = 0; j < 4; ++j) { u32x2 u; u.x = pk2(v[j][0], v[j][1]); u.y = pk2(v[j][2], v[j][3]); *(u32x2*)(p + 4 * lane + 256 * j) = u; }
}
__device__ __forceinline__ void st_row_f32(float* p, int lane, const f32x4 (&v)[4]) {
#pragma unroll
    for (int j = 0; j < 4; ++j) *(f32x4*)(p + 4 * lane + 256 * j) = v[j];
}
__device__ __forceinline__ float row_rstd(const f32x4 (&v)[4]) {
    float s = 0.f;
#pragma unroll
    for (int j = 0; j < 4; ++j) s += (v[j][0] * v[j][0] + v[j][1] * v[j][1]) + (v[j][2] * v[j][2] + v[j][3] * v[j][3]);
    return 1.0f / sqrtf(wave_sum(s) * (1.0f / D) + RMS_EPS);
}
__device__ __forceinline__ void modulate(const f32x4 (&x)[4], float rstd, const float* g, const float* sc, const float* sh, int lane, f32x4 (&h)[4]) {
    f32x4 gv[4], scv[4], shv[4]; ld_row_f32(g, lane, gv); ld_row_f32(sc, lane, scv); ld_row_f32(sh, lane, shv);
#pragma unroll
    for (int j = 0; j < 4; ++j) h[j] = x[j] * rstd * gv[j] * (1.0f + scv[j]) + shv[j];
}

__device__ __forceinline__ const float* inp_ptr(const Args& a, int i) { asm volatile("" : "+s"(i)); return a.in[i]; }
#define INP(i) inp_ptr(args, (i))
#define mod_l (MOD + (size_t)l * 8 * 6 * D)
#define PHASE_PROLOGUE \
    int tid_l = threadIdx.x; asm volatile("" : "+v"(tid_l)); const int tid = tid_l, lane = tid & 63, wave = __builtin_amdgcn_readfirstlane(tid >> 6), gw = vcu * NWAVES + wave; (void)lane; (void)wave; (void)gw; (void)tid; \
    size_t zofs_ = 0; asm volatile("" : "+s"(zofs_)); unsigned char* const ws = ws0 + zofs_; float* const X = (float*)((unsigned char*)args.out + zofs_);   \
    float* const MOD = (float*)(ws + WS_MOD); bf16* const H = (bf16*)(ws + WS_H); float* const YS = (float*)(ws + WS_H); bf16* const Z = (bf16*)(ws + WS_Z); bf16* const YCAT = (bf16*)(ws + WS_YCAT); \
    bf16* const SCAN = (bf16*)(ws + WS_SCAN); bf16* const Y = (bf16*)(ws + WS_Y); bf16* const HID = (bf16*)(ws + WS_HID); int* const TOPI = (int*)(ws + WS_TOPI); float* const GATE = (float*)(ws + WS_GATE); \
    int* const DEST = (int*)(ws + WS_DEST); int* const ROWTOK = (int*)(ws + WS_ROWTOK); int* const WGCNT = (int*)(ws + WS_WGCNT); int* const MOEINFO = (int*)(ws + WS_MOEINFO); \
    bf16* const CH = (bf16*)(ws + WS_CH); bf16* const BONUS = (bf16*)(ws + WS_BONUS); bf16* const SLG = (bf16*)(ws + WS_SLG); (void)CH; (void)BONUS; (void)SLG; \
    (void)X; (void)MOD; (void)H; (void)YS; (void)Z; (void)YCAT; (void)SCAN; (void)Y; (void)HID; (void)TOPI; (void)GATE; (void)DEST; (void)ROWTOK; (void)WGCNT; (void)MOEINFO;
#ifndef PH_MASK
#define PH_MASK 0xffff
#endif
#define PHEN(i) (((PH_MASK) >> (i)) & 1)
#ifndef SUB_MASK
#define SUB_MASK 7
#endif
#define SUBEN(i) (((SUB_MASK) >> (i)) & 1)
#define IN(k) (lo <= (k) && (k) < hi)
#define SEAM(k) do { if (MK_N_LAUNCHES == 1 && IN((k) + 1)) xcd_barrier(bar); } while (0)
__device__ __forceinline__ void load_rowvecs(const float* g_a, const float* gate, const float* g_b, const float* sc, const float* sh, int lane, f32x4 (&a1)[4], f32x4 (&bv)[4], f32x4 (&cv)[4]) {
#pragma unroll
    for (int j = 0; j < 4; ++j) { const int o = 4 * lane + 256 * j; const f32x4 ga = *(const f32x4*)(g_a + o), gt = *(const f32x4*)(gate + o), gb = *(const f32x4*)(g_b + o), s = *(const f32x4*)(sc + o);
        a1[j] = ga * gt; bv[j] = gb * (1.0f + s); cv[j] = *(const f32x4*)(sh + o); }
}
template <int l> __device__ __forceinline__ void layer_phases(const Args& args, unsigned char* const ws0, LAS unsigned char* lds, const int vcu, const int G, const int bx, const int NGW, const int lo, const int hi, const XcdBarrier& bar) {
        const int P = 2 + 16 * l;
        if (PHEN(2) && IN(P + 0)) {
            PHASE_PROLOGUE
            pg8::Gemm g{H, (const bf16*)(ws + WS_WIN) + (size_t)l * ZW * D, M, ZW, D, nullptr, 0}; pg8::StaticOrder S; S.init(M, ZW, G, bx);
            pg8::EpiBf16 E{Z, ZW, 1.0f};
            pg8::gemm_phase<pg8::EpiBf16, pg8::StaticOrder, false>(lds, g, S, E);
            SEAM(P + 0);
        }
        if (PHEN(3) && IN(P + 1)) {
            PHASE_PROLOGUE
            if (SUBEN(0) && (args.sub & 1)) {
                LAS unsigned char* Ks = lds; LAS unsigned char* Vs = lds + 65536;
                LAS float* rp = (LAS float*)(lds + 131072);
                LAS float* xch = (LAS float*)(lds + 131072 + 2048);
                const float* rpb = INP(IN_RPB) + (size_t)l * 4 * 15 * 31;
                const int qt = wave & 3, half = wave >> 2, r16 = lane & 15, kq = lane >> 4;
                const int q = qt * 16 + r16;
                const int c0 = (qt == 0) ? 0 : (qt == 1) ? 8 : (qt == 2) ? 24 : 32;
                const int cs = min(max(q - 8, 0), 48);
                for (int ub = vcu * 8; ub < BATCH * 4 * 64; ub += G * 8) {
                    const int bh = ub >> 6, b = bh >> 2, hh = bh & 3, r0u = ub & 63;
                    for (int i = tid; i < 465; i += NWAVES * 64) rp[i] = rpb[hh * 465 + i];
                    { const int rs0 = min(max(r0u - 4, 0), 56);
                      for (int i = tid; i < 8192; i += NWAVES * 64) { const int kv = i >> 12, krow = rs0 + ((i >> 9) & 7), col = (i >> 3) & 63, ch = i & 7;
                          const bf16* src = Z + (size_t)(b * T + krow * 64 + col) * ZW + (kv ? ZV : ZK) + hh * 64 + ch * 8;
                          *(LAS u32x4*)((kv ? Vs : Ks) + ((((krow & 7) * 64 + col) << 7) + ((ch ^ (col & 7)) << 4))) = *(const u32x4*)src; } }
                    bf16x8 q0, q1;
                    { const bf16* qp = Z + (size_t)(b * T + r0u * 64 + q) * ZW + ZQ + hh * 64; q0 = *(const bf16x8*)(qp + kq * 8); q1 = *(const bf16x8*)(qp + 32 + kq * 8); }
                    __syncthreads();
#pragma unroll 1
                    for (int k8 = 0; k8 < 8; ++k8) {
                        const int r = r0u + k8;
                        const int rs = min(max(r - 4, 0), 56);
                        const int rn = min(r + 1, 63), rsn = min(max(rn - 4, 0), 56); const bool newrow = (k8 < 7) && (rsn != rs); const int krn = rsn + 7;
                        bf16x8 nq0, nq1; u32x4 st0 = (u32x4){0u, 0u, 0u, 0u}, st1 = st0;
                        { const bf16* qp = Z + (size_t)(b * T + rn * 64 + q) * ZW + ZQ + hh * 64; nq0 = *(const bf16x8*)(qp + kq * 8); nq1 = *(const bf16x8*)(qp + 32 + kq * 8); }
                        { const int col = (tid >> 3) & 63, ch = tid & 7; const bf16* src = Z + (size_t)(b * T + min(krn, 63) * 64 + col) * ZW + hh * 64 + ch * 8;
                            st0 = *(const u32x4*)(src + ZK); st1 = *(const u32x4*)(src + ZV); }
                        float sc[8][4]; float mx = -1e30f;
#pragma unroll
                        for (int kt = 0; kt < 8; ++kt) { const int il = kt >> 1, ch2 = kt & 1, krow = rs + half * 4 + il, colA = c0 + 16 * ch2 + r16;
                            const LAS unsigned char* ka = Ks + ((((krow & 7) * 64 + colA) << 7));
                            const bf16x8 a0 = *(const LAS bf16x8*)(ka + ((kq ^ (colA & 7)) << 4)), a1 = *(const LAS bf16x8*)(ka + (((4 + kq) ^ (colA & 7)) << 4));
                            f32x4 acc = (f32x4){0.f, 0.f, 0.f, 0.f};
                            acc = __builtin_amdgcn_mfma_f32_16x16x32_bf16(a0, q0, acc, 0, 0, 0); acc = __builtin_amdgcn_mfma_f32_16x16x32_bf16(a1, q1, acc, 0, 0, 0);
                            const LAS float* brow = rp + (krow - r + 7) * 31 + (15 - q);
#pragma unroll
                            for (int g = 0; g < 4; ++g) { const int col = c0 + 16 * ch2 + 4 * kq + g; const bool valid = (col >= cs) && (col < cs + 16);
                                const float bias = brow[valid ? col : (q - 15)];
                                const float v = valid ? (acc[g] * 0.125f + bias) : -1e30f; sc[kt][g] = v; mx = fmaxf(mx, v); } }
                        mx = fmaxf(mx, __shfl_xor(mx, 16)); mx = fmaxf(mx, __shfl_xor(mx, 32));
                        float ls = 0.f;
#pragma unroll
                        for (int kt = 0; kt < 8; ++kt)
#pragma unroll
                            for (int g = 0; g < 4; ++g) { const float pv = __expf(sc[kt][g] - mx); sc[kt][g] = pv; ls += pv; }
                        ls += __shfl_xor(ls, 16); ls += __shfl_xor(ls, 32);
                        f32x4 o[4];
#pragma unroll
                        for (int dt = 0; dt < 4; ++dt) o[dt] = (f32x4){0.f, 0.f, 0.f, 0.f};
                        const int qq = r16 >> 2, pp = r16 & 3;
#pragma unroll
                        for (int m2 = 0; m2 < 4; ++m2) { const int krow = rs + half * 4 + m2;
                            u32x4 pb; pb.x = pk2(sc[2 * m2][0], sc[2 * m2][1]); pb.y = pk2(sc[2 * m2][2], sc[2 * m2][3]); pb.z = pk2(sc[2 * m2 + 1][0], sc[2 * m2 + 1][1]); pb.w = pk2(sc[2 * m2 + 1][2], sc[2 * m2 + 1][3]);
                            const bf16x8 bfrag = __builtin_bit_cast(bf16x8, pb);
                            const int col0 = c0 + 4 * kq + qq, col1 = col0 + 16;
                            const LAS unsigned char* v0b = Vs + ((((krow & 7) * 64 + col0) << 7)) + (pp & 1) * 8; const LAS unsigned char* v1b = Vs + ((((krow & 7) * 64 + col1) << 7)) + (pp & 1) * 8;
#pragma unroll
                            for (int dt = 0; dt < 4; ++dt) { const int chn = 2 * dt + (pp >> 1);
                                const s16x4 t0 = __builtin_amdgcn_ds_read_tr16_b64_v4i16((LAS s16x4*)(v0b + ((chn ^ (col0 & 7)) << 4)));
                                const s16x4 t1 = __builtin_amdgcn_ds_read_tr16_b64_v4i16((LAS s16x4*)(v1b + ((chn ^ (col1 & 7)) << 4)));
                                const bf16x8 afrag = (bf16x8){t0[0], t0[1], t0[2], t0[3], t1[0], t1[1], t1[2], t1[3]};
                                o[dt] = __builtin_amdgcn_mfma_f32_16x16x32_bf16(afrag, bfrag, o[dt], 0, 0, 0); } }
                        LAS float* px = xch + q * 68;
                        if (half == 1) {
#pragma unroll
                            for (int dt = 0; dt < 4; ++dt) *(LAS f32x4*)(px + 16 * dt + 4 * kq) = o[dt];
                            if (kq == 0) { px[64] = mx; px[65] = ls; } }
                        __syncthreads();
                        if (half == 0) { const float m1 = px[64], l1 = px[65]; const float mm = fmaxf(mx, m1), f0 = __expf(mx - mm), f1 = __expf(m1 - mm); const float inv = __builtin_amdgcn_rcpf(f0 * ls + f1 * l1);
                            bf16* op = YCAT + (size_t)(b * T + r * 64 + q) * D + hh * 64 + 4 * kq;
#pragma unroll
                            for (int dt = 0; dt < 4; ++dt) { const f32x4 o1 = *(const LAS f32x4*)(px + 16 * dt + 4 * kq); const f32x4 res = (o[dt] * f0 + o1 * f1) * inv;
                                u32x2 w; w.x = pk2(res[0], res[1]); w.y = pk2(res[2], res[3]); *(u32x2*)(op + 16 * dt) = w; } }
                        if (newrow) { const int col = (tid >> 3) & 63, ch = tid & 7; const int off = ((((krn & 7) * 64 + col) << 7) + ((ch ^ (col & 7)) << 4));
                            *(LAS u32x4*)(Ks + off) = st0; *(LAS u32x4*)(Vs + off) = st1; }
                        q0 = nq0; q1 = nq1;
                        __syncthreads();
                    }
                }
            }
            if (SUBEN(1) && (args.sub & 2)) {
                LAS bf16* PWT = (LAS bf16*)lds;
                LAS bf16* DB = PWT + 4 * 64 * 72;
                const int ch = tid & 255, hf = tid >> 8, gq = ch >> 6, hw = 1 << gq;
                { const float* pwp = INP(IN_POOLW) + (size_t)l * 4 * 64 * 64;
                  for (int i = tid; i < 4 * 64 * 64; i += NWAVES * 64) { const int g = i >> 12, c = (i >> 6) & 63, dd = i & 63; PWT[(g * 64 + dd) * 72 + c] = (bf16)f2bf(pwp[i]); } }
                const int r16 = lane & 15, kq = lane >> 4, mg = wave & 3, mtk = wave >> 2;
                f32x4 psc[4];
                { const float* psp = INP(IN_POOLS) + l * GW + mg * 64;
#pragma unroll
                  for (int dt = 0; dt < 4; ++dt) psc[dt] = *(const f32x4*)(psp + dt * 16 + 4 * kq); }
                const float cw0 = INP(IN_CONVW)[(size_t)l * 3 * GW + ch], cw1 = INP(IN_CONVW)[(size_t)l * 3 * GW + GW + ch], cw2 = INP(IN_CONVW)[(size_t)l * 3 * GW + 2 * GW + ch];
                __syncthreads();
                for (int it = vcu; it < M / 32; it += G) {
                    const int b = it >> 7, tb = (it & 127) * 32, t0 = tb + hf * 16;
                    const bf16* zb = Z + (size_t)b * T * ZW;
                    float ps[33]; ps[0] = 0.f;
#pragma unroll
                    for (int i = 0; i < 32; ++i) { const int tp = t0 - 8 + i; const int tc = min(max(tp, 0), T - 1); const float zv = bf2f(zb[(size_t)tc * ZW + ZP + ch]) * ((tp == tc) ? 1.f : 0.f); ps[i + 1] = ps[i] + zv; }
                    float uu[18], bg[16];
#pragma unroll
                    for (int i = 0; i < 18; ++i) { const int tp = t0 - 1 + i; const int tc = min(max(tp, 0), T - 1); uu[i] = bf2f(zb[(size_t)tc * ZW + ZCC + ch]) * bf2f(zb[(size_t)tc * ZW + ZCH + ch]) * ((tp == tc) ? 1.f : 0.f); }
#pragma unroll
                    for (int k = 0; k < 16; ++k) bg[k] = bf2f(zb[(size_t)(t0 + k) * ZW + ZCB + ch]);
#pragma unroll
                    for (int k = 0; k < 16; ++k) { const int t = t0 + k;
                        const int lo_ = max(t - hw, 0), hi_ = min(t + hw, T);
                        float sw;
                        if (gq == 0) sw = ps[k + 9] - ps[k + 7]; else if (gq == 1) sw = ps[k + 10] - ps[k + 6]; else if (gq == 2) sw = ps[k + 12] - ps[k + 4]; else sw = ps[k + 16] - ps[k];
                        const float uq = ps[k + 9] - ps[k + 8];
                        DB[(hf * 16 + k) * 264 + ch] = (bf16)f2bf(sw * __builtin_amdgcn_rcpf((float)(hi_ - lo_)) - uq); }
                    __syncthreads();
                    { const LAS bf16* bp = DB + (mtk * 16 + r16) * 264 + mg * 64 + kq * 8;
                      const bf16x8 b0 = *(const LAS bf16x8*)bp, b1 = *(const LAS bf16x8*)(bp + 32);
                      bf16* op = YCAT + (size_t)(b * T + tb + mtk * 16 + r16) * D + 512 + mg * 64 + 4 * kq;
#pragma unroll
                      for (int dt = 0; dt < 4; ++dt) { const LAS bf16* ap = PWT + (mg * 64 + dt * 16 + r16) * 72 + kq * 8;
                          f32x4 acc = __builtin_amdgcn_mfma_f32_16x16x32_bf16(*(const LAS bf16x8*)ap, b0, (f32x4){0.f, 0.f, 0.f, 0.f}, 0, 0, 0);
                          acc = __builtin_amdgcn_mfma_f32_16x16x32_bf16(*(const LAS bf16x8*)(ap + 32), b1, acc, 0, 0, 0);
                          acc = acc * psc[dt];
                          u32x2 w; w.x = pk2(acc[0], acc[1]); w.y = pk2(acc[2], acc[3]); *(u32x2*)(op + dt * 16) = w; } }
#pragma unroll
                    for (int k = 0; k < 16; ++k) YCAT[(size_t)(b * T + t0 + k) * D + 768 + ch] = (bf16)f2bf(bg[k] * (cw0 * uu[k] + cw1 * uu[k + 1] + cw2 * uu[k + 2]));
                    __syncthreads();
                }
            }
        }
        if (PHEN(4) && IN(P + 2)) {
            PHASE_PROLOGUE
            constexpr int LP = 64, MS = 64 * LP;
            LAS bf16* At = (LAS bf16*)lds; LAS bf16* Rt = At + MS; LAS bf16* Bt = Rt + MS; LAS bf16* Kt = Bt + MS;
            LAS bf16* XT = Kt + MS;
            LAS bf16* BhT = XT + 2 * MS; LAS bf16* KhT = BhT + MS; LAS bf16* VT = KhT + MS;
            LAS bf16* Nb = VT + MS;
            LAS bf16* Mk = Nb + 4 * MS; LAS bf16* Pb = Mk + MS; LAS bf16* Pk = Pb + MS;
            LAS float* tot = (LAS float*)(Pk + MS);
            const int r16 = lane & 15, kq = lane >> 4, sw = r16 & 7;
            const int fo0 = r16 * LP + ((kq ^ sw) << 3), fo1 = r16 * LP + (((4 + kq) ^ sw) << 3);
#define TOFF(y0) (r16 * LP + (((((y0) >> 3) + (kq >> 1)) ^ sw) << 3) + 4 * (kq & 1))
#define LBAR() do { asm volatile("s_waitcnt lgkmcnt(0)" ::: "memory"); __builtin_amdgcn_s_barrier(); asm volatile("" ::: "memory"); } while (0)
#define MMA16H(acc, Ap, Bp, h) do { const bf16x8 _a = *(const LAS bf16x8*)((Ap) + ((h) ? fo1 : fo0)); const bf16x8 _b = *(const LAS bf16x8*)((Bp) + ((h) ? fo1 : fo0)); \
        acc = __builtin_amdgcn_mfma_f32_16x16x32_bf16(_a, _b, acc, 0, 0, 0); } while (0)
#define MMA16(acc, Ap, Bp) do { MMA16H(acc, Ap, Bp, 0); MMA16H(acc, Ap, Bp, 1); } while (0)
#define STORE_T(dst, x0, y0, acc) do { u32x2 _w; _w.x = pk2((acc)[0], (acc)[1]); _w.y = pk2((acc)[2], (acc)[3]); *(LAS u32x2*)((dst) + (x0) * LP + TOFF(y0)) = _w; } while (0)
            const int e = (vcu & 7) >> 2, hh = vcu & 3, cch = hh * 64 + lane;
            LAS bf16* LWT = (LAS bf16*)(tot + 1024);
            LAS bf16* LATW = Pb; LAS bf16* LATA = Pk;
            LAS float* WPA = (LAS float*)Nb;
            { const float* w2p = INP(IN_W2L); const float* a2p = INP(IN_A2L);
              for (int i = tid; i < 4096; i += NWAVES * 64) { const int wh = i >> 11, q = (i >> 6) & 31, cc = i & 63;
                  LWT[(wh * 64 + cc) * 40 + q] = (bf16)f2bf((wh ? a2p : w2p)[((size_t)(l * 2 + e) * 32 + q) * GW + hh * 64 + cc]); } }
            const float w0c = INP(IN_W0)[(size_t)(l * 2 + e) * GW + cch], a0c = INP(IN_A0)[(size_t)(l * 2 + e) * GW + cch];
            const float kkc = INP(IN_KK)[(size_t)l * GW + cch], kac = INP(IN_KA)[(size_t)l * GW + cch];
            float mur, muk, muv, mulat;
            { const float* mu = INP(IN_MU) + (size_t)(l * 2 + e) * RWS; mur = mu[cch]; muk = mu[256 + cch]; muv = mu[512 + cch]; mulat = mu[768 + lane]; }
            __syncthreads();
            float rz[9], kz[9], vz[9], lz[9];
#define E0_LOAD(idx_) do { const int _b = (idx_) >> 6, _ck = (idx_) & 63; int cl_ = cch, jl_ = lane; asm volatile("" : "+v"(cl_), "+v"(jl_)); \
        _Pragma("unroll") for (int x = 0; x < 9; ++x) { const int sidx = _ck * 64 + wave * 8 + x - 1; const int t = e ? (T - 1 - sidx) : sidx; \
            const float okf = (sidx >= 0) ? 1.f : 0.f; const int tcl = min(max(t, 0), T - 1); \
            const bf16* zp = Z + (size_t)(_b * T + tcl) * ZW + ZR; rz[x] = bf2f(zp[cl_]) * okf; kz[x] = bf2f(zp[256 + cl_]) * okf; vz[x] = bf2f(zp[512 + cl_]) * okf; lz[x] = bf2f(zp[768 + jl_]) * okf; } } while (0)
            E0_LOAD(vcu >> 3);
            for (int idx = vcu >> 3; idx < 512; idx += (G >> 3)) {
                const int b = idx >> 6, ck = idx & 63, chain = (e * 8 + b) * 4 + hh, u = chain * 64 + ck;
                for (int rep_ = 0; rep_ <= ((args.sub >> 8) & 1); ++rep_) {
                    const int j = lane, s0 = wave * 8;
#pragma unroll
                    for (int x = 0; x < 8; ++x) { const float zd = lz[x + 1] + mulat * (lz[x] - lz[x + 1]);
                        const float tv = 1.0f - 2.0f * __builtin_amdgcn_rcpf(1.0f + __expf(2.0f * zd));
                        ((j < 32) ? LATW : LATA)[(s0 + x) * LP + ((((j & 31) >> 3) ^ x) << 3) + (j & 7)] = (bf16)f2bf((j < 32) ? tv : zd); }
                    LBAR();
                    { const int wh = wave >> 2, ty = wave & 3;
                      const bf16x8 af = *(const LAS bf16x8*)((wh ? LATA : LATW) + ty * 16 * LP + fo0);
#pragma unroll
                      for (int tx = 0; tx < 4; ++tx) { const bf16x8 bfr = *(const LAS bf16x8*)(LWT + (wh * 64 + tx * 16 + r16) * 40 + kq * 8);
                          const f32x4 acc = __builtin_amdgcn_mfma_f32_16x16x32_bf16(af, bfr, (f32x4){0.f, 0.f, 0.f, 0.f}, 0, 0, 0);
                          *(LAS f32x4*)(WPA + (wh * 64 + tx * 16 + r16) * 68 + ty * 16 + 4 * kq) = acc; } }
                    LBAR();
                    f32x4 wpv[2], apv[2];
                    wpv[0] = *(const LAS f32x4*)(WPA + j * 68 + s0); wpv[1] = *(const LAS f32x4*)(WPA + j * 68 + s0 + 4); apv[0] = *(const LAS f32x4*)(WPA + (64 + j) * 68 + s0); apv[1] = *(const LAS f32x4*)(WPA + (64 + j) * 68 + s0 + 4);
                    float cw[8], lwv[8], rr[8], kk_[8], aa[8], bb[8];
                    float run = 0.f;
#pragma unroll
                    for (int x = 0; x < 8; ++x) {
                        const float r_ = rz[x + 1] + mur * (rz[x] - rz[x + 1]), kk0 = kz[x + 1] + muk * (kz[x] - kz[x + 1]);
                        const float wp = w0c + wpv[x >> 2][x & 3], ap = a0c + apv[x >> 2][x & 3];
                        const float nx = -wp; const float sp = fmaxf(nx, 0.f) + __logf(1.0f + __expf(-fabsf(nx)));
                        lwv[x] = -__expf(-sp - 0.5f);
                        const float av = sigmoidf_(ap);
                        float kk = kk0 * kkc; const float ss = wave_sum(kk * kk); kk *= __builtin_amdgcn_rsqf(fmaxf(ss, 1e-12f));
                        rr[x] = r_; kk_[x] = kk0 * (1.0f + (av - 1.0f) * kac); aa[x] = -kk; bb[x] = kk * av;
                        run += lwv[x]; cw[x] = run; }
                    tot[wave * 64 + j] = run;
                    LBAR();
                    float pre = 0.f, all = 0.f;
#pragma unroll
                    for (int w = 0; w < 8; ++w) { const float v = tot[w * 64 + j]; all += v; pre += (w < wave) ? v : 0.f; }
                    unsigned xt[8], bh[8], kh[8], vt[8];
                    const int rm = (j >> 3) << 3, jl = j & 7;
                    const float wlall = __expf(all); float ewp = __expf(pre); if (wave == 0) tot[512 + j] = wlall;
#pragma unroll
                    for (int x = 0; x < 8; ++x) { const float c = cw[x] + pre; const float ew = __expf(c), ewx = ewp, einv = __builtin_amdgcn_rcpf(ew), eL = wlall * einv; ewp = ew;
                        xt[x] = f2bf(aa[x] * ewx); bh[x] = f2bf(bb[x] * eL); kh[x] = f2bf(kk_[x] * eL); vt[x] = f2bf(vz[x + 1] + muv * (vz[x] - vz[x + 1]));
                        const int ro = (s0 + x) * LP + ((rm ^ (x << 3))) + jl;
                        At[ro] = (bf16)xt[x]; Rt[ro] = (bf16)f2bf(rr[x] * ew); Bt[ro] = (bf16)f2bf(bb[x] * einv); Kt[ro] = (bf16)f2bf(kk_[x] * einv); }
                    const int to = j * LP + ((wave ^ (j & 7)) << 3);
                    u32x4 w4;
                    w4.x = xt[0] | (xt[1] << 16); w4.y = xt[2] | (xt[3] << 16); w4.z = xt[4] | (xt[5] << 16); w4.w = xt[6] | (xt[7] << 16); *(LAS u32x4*)(XT + to) = w4;
                    w4.x = bh[0] | (bh[1] << 16); w4.y = bh[2] | (bh[3] << 16); w4.z = bh[4] | (bh[5] << 16); w4.w = bh[6] | (bh[7] << 16); *(LAS u32x4*)(BhT + to) = w4;
                    w4.x = kh[0] | (kh[1] << 16); w4.y = kh[2] | (kh[3] << 16); w4.z = kh[4] | (kh[5] << 16); w4.w = kh[6] | (kh[7] << 16); *(LAS u32x4*)(KhT + to) = w4;
                    w4.x = vt[0] | (vt[1] << 16); w4.y = vt[2] | (vt[3] << 16); w4.z = vt[4] | (vt[5] << 16); w4.w = vt[6] | (vt[7] << 16); *(LAS u32x4*)(VT + to) = w4;
                    LBAR();
                    if (rep_ == ((args.sub >> 8) & 1)) E0_LOAD(min(idx + (G >> 3), 511));
                }
                for (int rep_ = 0; rep_ <= ((args.sub >> 9) & 1); ++rep_) {
#pragma unroll
                for (int n2 = 0; n2 < 2; ++n2) {
                    const int ty = n2 * 2 + (wave >> 2), tx = wave & 3;
                    const f32x4 z4 = (f32x4){0.f, 0.f, 0.f, 0.f};
                    f32x4 aN = z4, aNT = z4, aMk = z4, aPb = z4, aPk = z4;
                    const LAS bf16* yA = At + ty * 16 * LP; const LAS bf16* yB = Bt + ty * 16 * LP; const LAS bf16* yK = Kt + ty * 16 * LP;
                    const LAS bf16* xA = At + tx * 16 * LP; const LAS bf16* xB = Bt + tx * 16 * LP; const LAS bf16* xR = Rt + tx * 16 * LP;
                    if (ty <= tx) {
                        const bf16x8 yb0 = *(const LAS bf16x8*)(yB + fo0), yb1 = *(const LAS bf16x8*)(yB + fo1), yk0 = *(const LAS bf16x8*)(yK + fo0), yk1 = *(const LAS bf16x8*)(yK + fo1);
                        const bf16x8 xa0 = *(const LAS bf16x8*)(xA + fo0), xa1 = *(const LAS bf16x8*)(xA + fo1), xr0 = *(const LAS bf16x8*)(xR + fo0), xr1 = *(const LAS bf16x8*)(xR + fo1);
                        aN = __builtin_amdgcn_mfma_f32_16x16x32_bf16(yb0, xa0, aN, 0, 0, 0); aMk = __builtin_amdgcn_mfma_f32_16x16x32_bf16(yk0, xa0, aMk, 0, 0, 0);
                        aPb = __builtin_amdgcn_mfma_f32_16x16x32_bf16(yb0, xr0, aPb, 0, 0, 0); aPk = __builtin_amdgcn_mfma_f32_16x16x32_bf16(yk0, xr0, aPk, 0, 0, 0);
                        aN = __builtin_amdgcn_mfma_f32_16x16x32_bf16(yb1, xa1, aN, 0, 0, 0); aMk = __builtin_amdgcn_mfma_f32_16x16x32_bf16(yk1, xa1, aMk, 0, 0, 0);
                        aPb = __builtin_amdgcn_mfma_f32_16x16x32_bf16(yb1, xr1, aPb, 0, 0, 0); aPk = __builtin_amdgcn_mfma_f32_16x16x32_bf16(yk1, xr1, aPk, 0, 0, 0); }
                    if (tx <= ty) {
                        const bf16x8 ya0 = *(const LAS bf16x8*)(yA + fo0), ya1 = *(const LAS bf16x8*)(yA + fo1), xb0 = *(const LAS bf16x8*)(xB + fo0), xb1 = *(const LAS bf16x8*)(xB + fo1);
                        aNT = __builtin_amdgcn_mfma_f32_16x16x32_bf16(ya0, xb0, aNT, 0, 0, 0); aNT = __builtin_amdgcn_mfma_f32_16x16x32_bf16(ya1, xb1, aNT, 0, 0, 0); }
                    if (ty == tx) {
#pragma unroll
                        for (int q = 0; q < 4; ++q) { const int yy = 4 * kq + q; const bool lt = yy < r16, le = yy <= r16;
                            aN[q] = lt ? aN[q] : 0.f; aMk[q] = lt ? aMk[q] : 0.f; aPb[q] = le ? aPb[q] : 0.f; aPk[q] = le ? aPk[q] : 0.f; aNT[q] = (r16 < yy) ? aNT[q] : 0.f; } }
                    STORE_T(Nb, tx * 16, ty * 16, aN); STORE_T(Nb + MS, tx * 16, ty * 16, aNT); STORE_T(Mk, tx * 16, ty * 16, aMk); STORE_T(Pb, tx * 16, ty * 16, aPb); STORE_T(Pk, tx * 16, ty * 16, aPk); asm volatile("" ::: "memory"); }
                LBAR();
                for (int id = wave; id < 16; id += 8) { const int ty = id >> 2, tx = id & 3;
                    f32x4 acc = (f32x4){0.f, 0.f, 0.f, 0.f};
                    MMA16H(acc, Mk + ty * 16 * LP, VT + tx * 16 * LP, 0); if (ty >= 2) MMA16H(acc, Mk + ty * 16 * LP, VT + tx * 16 * LP, 1);
                    STORE_T(XT + MS, tx * 16, ty * 16, acc); }
                LBAR();
                }
                {
                    LAS bf16* Nc = Nb; LAS bf16* NcT = Nb + MS; LAS bf16* Nn = Nb + 2 * MS; LAS bf16* NnT = Nb + 3 * MS;
                    const int which = wave >> 2, wq = wave & 3;
                    const int tt0 = (wq == 0) ? 0 : (wq == 1) ? 3 : (wq == 2) ? 1 : 2, st0 = (wq == 0) ? 0 : (wq == 1) ? 0 : (wq == 2) ? 1 : 2;
                    const int tt1 = (wq == 0) ? 1 : (wq == 1) ? 3 : (wq == 2) ? 2 : 3, st1 = (wq == 0) ? 0 : (wq == 1) ? 1 : (wq == 2) ? 1 : 3;
                    const int tt2 = (wq == 0) ? 2 : (wq == 1) ? 3 : (wq == 2) ? 3 : 1, st2 = (wq == 0) ? 0 : (wq == 1) ? 2 : (wq == 2) ? 3 : 1;
                    const int ty0 = which ? tt0 : st0, tx0 = which ? st0 : tt0, ty1 = which ? tt1 : st1, tx1 = which ? st1 : tt1, ty2 = which ? tt2 : st2, tx2 = which ? st2 : tt2;
                    for (int k = 0; k < 6; ++k) {
                        LAS bf16* Xw = XT + wave * 16 * LP;
                        const bf16x8 b0 = *(const LAS bf16x8*)(Xw + fo0), b1 = *(const LAS bf16x8*)(Xw + fo1);
                        u32x2 c0[4]; bf16x8 a0[4], a1[4];
#pragma unroll
                        for (int ty = 0; ty < 4; ++ty) { c0[ty] = *(const LAS u32x2*)(Xw + TOFF(ty * 16)); a0[ty] = *(const LAS bf16x8*)(Nc + ty * 16 * LP + fo0); a1[ty] = *(const LAS bf16x8*)(Nc + ty * 16 * LP + fo1); }
                        const LAS bf16* sA = which ? Nc : NcT; const LAS bf16* sB = which ? NcT : Nc;
                        const bf16x8 p0 = *(const LAS bf16x8*)(sA + ty0 * 16 * LP + fo0), p1 = *(const LAS bf16x8*)(sA + ty0 * 16 * LP + fo1), q0 = *(const LAS bf16x8*)(sB + tx0 * 16 * LP + fo0), q1 = *(const LAS bf16x8*)(sB + tx0 * 16 * LP + fo1);
                        const bf16x8 p2 = *(const LAS bf16x8*)(sA + ty1 * 16 * LP + fo0), p3 = *(const LAS bf16x8*)(sA + ty1 * 16 * LP + fo1), q2 = *(const LAS bf16x8*)(sB + tx1 * 16 * LP + fo0), q3 = *(const LAS bf16x8*)(sB + tx1 * 16 * LP + fo1);
                        const bf16x8 p4 = *(const LAS bf16x8*)(sA + ty2 * 16 * LP + fo0), p5 = *(const LAS bf16x8*)(sA + ty2 * 16 * LP + fo1), q4 = *(const LAS bf16x8*)(sB + tx2 * 16 * LP + fo0), q5 = *(const LAS bf16x8*)(sB + tx2 * 16 * LP + fo1);
                        f32x4 acc[4];
#pragma unroll
                        for (int ty = 0; ty < 4; ++ty) { acc[ty] = (f32x4){bflo(c0[ty].x), bfhi(c0[ty].x), bflo(c0[ty].y), bfhi(c0[ty].y)};
                            acc[ty] = __builtin_amdgcn_mfma_f32_16x16x32_bf16(a0[ty], b0, acc[ty], 0, 0, 0); acc[ty] = __builtin_amdgcn_mfma_f32_16x16x32_bf16(a1[ty], b1, acc[ty], 0, 0, 0); }
                        const f32x4 z4 = (f32x4){0.f, 0.f, 0.f, 0.f};
                        f32x4 s0a = __builtin_amdgcn_mfma_f32_16x16x32_bf16(p0, q0, z4, 0, 0, 0), s1a = __builtin_amdgcn_mfma_f32_16x16x32_bf16(p2, q2, z4, 0, 0, 0), s2a = __builtin_amdgcn_mfma_f32_16x16x32_bf16(p4, q4, z4, 0, 0, 0);
                        s0a = __builtin_amdgcn_mfma_f32_16x16x32_bf16(p1, q1, s0a, 0, 0, 0); s1a = __builtin_amdgcn_mfma_f32_16x16x32_bf16(p3, q3, s1a, 0, 0, 0); s2a = __builtin_amdgcn_mfma_f32_16x16x32_bf16(p5, q5, s2a, 0, 0, 0);
#pragma unroll
                        for (int ty = 0; ty < 4; ++ty) STORE_T(Xw, 0, ty * 16, acc[ty]);
                        if (k < 5) { LAS bf16* dst = which ? NnT : Nn;
                            STORE_T(dst, tx0 * 16, ty0 * 16, s0a); STORE_T(dst, tx1 * 16, ty1 * 16, s1a); STORE_T(dst, tx2 * 16, ty2 * 16, s2a);
                            if (k == 0) {
                                if (wq < 3) { for (int st = wq + 1; st < 4; ++st) { const int tt = wq; const int tyz = which ? tt : st, txz = which ? st : tt; STORE_T(dst, txz * 16, tyz * 16, z4); } } } }
                        LBAR();
                        { LAS bf16* t0 = Nc; Nc = Nn; Nn = t0; t0 = NcT; NcT = NnT; NnT = t0; }
                    }
                }
                for (int rep_ = 0; rep_ <= ((args.sub >> 10) & 1); ++rep_) {
                    bf16* cho = CH + (size_t)u * 16384;
#pragma unroll
                    for (int n2 = 0; n2 < 2; ++n2) {
                        const int ty = n2 * 2 + (wave >> 2), tx = wave & 3;
                        const int xg = tx * 16 + r16, yg = ty * 16 + 4 * kq;
                        const f32x4 z4 = (f32x4){0.f, 0.f, 0.f, 0.f};
                        f32x4 aRp = z4, aPm = z4, aYl = z4, aQm = z4;
#pragma unroll
                        for (int h = 0; h < 2; ++h) { const int fo = h ? fo1 : fo0;
                            const bf16x8 yU = *(const LAS bf16x8*)(XT + ty * 16 * LP + fo), yPb = *(const LAS bf16x8*)(Pb + ty * 16 * LP + fo), yPk = *(const LAS bf16x8*)(Pk + ty * 16 * LP + fo),
                                         yBh = *(const LAS bf16x8*)(BhT + ty * 16 * LP + fo), yKh = *(const LAS bf16x8*)(KhT + ty * 16 * LP + fo);
                            const bf16x8 xPb = *(const LAS bf16x8*)(Pb + tx * 16 * LP + fo), xBh = *(const LAS bf16x8*)(BhT + tx * 16 * LP + fo), xUv = *(const LAS bf16x8*)(XT + MS + tx * 16 * LP + fo), xV = *(const LAS bf16x8*)(VT + tx * 16 * LP + fo);
                            aRp = __builtin_amdgcn_mfma_f32_16x16x32_bf16(yU, xPb, aRp, 0, 0, 0);
                            aPm = __builtin_amdgcn_mfma_f32_16x16x32_bf16(yU, xBh, aPm, 0, 0, 0);
                            aYl = __builtin_amdgcn_mfma_f32_16x16x32_bf16(yPb, xUv, aYl, 0, 0, 0);
                            aYl = __builtin_amdgcn_mfma_f32_16x16x32_bf16(yPk, xV, aYl, 0, 0, 0);
                            aQm = __builtin_amdgcn_mfma_f32_16x16x32_bf16(yBh, xUv, aQm, 0, 0, 0);
                            aQm = __builtin_amdgcn_mfma_f32_16x16x32_bf16(yKh, xV, aQm, 0, 0, 0); }
                        { const u32x2 c0 = *(const LAS u32x2*)(Rt + tx * 16 * LP + TOFF(ty * 16)); aRp[0] += bflo(c0.x); aRp[1] += bfhi(c0.x); aRp[2] += bflo(c0.y); aRp[3] += bfhi(c0.y); }
                        { const float wl = tot[512 + xg];
#pragma unroll
                          for (int q = 0; q < 4; ++q) aPm[q] += (yg + q == xg) ? wl : 0.f; }
                        u32x2 w2; int lofs = xg * 64 + yg; asm volatile("" : "+v"(lofs));
                        bf16* const cl = cho + lofs;
                        w2.x = pk2(aRp[0], aRp[1]); w2.y = pk2(aRp[2], aRp[3]); *(u32x2*)(cl + 0 * 4096) = w2;
                        w2.x = pk2(aPm[0], aPm[1]); w2.y = pk2(aPm[2], aPm[3]); *(u32x2*)(cl + 1 * 4096) = w2;
                        w2.x = pk2(aYl[0], aYl[1]); w2.y = pk2(aYl[2], aYl[3]); *(u32x2*)(cl + 2 * 4096) = w2;
                        w2.x = pk2(aQm[0], aQm[1]); w2.y = pk2(aQm[2], aQm[3]); *(u32x2*)(cl + 3 * 4096) = w2; asm volatile("" ::: "memory"); }
                }
                LBAR();
            }
#undef E0_LOAD
#undef MMA16
#undef MMA16H
#undef STORE_T
#undef TOFF
#undef LBAR
            SEAM(P + 2);
        }
        if (PHEN(15) && IN(P + 3)) {
            PHASE_PROLOGUE
            constexpr int LP = 72, MS = 16 * LP;
            LAS bf16* Sb = (LAS bf16*)lds;
            const int r16 = lane & 15, kq = lane >> 4, ty = wave & 3, role = wave >> 2;
            for (int wu = bx; wu < 256; wu += G) {
                const int chain = (wu & 7) + 8 * (wu >> 5), it = (wu >> 3) & 3;
                const int e = chain >> 5, b = (chain >> 2) & 7, hh = chain & 3;
                for (int i = tid; i < 2 * MS / 2; i += NWAVES * 64) ((LAS unsigned*)Sb)[i] = 0u;
                __syncthreads();
                const bf16* ch0 = CH + (size_t)chain * 64 * 16384;
                float* ysb = YS + ((size_t)(e * 8 + b) * T) * 256 + hh * 64 + it * 16 + r16;
#define SQ_LOAD(Aq, Cq, c) do { const bf16* _ab = ch0 + (size_t)(c) * 16384 + (role ? 0 : 4096) + (ty * 16 + r16) * 64 + kq * 8; \
        Aq[0] = *(const bf16x8*)_ab; Aq[1] = *(const bf16x8*)(_ab + 32); \
        Cq = *(const u32x2*)(ch0 + (size_t)(c) * 16384 + (role ? 8192 : 12288) + (it * 16 + r16) * 64 + ty * 16 + 4 * kq); } while (0)
#define SQ_STEP(Aq, Cq, c) do { const LAS bf16* _Sc = Sb + ((c) & 1) * MS; LAS bf16* _Sn = Sb + (((c) + 1) & 1) * MS; \
        const bf16x8 _b0 = *(const LAS bf16x8*)(_Sc + r16 * LP + kq * 8), _b1 = *(const LAS bf16x8*)(_Sc + r16 * LP + 32 + kq * 8); \
        f32x4 _acc = (f32x4){bflo(Cq.x), bfhi(Cq.x), bflo(Cq.y), bfhi(Cq.y)}; \
        _acc = __builtin_amdgcn_mfma_f32_16x16x32_bf16(Aq[0], _b0, _acc, 0, 0, 0); _acc = __builtin_amdgcn_mfma_f32_16x16x32_bf16(Aq[1], _b1, _acc, 0, 0, 0); \
        if (role == 0) { u32x2 _w; _w.x = pk2(_acc[0], _acc[1]); _w.y = pk2(_acc[2], _acc[3]); *(LAS u32x2*)(_Sn + r16 * LP + ty * 16 + 4 * kq) = _w; } \
        else { _Pragma("unroll") for (int _q = 0; _q < 4; ++_q) { const int _s = (c) * 64 + ty * 16 + 4 * kq + _q; const int _t = e ? (T - 1 - _s) : _s; ysb[(size_t)_t * 256] = _acc[_q]; } } \
        asm volatile("s_waitcnt lgkmcnt(0)" ::: "memory"); __builtin_amdgcn_s_barrier(); asm volatile("" ::: "memory"); } while (0)
                bf16x8 A0[2], A1[2], A2[2], A3[2], A4[2], A5[2], A6[2], A7[2]; u32x2 C0, C1, C2, C3, C4, C5, C6, C7;
                if constexpr (l == 0) {
                SQ_LOAD(A0, C0, 0); SQ_LOAD(A1, C1, 1); SQ_LOAD(A2, C2, 2); SQ_LOAD(A3, C3, 3); SQ_LOAD(A4, C4, 4); SQ_LOAD(A5, C5, 5); SQ_LOAD(A6, C6, 6);
                for (int c = 0; c < 64; c += 8) {
                    SQ_LOAD(A7, C7, c + 7);
                    SQ_STEP(A0, C0, c);
                    SQ_LOAD(A0, C0, min(c + 8, 63));
                    SQ_STEP(A1, C1, c + 1);
                    SQ_LOAD(A1, C1, min(c + 9, 63));
                    SQ_STEP(A2, C2, c + 2);
                    SQ_LOAD(A2, C2, min(c + 10, 63));
                    SQ_STEP(A3, C3, c + 3);
                    SQ_LOAD(A3, C3, min(c + 11, 63));
                    SQ_STEP(A4, C4, c + 4);
                    SQ_LOAD(A4, C4, min(c + 12, 63));
                    SQ_STEP(A5, C5, c + 5);
                    SQ_LOAD(A5, C5, min(c + 13, 63));
                    SQ_STEP(A6, C6, c + 6);
                    SQ_LOAD(A6, C6, min(c + 14, 63));
                    SQ_STEP(A7, C7, c + 7);
                }
                } else {
                LAS float* scr = (LAS float*)(lds + 8192 + wave * 8448);
                const float* mw1 = INP(IN_MW1); const float* mw3 = INP(IN_MW3); const float* mw2 = INP(IN_MW2);
                float rv[32];
#define CV_DECODE(j_) const int _g = gw + NGW * (j_), _e = _g / 5376, _r = _g % 5376, _wh = _r / 1792, _it = _r % 1792; \
        const int _nblk = (_wh == 2) ? 32 : 112, _kb = _it / _nblk, _nb = _it % _nblk, _N = (_wh == 2) ? D : FF, _K = (_wh == 2) ? FF : D; \
        const float* _src = ((_wh == 0) ? mw1 : (_wh == 1) ? mw3 : mw2) + (size_t)_e * D * FF
#define CV_LOAD(j_) do { CV_DECODE(j_); const float* _w = _src + (size_t)(64 * _kb + (lane >> 5)) * _N + 32 * _nb + (lane & 31); \
        _Pragma("unroll") for (int i = 0; i < 32; ++i) rv[i] = _w[(size_t)(2 * i) * _N]; } while (0)
#define CV_FINISH(j_) do { CV_DECODE(j_); const int _n0 = 32 * _nb, _k0 = 64 * _kb; const float _sc = (_wh == 2) ? SC_W2 : SC_W13; \
        const int _drow0 = (_wh == 2) ? _n0 : (256 * (_n0 >> 7) + (_n0 & 127) + (_wh == 1 ? 128 : 0)); \
        unsigned char* _dst = (_wh == 2) ? (ws + WS_WM2 + (size_t)_e * D * FF) : (ws + WS_WM13 + (size_t)_e * 2 * FF * D); \
        _Pragma("unroll") for (int i = 0; i < 32; ++i) scr[(2 * i + (lane >> 5)) * 33 + (lane & 31)] = rv[i]; \
        LDS_WAIT(); asm volatile("" ::: "memory"); \
        { const int c_ = lane & 7; \
          _Pragma("unroll") for (int j = 0; j < 4; ++j) { const int n = (lane >> 3) + 8 * j; const LAS float* s_ = scr + (8 * c_) * 33 + n; \
            u32x2 o; o.x = pg8::cvt4_fp8(s_[0 * 33] * _sc, s_[1 * 33] * _sc, s_[2 * 33] * _sc, s_[3 * 33] * _sc); o.y = pg8::cvt4_fp8(s_[4 * 33] * _sc, s_[5 * 33] * _sc, s_[6 * 33] * _sc, s_[7 * 33] * _sc); \
            *(u32x2*)(_dst + (size_t)(_drow0 + n) * _K + _k0 + 8 * c_) = o; } } \
        LDS_WAIT(); asm volatile("" ::: "memory"); } while (0)
                SQ_LOAD(A0, C0, 0); SQ_LOAD(A1, C1, 1); SQ_LOAD(A2, C2, 2); SQ_LOAD(A3, C3, 3); SQ_LOAD(A4, C4, 4);
                for (int c = 0; c < 60; c += 6) { const int j0 = (c / 6) * 2;
                    CV_LOAD(j0);
                    SQ_LOAD(A5, C5, c + 5);
                    SQ_STEP(A0, C0, c);     SQ_LOAD(A0, C0, min(c + 6, 63));
                    SQ_STEP(A1, C1, c + 1); SQ_LOAD(A1, C1, min(c + 7, 63));
                    CV_FINISH(j0); CV_LOAD(j0 + 1);
                    SQ_STEP(A2, C2, c + 2); SQ_LOAD(A2, C2, min(c + 8, 63));
                    SQ_STEP(A3, C3, c + 3); SQ_LOAD(A3, C3, min(c + 9, 63));
                    SQ_STEP(A4, C4, c + 4); SQ_LOAD(A4, C4, min(c + 10, 63));
                    CV_FINISH(j0 + 1);
                    SQ_STEP(A5, C5, c + 5);
                }
                CV_LOAD(20);
                SQ_STEP(A0, C0, 60); SQ_STEP(A1, C1, 61);
                CV_FINISH(20);
                SQ_STEP(A2, C2, 62); SQ_STEP(A3, C3, 63);
#undef CV_DECODE
#undef CV_LOAD
#undef CV_FINISH
                }
#undef SQ_LOAD
#undef SQ_STEP
                __syncthreads();
            }
            SEAM(P + 3);
        }
        if (PHEN(5) && IN(P + 4)) {
            PHASE_PROLOGUE
            LAS bf16* G2T = (LAS bf16*)lds;
            LAS bf16* SGB = G2T + 256 * 72;
            LAS float* GT = (LAS float*)(SGB + 16 * 72);
            const int c = tid & 255, hf = tid >> 8, r16 = lane & 15, kq = lane >> 4;
            { const float* g2p = INP(IN_G2) + (size_t)l * 64 * GW;
              for (int i = tid; i < 64 * 256; i += NWAVES * 64) G2T[(i & 255) * 72 + (i >> 8)] = (bf16)f2bf(g2p[i]); }
            const float lw = INP(IN_LNW)[(size_t)l * GW + c], lb = INP(IN_LNB)[(size_t)l * GW + c], rk = INP(IN_RK)[(size_t)l * GW + c];
            for (int it = vcu; it < M / 16; it += G) {
                const int m0 = it * 16;
                for (int i = tid; i < 1024; i += NWAVES * 64) SGB[(i >> 6) * 72 + (i & 63)] = (bf16)f2bf(sigmoidf_(bf2f(Z[(size_t)(m0 + (i >> 6)) * ZW + ZLG + (i & 63)])));
                __syncthreads();
                { const bf16x8 b0 = *(const LAS bf16x8*)(SGB + r16 * 72 + kq * 8), b1 = *(const LAS bf16x8*)(SGB + r16 * 72 + 32 + kq * 8);
#pragma unroll
                  for (int n2 = 0; n2 < 2; ++n2) { const int ct = wave * 2 + n2; const LAS bf16* ap = G2T + (ct * 16 + r16) * 72 + kq * 8;
                      f32x4 acc = __builtin_amdgcn_mfma_f32_16x16x32_bf16(*(const LAS bf16x8*)ap, b0, (f32x4){0.f, 0.f, 0.f, 0.f}, 0, 0, 0);
                      acc = __builtin_amdgcn_mfma_f32_16x16x32_bf16(*(const LAS bf16x8*)(ap + 32), b1, acc, 0, 0, 0);
                      *(LAS f32x4*)(GT + r16 * 260 + ct * 16 + 4 * kq) = acc; } }
                __syncthreads();
                float ya[8], yb[8], r0[8], k0[8], v0[8], res[8];
#pragma unroll
                for (int k = 0; k < 8; ++k) { const int m = m0 + hf * 8 + k; const bf16* zc = Z + (size_t)m * ZW + ZR;
                    ya[k] = YS[(size_t)m * 256 + c]; yb[k] = YS[(size_t)(M + m) * 256 + c]; r0[k] = bf2f(zc[c]); k0[k] = bf2f(zc[256 + c]); v0[k] = bf2f(zc[512 + c]); }
#pragma unroll
                for (int k = 0; k < 8; ++k) { const int tt = hf * 8 + k;
                    const float y = ya[k] + yb[k];
                    const float mean = wave_sum(y) * (1.0f / 64.0f); const float dv = y - mean;
                    const float var = wave_sum(dv * dv) * (1.0f / 64.0f);
                    float yn = dv * __builtin_amdgcn_rsqf(var + LNX_EPS) * lw + lb;
                    yn += wave_sum(r0[k] * k0[k] * rk) * v0[k];
                    res[k] = yn * GT[tt * 260 + c]; }
#pragma unroll
                for (int k = 0; k < 8; ++k) YCAT[(size_t)(m0 + hf * 8 + k) * D + 256 + c] = (bf16)f2bf(res[k]);
                __syncthreads();
            }
            SEAM(P + 4);
        }
        if (PHEN(6) && IN(P + 5)) {
            PHASE_PROLOGUE
            pg8::Gemm g{YCAT, (const bf16*)(ws + WS_WOUT) + (size_t)l * D * D, M, D, D, nullptr, 0}; pg8::StaticOrder S; S.init(M, D, G, bx);
            pg8::EpiBf16 E{Y, D, 1.0f};
            pg8::gemm_phase<pg8::EpiBf16, pg8::StaticOrder, false>(lds, g, S, E);
            SEAM(P + 5);
        }
        if (PHEN(7) && IN(P + 6)) {
            PHASE_PROLOGUE
            LAS float* rw = (LAS float*)lds;
            LAS int* lcnt = (LAS int*)(lds + 32768);
            if (l == 1) { const float* rwp = INP(IN_ROUTER); for (int i = tid; i < D * NE; i += NWAVES * 64) rw[i] = rwp[i]; if (tid < 8) lcnt[tid] = 0; __syncthreads(); }
            const float* xsrc = (l == 0) ? INP(IN_X) : X; const float* ng = INP(IN_NORMG) + (size_t)l * 4 * D;
            const int m0 = bx * 128 + wave * 16;
            f32x4 a1[4], bvv[4], cvv[4];
            { const float* mod = mod_l + (size_t)(m0 / T) * 6 * D; load_rowvecs(ng + 1 * D, mod + 2 * D, ng + 2 * D, mod + 4 * D, mod + 3 * D, lane, a1, bvv, cvv); }
            f32x4 yn[4], xn[4];
            ld_row_bf16(Y + (size_t)m0 * D, lane, yn); ld_row_f32(xsrc + (size_t)m0 * D, lane, xn);
#pragma unroll 1
            for (int r = 0; r < 16; ++r) { const int m = m0 + r, mn = m0 + min(r + 1, 15);
                f32x4 yv[4], xv[4], hv[4];
#pragma unroll
                for (int j = 0; j < 4; ++j) { yv[j] = yn[j]; xv[j] = xn[j]; }
                ld_row_bf16(Y + (size_t)mn * D, lane, yn); ld_row_f32(xsrc + (size_t)mn * D, lane, xn);
                const float rs = row_rstd(yv);
#pragma unroll
                for (int j = 0; j < 4; ++j) xv[j] = xv[j] + a1[j] * (yv[j] * rs);
                st_row_f32(X + (size_t)m * D, lane, xv);
                { const float rs2 = row_rstd(xv);
#pragma unroll
                  for (int j = 0; j < 4; ++j) hv[j] = xv[j] * rs2 * bvv[j] + cvv[j]; }
                if (l == 0) st_row_bf16(H + (size_t)m * D, lane, hv);
                else {
#pragma unroll
                    for (int j = 0; j < 4; ++j) *(unsigned*)((unsigned char*)H + (size_t)m * D + 4 * lane + 256 * j) = pg8::cvt4_fp8(hv[j][0] * SC_H8, hv[j][1] * SC_H8, hv[j][2] * SC_H8, hv[j][3] * SC_H8); }
                if (l == 1) {
                    float lg[8];
#pragma unroll
                    for (int e = 0; e < 8; ++e) lg[e] = 0.f;
#pragma unroll
                    for (int j = 0; j < 4; ++j)
#pragma unroll
                        for (int x = 0; x < 4; ++x) { const LAS float* rr = rw + (4 * lane + 256 * j + x) * 8; const f32x4 w0 = *(const LAS f32x4*)rr, w1 = *(const LAS f32x4*)(rr + 4); const float hx = hv[j][x];
                            lg[0] += hx * w0[0]; lg[1] += hx * w0[1]; lg[2] += hx * w0[2]; lg[3] += hx * w0[3]; lg[4] += hx * w1[0]; lg[5] += hx * w1[1]; lg[6] += hx * w1[2]; lg[7] += hx * w1[3]; }
#pragma unroll
                    for (int e = 0; e < 8; ++e) lg[e] = wave_sum(lg[e]);
                    int i1 = 0; float v1 = lg[0];
#pragma unroll
                    for (int e = 1; e < 8; ++e) if (lg[e] > v1) { v1 = lg[e]; i1 = e; }
                    int i2 = -1; float v2 = -3.0e38f;
#pragma unroll
                    for (int e = 0; e < 8; ++e) if (e != i1 && lg[e] > v2) { v2 = lg[e]; i2 = e; }
                    if (lane == 0) { const float g2 = 1.0f / (1.0f + __expf(v1 - v2)); TOPI[2 * m] = i1; TOPI[2 * m + 1] = i2; GATE[2 * m] = 1.0f - g2; GATE[2 * m + 1] = g2;
                        __hip_atomic_fetch_add(lcnt + i1, 1, __ATOMIC_RELAXED, __HIP_MEMORY_SCOPE_WORKGROUP); __hip_atomic_fetch_add(lcnt + i2, 1, __ATOMIC_RELAXED, __HIP_MEMORY_SCOPE_WORKGROUP); }
                }
            }
            if (l == 1) { __syncthreads(); if (tid < 8) WGCNT[bx * 8 + tid] = lcnt[tid]; }
            SEAM(P + 6);
        }
        if (l == 0) {
            if (PHEN(8) && IN(P + 7)) {
            PHASE_PROLOGUE
                pg8::Gemm g{H, (const bf16*)(ws + WS_W13), M, 2 * FF, D, nullptr, 0}; pg8::StaticOrder S; S.init(M, 2 * FF, G, bx);
                pg8::EpiSwiGLU E{HID, FF};
                pg8::gemm_phase<pg8::EpiSwiGLU, pg8::StaticOrder, false>(lds, g, S, E);
                SEAM(P + 7);
            }
            if (PHEN(9) && IN(P + 8)) {
            PHASE_PROLOGUE
                pg8::Gemm g{HID, (const bf16*)(ws + WS_W2), M, D, FF, nullptr, 0}; pg8::StaticOrder S; S.init(M, D, G, bx);
                pg8::EpiBf16 E{Y, D, 1.0f};
                pg8::gemm_phase<pg8::EpiBf16, pg8::StaticOrder, false>(lds, g, S, E);
                SEAM(P + 8);
            }
            if (PHEN(10) && IN(P + 9)) {
            PHASE_PROLOGUE
                const float* ng = INP(IN_NORMG) + (size_t)l * 4 * D; const float* ng1 = INP(IN_NORMG) + 4 * D;
                const int m0 = bx * 128 + wave * 16;
                f32x4 a1[4], bvv[4], cvv[4];
                { const float* mod = mod_l + (size_t)(m0 / T) * 6 * D; const float* mod1 = MOD + (size_t)(8 + m0 / T) * 6 * D; load_rowvecs(ng + 3 * D, mod + 5 * D, ng1, mod1 + D, mod1, lane, a1, bvv, cvv); }
                f32x4 yn[4], xn[4];
                ld_row_bf16(Y + (size_t)m0 * D, lane, yn); ld_row_f32(X + (size_t)m0 * D, lane, xn);
#pragma unroll 1
                for (int r = 0; r < 16; ++r) { const int m = m0 + r, mn = m0 + min(r + 1, 15);
                    f32x4 yv[4], xv[4], hv[4];
#pragma unroll
                    for (int j = 0; j < 4; ++j) { yv[j] = yn[j]; xv[j] = xn[j]; }
                    ld_row_bf16(Y + (size_t)mn * D, lane, yn); ld_row_f32(X + (size_t)mn * D, lane, xn);
                    const float rs = row_rstd(yv);
#pragma unroll
                    for (int j = 0; j < 4; ++j) xv[j] = xv[j] + a1[j] * (yv[j] * rs);
                    st_row_f32(X + (size_t)m * D, lane, xv);
                    const float rs2 = row_rstd(xv);
#pragma unroll
                    for (int j = 0; j < 4; ++j) hv[j] = xv[j] * rs2 * bvv[j] + cvv[j];
                    st_row_bf16(H + (size_t)m * D, lane, hv); }
                SEAM(P + 9);
            }
        } else {
            if (PHEN(11) && IN(P + 7)) {
            PHASE_PROLOGUE
                LAS int* sh = (LAS int*)lds;
                if (tid < 8) { int tot = 0, before = 0; for (int w = 0; w < G; ++w) { const int c = WGCNT[w * 8 + tid]; if (w < bx) before += c; tot += c; } sh[24 + tid] = tot; sh[tid] = before; sh[8 + tid] = 0; }
                __syncthreads();
                if (tid == 0) { int ps = 0; for (int e = 0; e < 8; ++e) { sh[16 + e] = ps; ps += (sh[24 + e] + 255) / 256 * 256; }
                    if (bx == 0) { MOEINFO[0] = ps / 256; int blk = 0; for (int e = 0; e < 8; ++e) { const int nb = (sh[24 + e] + 255) / 256; for (int q = 0; q < nb; ++q) MOEINFO[8 + blk++] = e; } for (; blk < MOE_BLKS; ++blk) MOEINFO[8 + blk] = 7; } }
                __syncthreads();
                if (tid < 256) { const int tok = bx * 128 + (tid >> 1), e = TOPI[bx * 256 + tid];
                    const int rank = __hip_atomic_fetch_add(sh + 8 + e, 1, __ATOMIC_RELAXED, __HIP_MEMORY_SCOPE_WORKGROUP); const int dest = sh[16 + e] + sh[e] + rank;
                    DEST[bx * 256 + tid] = dest; ROWTOK[dest] = tok; }
                if (bx < 8 && tid < 256) { const int e = bx, cnt = sh[24 + e], pe = sh[16 + e] + (cnt + 255) / 256 * 256; const int d = sh[16 + e] + cnt + tid; if (d < pe) ROWTOK[d] = 0; }
                __syncthreads();
                SEAM(P + 7);
            }
            for (int part = 0; part < NPART; ++part) {
                const int pm0 = part * PART_BLKS;
                if (PHEN(12) && IN(P + 8 + 2 * part)) {
            PHASE_PROLOGUE
                    const int nblk = MOEINFO[0]; const int nb = min(max(nblk - pm0, 0), PART_BLKS);
                    pg8::Gemm g{H, (const bf16*)(ws + WS_WM13), nb * 256, 2 * FF, D / 2, ROWTOK, 0}; pg8::MoeOrder S; S.init(nb * 256, 2 * FF, G, bx); S.blk_e = MOEINFO + 8; S.pm0 = pm0; S.apm0 = pm0; S.estride = (size_t)2 * FF * D;
                    pg8::EpiSwiGLU8 E{ws + WS_HIDM, FF, 1.0f / (SC_H8 * SC_W13), SC_HID};
                    pg8::gemm_phase<pg8::EpiSwiGLU8, pg8::MoeOrder, true, true>(lds, g, S, E);
                    SEAM(P + 8 + 2 * part);
                }
                if (PHEN(13) && IN(P + 9 + 2 * part)) {
            PHASE_PROLOGUE
                    const int nblk = MOEINFO[0]; const int nb = min(max(nblk - pm0, 0), PART_BLKS);
                    const int fb = min(nb, 256);
                    { pg8::Gemm g{(const bf16*)(ws + WS_HIDM), (const bf16*)(ws + WS_WM2), fb * 256, D, FF / 2, nullptr, 0}; pg8::MoeOrder S; S.init(fb * 256, D, G, bx); S.blk_e = MOEINFO + 8; S.pm0 = pm0; S.apm0 = 0; S.estride = (size_t)D * FF;
                      pg8::EpiBf16 E{(bf16*)(ws + WS_YB) + (size_t)pm0 * 256 * D, D, 1.0f / (SC_HID * SC_W2)};
                      pg8::gemm_phase<pg8::EpiBf16, pg8::MoeOrder, false, true>(lds, g, S, E); }
                    if (nb > 256) {
                        const int ntask = (nb - 256) * 4 * 7, tk = bx, unit = tk / 7, sl = tk % 7;
                        pg8::Gemm g{(const bf16*)(ws + WS_HIDM + (size_t)256 * 256 * FF + (size_t)sl * 512), (const bf16*)(ws + WS_WM2 + (size_t)sl * 512), (nb - 256) * 256, D, 256, nullptr, FF / 2};
                        pg8::TailOrder S; S.blk_e = MOEINFO + 8; S.pm0 = 256; S.unit = unit; S.has = tk < ntask; S.estride = (size_t)D * FF;
                        pg8::EpiBf16 E{(bf16*)(ws + WS_SLAB) + (size_t)sl * 8 * 256 * D, D, 1.0f / (SC_HID * SC_W2)};
                        pg8::gemm_phase<pg8::EpiBf16, pg8::TailOrder, false, true>(lds, g, S, E); }
                    SEAM(P + 9 + 2 * part);
                }
            }
            if (PHEN(14) && IN(P + 8 + 2 * NPART)) {
            PHASE_PROLOGUE
                const bf16* YB = (const bf16*)(ws + WS_YB); const float* ng = INP(IN_NORMG) + (size_t)l * 4 * D;
                const int m0 = bx * 128 + wave * 16;
                f32x4 a1[4];
                { const float* mod = mod_l + (size_t)(m0 / T) * 6 * D;
#pragma unroll
                  for (int j = 0; j < 4; ++j) a1[j] = *(const f32x4*)(ng + 3 * D + 4 * lane + 256 * j) * *(const f32x4*)(mod + 5 * D + 4 * lane + 256 * j); }
                const int dlane = DEST[2 * m0 + (lane & 31)]; const float glane = GATE[2 * m0 + (lane & 31)];
                f32x4 y0n[4], y1n[4], xn[4];
                const bf16* SLAB = (const bf16*)(ws + WS_SLAB);
                { const int d0 = __builtin_amdgcn_readlane(dlane, 0), d1 = __builtin_amdgcn_readlane(dlane, 1);
                  ld_moe_row(YB, SLAB, d0, lane, y0n); ld_moe_row(YB, SLAB, d1, lane, y1n); ld_row_f32(X + (size_t)m0 * D, lane, xn); }
#pragma unroll 1
                for (int r = 0; r < 16; ++r) { const int m = m0 + r, rn = min(r + 1, 15);
                    const float g0 = __builtin_bit_cast(float, __builtin_amdgcn_readlane(__builtin_bit_cast(int, glane), 2 * r)), g1 = __builtin_bit_cast(float, __builtin_amdgcn_readlane(__builtin_bit_cast(int, glane), 2 * r + 1));
                    f32x4 y0[4], y1[4], xv[4];
#pragma unroll
                    for (int j = 0; j < 4; ++j) { y0[j] = y0n[j]; y1[j] = y1n[j]; xv[j] = xn[j]; }
                    { const int d0 = __builtin_amdgcn_readlane(dlane, 2 * rn), d1 = __builtin_amdgcn_readlane(dlane, 2 * rn + 1);
                      ld_moe_row(YB, SLAB, d0, lane, y0n); ld_moe_row(YB, SLAB, d1, lane, y1n); ld_row_f32(X + (size_t)(m0 + rn) * D, lane, xn); }
#pragma unroll
                    for (int j = 0; j < 4; ++j) y0[j] = g0 * y0[j] + g1 * y1[j];
                    const float rs = row_rstd(y0);
#pragma unroll
                    for (int j = 0; j < 4; ++j) xv[j] = xv[j] + a1[j] * (y0[j] * rs);
                    st_row_f32(X + (size_t)m * D, lane, xv); }
            }
        }
}
__global__ void __launch_bounds__(NWAVES * 64, 2) skel_fwd(Args args) {
    extern __shared__ __attribute__((aligned(16))) unsigned char lds_raw[];
    LAS unsigned char* lds = (LAS unsigned char*)lds_raw;
    volatile LAS unsigned* MISC = (volatile LAS unsigned*)(lds + MISC_OFF);
    const int tid0 = threadIdx.x;
    const int G = gridDim.x, bx = blockIdx.x;
    const int vcu = (G % 8 == 0) ? (bx % 8) * (G / 8) + bx / 8 : bx;
    const int NGW = G * NWAVES;
    unsigned char* const ws0 = args.ws;
    unsigned* ctl = (unsigned*)(ws0 + WS_CTL);
    for (int u = tid0; u < 128; u += NWAVES * 64) ((LAS unsigned*)(lds + MISC_OFF))[u] = 0u;
    __syncthreads();
    XcdBarrier bar; bar.bar = ctl; bar.x = 0; bar.st = nullptr;
    if (MK_N_LAUNCHES == 1) bar = xcd_barrier_post(ctl, MISC + 8);
    const int lo = args.ph_lo, hi = args.ph_hi;


    if (PHEN(0) && IN(0)) {
            PHASE_PROLOGUE
        LAS float* scr = (LAS float*)(lds + wave * 16384);
        for (int l = 0; l < 2; ++l) {
            transpose_mat<0>(INP(IN_WIN) + (size_t)l * D * INW, D, INW, (bf16*)(ws + WS_WIN) + (size_t)l * ZW * D, gw, NGW, scr, lane);
            transpose_mat<0>(INP(IN_WOUT) + (size_t)l * D * D, D, D, (bf16*)(ws + WS_WOUT) + (size_t)l * D * D, gw, NGW, scr, lane);
            bf16* pad = (bf16*)(ws + WS_WIN) + (size_t)l * ZW * D + (size_t)INW * D;
            for (int i = gw * 64 + lane; i < (ZW - INW) * D / 8; i += NGW * 64) *(u32x4*)(pad + (size_t)i * 8) = (u32x4){0u, 0u, 0u, 0u};
        }
        transpose_mat<1>(INP(IN_FW1), D, FF, (bf16*)(ws + WS_W13), gw, NGW, scr, lane);
        transpose_mat<2>(INP(IN_FW3), D, FF, (bf16*)(ws + WS_W13), gw, NGW, scr, lane);
        transpose_mat<0>(INP(IN_FW2), FF, D, (bf16*)(ws + WS_W2), gw, NGW, scr, lane);
        __syncthreads();
        {
            LAS float* sc = (LAS float*)lds;
            LAS float* red = (LAS float*)(lds + 32768);
            bool have = false;
            for (int it = vcu; it < 2 * 96; it += G) {
                if (!have) { const float* cin = INP(IN_C); for (int i = tid; i < BATCH * D; i += NWAVES * 64) { const float c = cin[i]; sc[i] = c / (1.0f + __expf(-c)); } __syncthreads(); have = true; }
                const int l = it / 96, n = (it % 96) * 64 + (tid & 63), kg = tid >> 6;
                const float* w = INP(IN_ADAW) + (size_t)l * D * 6 * D + (size_t)(kg * 128) * 6 * D + n;
                float a[8];
#pragma unroll
                for (int b = 0; b < 8; ++b) a[b] = 0.f;
#pragma unroll 1
                for (int k0 = 0; k0 < 128; k0 += 16) { float wv[16];
#pragma unroll
                    for (int q = 0; q < 16; ++q) wv[q] = w[(size_t)(k0 + q) * 6 * D];
#pragma unroll
                    for (int q = 0; q < 16; ++q)
#pragma unroll
                        for (int b = 0; b < 8; ++b) a[b] += sc[b * D + kg * 128 + k0 + q] * wv[q]; }
#pragma unroll
                for (int b = 0; b < 8; ++b) red[(kg * 8 + b) * 64 + (tid & 63)] = a[b];
                __syncthreads();
                if (tid < 512) { const int b = tid >> 6, c = tid & 63; float s_ = 0.f;
#pragma unroll
                    for (int q = 0; q < 8; ++q) s_ += red[(q * 8 + b) * 64 + c];
                    const int nn = (it % 96) * 64 + c;
                    MOD[((size_t)l * 8 + b) * 6 * D + nn] = s_ + INP(IN_ADAB)[(size_t)l * 6 * D + nn]; }
                __syncthreads();
            }
        }
        SEAM(0);
    }
    if (PHEN(1) && IN(1)) {
            PHASE_PROLOGUE
        const float* x_in = INP(IN_X); const float* ng0 = INP(IN_NORMG);
        const int m0 = bx * 128 + wave * 16;
        f32x4 bvv[4], cvv[4], xn[4];
        { const float* mod = MOD + (size_t)(m0 / T) * 6 * D;
#pragma unroll
          for (int j = 0; j < 4; ++j) { const int o = 4 * lane + 256 * j; bvv[j] = *(const f32x4*)(ng0 + o) * (1.0f + *(const f32x4*)(mod + D + o)); cvv[j] = *(const f32x4*)(mod + o); } }
        ld_row_f32(x_in + (size_t)m0 * D, lane, xn);
#pragma unroll 1
        for (int r = 0; r < 16; ++r) { const int m = m0 + r;
            f32x4 xv[4], hv[4];
#pragma unroll
            for (int j = 0; j < 4; ++j) xv[j] = xn[j];
            ld_row_f32(x_in + (size_t)(m0 + min(r + 1, 15)) * D, lane, xn);
            const float rs = row_rstd(xv);
#pragma unroll
            for (int j = 0; j < 4; ++j) hv[j] = xv[j] * rs * bvv[j] + cvv[j];
            st_row_bf16(H + (size_t)m * D, lane, hv); }
        SEAM(1);
    }
    layer_phases<0>(args, ws0, lds, vcu, G, bx, NGW, lo, hi, bar);
    layer_phases<1>(args, ws0, lds, vcu, G, bx, NGW, lo, hi, bar);
#undef IN
#undef SEAM
}
constexpr int N_PHASES = 18 + 8 + 2 * NPART + 1;

extern "C" void kernel_launch(void* const* d_in, const int* in_sizes, int n_in, void* d_out, int out_size, void* d_ws, size_t ws_size, hipStream_t stream) {
    static int grid = 0;
    if (grid == 0) {
        if (n_in != 29 || out_size != M * D || ws_size < WS_END) { fprintf(stderr, "kernel_launch: unexpected shapes (n_in %d out %d ws %zu)\n", n_in, out_size, ws_size); grid = -1; return; }
        int dev = 0, cus = 0;
        if (hipGetDevice(&dev) != hipSuccess || hipDeviceGetAttribute(&cus, hipDeviceAttributeMultiprocessorCount, dev) != hipSuccess) { grid = -1; return; }
        if (hipFuncSetAttribute((const void*)skel_fwd, hipFuncAttributeMaxDynamicSharedMemorySize, LDS_BYTES) != hipSuccess) { fprintf(stderr, "kernel_launch: hipFuncSetAttribute failed\n"); grid = -1; return; }
        int per_cu = 0;
        if (hipOccupancyMaxActiveBlocksPerMultiprocessor(&per_cu, (const void*)skel_fwd, NWAVES * 64, LDS_BYTES) != hipSuccess || per_cu < 1) fprintf(stderr, "kernel_launch: occupancy query reports %d\n", per_cu);
        (void)hipGetLastError();
        grid = cus;
        if (grid != 256) { fprintf(stderr, "kernel_launch: built for 256 CUs, found %d\n", grid); grid = 256; }
    }
    if (grid < 0) return;
    (void)hipMemsetAsync((char*)d_ws + WS_CTL, 0, CTL_ZERO_BYTES, stream);
    Args a{};
    for (int i = 0; i < 29; ++i) a.in[i] = (const float*)d_in[i];
    a.out = (float*)d_out; a.ws = (unsigned char*)d_ws; a.sub = 7;
    if (MK_N_LAUNCHES == 1) {
        a.ph_lo = 0; a.ph_hi = N_PHASES;
        hipLaunchKernelGGL(skel_fwd, dim3(grid), dim3(NWAVES * 64), LDS_BYTES, stream, a);
    } else {
        static const int phases[] = {0, 1, 2, 3, 4, 5, 6, 7, 8, 9, 10, 11, 18, 19, 20, 21, 22, 23, 24, 25, 26, 27, 28};
        for (int p : phases) { a.ph_lo = p % 100; a.ph_hi = p % 100 + 1; a.sub = p >= 100 ? p / 100 : 7; hipLaunchKernelGGL(skel_fwd, dim3(grid), dim3(NWAVES * 64), LDS_BYTES, stream, a); }
    }
}
```

```cpp
#include <hip/hip_runtime.h>
#include <cstdio>
#include <cstdint>

#ifndef MK_N_LAUNCHES
#define MK_N_LAUNCHES 1
#endif

#define GAS __attribute__((address_space(1)))
#define LAS __attribute__((address_space(3)))
typedef unsigned short bf16;
typedef float f32x4 __attribute__((ext_vector_type(4)));
typedef float f32x2 __attribute__((ext_vector_type(2)));
typedef unsigned u32x4 __attribute__((ext_vector_type(4)));
typedef unsigned u32x2 __attribute__((ext_vector_type(2)));
typedef short bf16x8 __attribute__((ext_vector_type(8)));
typedef __bf16 bfx2 __attribute__((ext_vector_type(2)));
typedef short s16x4 __attribute__((ext_vector_type(4)));
typedef int i32x8 __attribute__((ext_vector_type(8)));
typedef int i32x4 __attribute__((ext_vector_type(4)));

constexpr int BATCH = 8, T = 4096, D = 1024, M = BATCH * T;
constexpr int GRID_W = 64, GW = 256;
constexpr int INW = 2688, ZW = 2816;
constexpr int FF = 3584, NE = 8;
constexpr int ZQ = 0, ZK = 256, ZV = 512, ZR = 768, ZLG = 1600, ZP = 1664, ZCB = 1920, ZCC = 2176, ZCH = 2432;
constexpr int RWS = 832;
constexpr float RMS_EPS = 1e-6f, LNX_EPS = 64e-5f;
constexpr int MOE_ROWS = 2 * M + NE * 256, MOE_BLKS = MOE_ROWS / 256;
constexpr int NPART = 1, PART_BLKS = MOE_BLKS;
constexpr float SC_H8 = 8.f, SC_W13 = 32.f, SC_W2 = 64.f, SC_HID = 4.f;

namespace pg8 {
typedef unsigned short bf16_t;
constexpr int BM = 256, BK = 64, HALF = 128, HTB = HALF * BK * 2, STAGE_BYTES = 8 * HTB, NXCD = 8, WGM = 8;
__host__ __device__ __forceinline__ int lds_byte(int r, int c) { const int st = (r >> 4) * 2 + (c >> 5), rr = r & 15, cc = c & 31, ob = rr * 64 + cc * 2; return st * 1024 + (ob ^ (((ob >> 9) & 1) << 5)); }
__host__ __device__ __forceinline__ void stage_rc(int b, int& R, int& C) { const int st = b / 1024, sb = b % 1024, swz = sb ^ (((sb >> 9) & 1) << 5); R = (st >> 1) * 16 + swz / 64; C = (st & 1) * 32 + (swz % 64) / 2; }
__host__ __device__ __forceinline__ int perm32(int rho) { const int n = rho >> 4, i = rho & 15; return 8 * (i >> 2) + 4 * n + (i & 3); }

struct Unit { int pm, pn; };
struct Gemm { const bf16_t* A; const bf16_t* Bt; int M, N, K; const int* rowtok; int ld; };

struct StaticOrder {
    int nM, nN, nwg, G, c;
    __device__ void init(int M_, int N_, int G_, int c_) { nM = M_ / BM; nN = N_ / BM; nwg = nM * nN; G = G_; c = c_; }
    __device__ bool next(int i, Unit& u) const {
        const long L = (long)i * G + c; if (L >= nwg) return false;
        int wgid = (int)L; { const int q = nwg / NXCD, r = nwg % NXCD, xcd = wgid % NXCD, off = wgid / NXCD; wgid = (xcd < r ? xcd * (q + 1) : r * (q + 1) + (xcd - r) * q) + off; }
        const int nig = WGM * nN, gid = wgid / nig, fm = gid * WGM, gsz = (nM - fm) < WGM ? (nM - fm) : WGM;
        u.pm = fm + ((wgid % nig) % gsz); u.pn = (wgid % nig) / gsz; return true;
    }
    __device__ __forceinline__ size_t b_off(const Unit& u, size_t tstep) const { return (size_t)u.pn * tstep; }
    __device__ __forceinline__ int a_blk(const Unit& u) const { return u.pm; }
};
struct ExpertEnds { int e0, e1, e2, e3, e4, e5, e6;
    __device__ __forceinline__ void load(const int* info) { e0 = __builtin_amdgcn_readfirstlane(info[1]); e1 = __builtin_amdgcn_readfirstlane(info[2]); e2 = __builtin_amdgcn_readfirstlane(info[3]); e3 = __builtin_amdgcn_readfirstlane(info[4]);
        e4 = __builtin_amdgcn_readfirstlane(info[5]); e5 = __builtin_amdgcn_readfirstlane(info[6]); e6 = __builtin_amdgcn_readfirstlane(info[7]); }
    __device__ __forceinline__ int expert(int blk) const { return (blk >= e0) + (blk >= e1) + (blk >= e2) + (blk >= e3) + (blk >= e4) + (blk >= e5) + (blk >= e6); } };
struct MoeOrder : StaticOrder {
    ExpertEnds ee; int pm0, apm0; size_t estride;
    __device__ __forceinline__ size_t b_off(const Unit& u, size_t tstep) const { return (size_t)ee.expert(pm0 + u.pm) * estride + (size_t)u.pn * tstep; }
    __device__ __forceinline__ int a_blk(const Unit& u) const { return apm0 + u.pm; }
};

struct TailOrder {
    ExpertEnds ee; int pm0, unit; bool has; size_t estride;
    __device__ bool next(int i, Unit& u) const { if (i > 0 || !has) return false; u.pm = unit >> 2; u.pn = unit & 3; return true; }
    __device__ __forceinline__ size_t b_off(const Unit& u, size_t tstep) const { return (size_t)ee.expert(pm0 + u.pm) * estride + (size_t)u.pn * tstep; }
    __device__ __forceinline__ int a_blk(const Unit& u) const { return u.pm; }
};
__device__ __forceinline__ unsigned cvt_pk_bf16(float lo, float hi) { unsigned r; asm volatile("v_cvt_pk_bf16_f32 %0, %1, %2" : "=v"(r) : "v"(lo), "v"(hi)); return r; }

struct EpiBf16 {
    static constexpr bool PERM = true;
    bf16_t* O; int ldc; float scale;
    __device__ __forceinline__ void operator()(const f32x4 (&acc)[2][2][4][2], const Unit& u, int wr, int wc, int fr, int fq) const {
        const int row0 = u.pm * BM + wr * 64 + fr; const int col0 = u.pn * BM + wc * 32 + 8 * fq;
#pragma unroll
        for (int ai = 0; ai < 2; ++ai)
#pragma unroll
            for (int m = 0; m < 4; ++m) { bf16_t* rowp = O + (size_t)(row0 + ai * HALF + m * 16) * ldc + col0;
#pragma unroll
                for (int bj = 0; bj < 2; ++bj) { const f32x4 v0 = acc[ai][bj][m][0] * scale, v1 = acc[ai][bj][m][1] * scale;
                    u32x4 w; w.x = cvt_pk_bf16(v0[0], v0[1]); w.y = cvt_pk_bf16(v0[2], v0[3]); w.z = cvt_pk_bf16(v1[0], v1[1]); w.w = cvt_pk_bf16(v1[2], v1[3]);
                    *(u32x4*)(rowp + bj * HALF) = w; } }
    }
};
struct EpiSwiGLU {
    static constexpr bool PERM = true;
    bf16_t* O; int ldc;
    __device__ __forceinline__ void operator()(const f32x4 (&acc)[2][2][4][2], const Unit& u, int wr, int wc, int fr, int fq) const {
        const int row0 = u.pm * BM + wr * 64 + fr; const int col0 = u.pn * HALF + wc * 32 + 8 * fq;
#pragma unroll
        for (int ai = 0; ai < 2; ++ai)
#pragma unroll
            for (int m = 0; m < 4; ++m) { bf16_t* rowp = O + (size_t)(row0 + ai * HALF + m * 16) * ldc + col0;
                float h[8];
#pragma unroll
                for (int n = 0; n < 2; ++n)
#pragma unroll
                    for (int x = 0; x < 4; ++x) { const float a = acc[ai][0][m][n][x], b = acc[ai][1][m][n][x]; h[4 * n + x] = a * b * __builtin_amdgcn_rcpf(1.0f + __expf(-a)); }
                u32x4 w; w.x = cvt_pk_bf16(h[0], h[1]); w.y = cvt_pk_bf16(h[2], h[3]); w.z = cvt_pk_bf16(h[4], h[5]); w.w = cvt_pk_bf16(h[6], h[7]);
                *(u32x4*)rowp = w; }
    }
};

__device__ __forceinline__ unsigned cvt4_fp8(float a, float b, float c, float d) {
    a = fminf(fmaxf(a, -448.f), 448.f); b = fminf(fmaxf(b, -448.f), 448.f); c = fminf(fmaxf(c, -448.f), 448.f); d = fminf(fmaxf(d, -448.f), 448.f);
    int r = 0; r = __builtin_amdgcn_cvt_pk_fp8_f32(a, b, r, false); r = __builtin_amdgcn_cvt_pk_fp8_f32(c, d, r, true); return (unsigned)r; }
struct EpiSwiGLU8 {
    static constexpr bool PERM = true;
    unsigned char* O; int ldc; float in_scale, out_scale;
    __device__ __forceinline__ void operator()(const f32x4 (&acc)[2][2][4][2], const Unit& u, int wr, int wc, int fr, int fq) const {
        const int row0 = u.pm * BM + wr * 64 + fr; const int col0 = u.pn * HALF + wc * 32 + 8 * fq;
#pragma unroll
        for (int ai = 0; ai < 2; ++ai)
#pragma unroll
            for (int m = 0; m < 4; ++m) { unsigned char* rowp = O + (size_t)(row0 + ai * HALF + m * 16) * ldc + col0;
                float h[8];
#pragma unroll
                for (int n = 0; n < 2; ++n)
#pragma unroll
                    for (int x = 0; x < 4; ++x) { const float a = acc[ai][0][m][n][x] * in_scale, b = acc[ai][1][m][n][x] * in_scale; h[4 * n + x] = out_scale * a * b * __builtin_amdgcn_rcpf(1.0f + __expf(-a)); }
                u32x2 w; w.x = cvt4_fp8(h[0], h[1], h[2], h[3]); w.y = cvt4_fp8(h[4], h[5], h[6], h[7]);
                *(u32x2*)rowp = w; }
    }
};

template <class Epi, class Sched, bool GATHER, bool FP8 = false>
__device__ __forceinline__ void gemm_phase(LAS unsigned char* lds, const Gemm g, const Sched& S, const Epi& E) {
    int tid_ = threadIdx.x; asm volatile("" : "+v"(tid_));
    const int tid = tid_, wid = __builtin_amdgcn_readfirstlane(tid >> 6), lane = tid & 63, wr = wid >> 2, wc = wid & 3, fr = lane & 15, fq = lane >> 4;
    const int K = g.ld ? g.ld : g.K, nt = g.K / BK;
    const size_t kstep = (size_t)(BK * 2);
    const size_t hstep = (size_t)HALF * K * 2;
    const size_t tstep = 2 * hstep;
    unsigned voffB[2], voffA0[2];
#pragma unroll
    for (int i = 0; i < 2; ++i) { int R, C; stage_rc(tid * 16 + i * 8192, R, C); const int Rb = Epi::PERM ? ((R & ~31) + perm32(R & 31)) : R;
        voffA0[i] = (unsigned)(R * K + C) * 2u; voffB[i] = (unsigned)(Rb * K + C) * 2u; }
    const unsigned ldsw = (unsigned)wid * 1024u;
    const int aoff = lds_byte(wr * 64 + fr, fq * 8), boff = lds_byte(wc * 32 + fr, fq * 8);
#define PG8_SA(b, h) (((b) * 2 + (h)) * HTB)
#define PG8_SB(b, h) ((4 + (b) * 2 + (h)) * HTB)
#define PG8_STAGE(bufoff, gbase, voff) do { _Pragma("unroll") for (int _i = 0; _i < 2; ++_i) \
        __builtin_amdgcn_global_load_lds((const unsigned*)((const char*)(gbase) + (voff)[_i]), (LAS unsigned*)(lds + (bufoff) + ldsw + _i * 8192), 16, 0, 0); } while (0)
#define PG8_LDA(dst, b, h) do { _Pragma("unroll") for (int m = 0; m < 4; ++m) dst[m] = __builtin_shufflevector(*(const LAS i32x4*)(lds + PG8_SA(b, h) + aoff + m * 2048), *(const LAS i32x4*)(lds + PG8_SA(b, h) + aoff + m * 2048 + 1024), 0, 1, 2, 3, 4, 5, 6, 7); } while (0)
#define PG8_LDB(dst, b, h) do { _Pragma("unroll") for (int n = 0; n < 2; ++n) dst[n] = __builtin_shufflevector(*(const LAS i32x4*)(lds + PG8_SB(b, h) + boff + n * 2048), *(const LAS i32x4*)(lds + PG8_SB(b, h) + boff + n * 2048 + 1024), 0, 1, 2, 3, 4, 5, 6, 7); } while (0)
#define PG8_MMA(ai, bj, At, Bt) do { __builtin_amdgcn_s_setprio(1); _Pragma("unroll") for (int m = 0; m < 4; ++m) _Pragma("unroll") for (int n = 0; n < 2; ++n) { \
        if constexpr (FP8) { asm volatile("v_mfma_scale_f32_16x16x128_f8f6f4 %0, %1, %2, %0, %3, %3 op_sel_hi:[0,0,0]" : "+v"(acc[ai][bj][m][n]) : "v"(Bt[n]), "v"(At[m]), "v"(sc1)); } \
        else { acc[ai][bj][m][n] = __builtin_amdgcn_mfma_f32_16x16x32_bf16(__builtin_bit_cast(bf16x8, __builtin_shufflevector(Bt[n], Bt[n], 0, 1, 2, 3)), __builtin_bit_cast(bf16x8, __builtin_shufflevector(At[m], At[m], 0, 1, 2, 3)), acc[ai][bj][m][n], 0, 0, 0); \
               acc[ai][bj][m][n] = __builtin_amdgcn_mfma_f32_16x16x32_bf16(__builtin_bit_cast(bf16x8, __builtin_shufflevector(Bt[n], Bt[n], 4, 5, 6, 7)), __builtin_bit_cast(bf16x8, __builtin_shufflevector(At[m], At[m], 4, 5, 6, 7)), acc[ai][bj][m][n], 0, 0, 0); } } \
        __builtin_amdgcn_s_setprio(0); } while (0)
#define PG8_WAIT_V(n) asm volatile("s_waitcnt vmcnt(" #n ")" ::: "memory")
#define PG8_WAIT_L(n) asm volatile("s_waitcnt lgkmcnt(" #n ")" ::: "memory")
#define PG8_BAR __builtin_amdgcn_s_barrier()
#define PG8_SCHED __builtin_amdgcn_sched_barrier(0)
#define PG8_AOFFS(dst, u) do { if constexpr (GATHER) { const int _rb = S.a_blk(u) * BM; int _t2 = tid; asm volatile("" : "+v"(_t2)); \
            _Pragma("unroll") for (int _h = 0; _h < 2; ++_h) _Pragma("unroll") for (int _i = 0; _i < 2; ++_i) { int _R, _C; stage_rc(_t2 * 16 + _i * 8192, _R, _C); \
            dst[_h][_i] = (unsigned)(g.rowtok[_rb + _h * HALF + _R] * K + _C) * 2u; } } } while (0)
#define PG8_STAGEA(bufoff, gbase, h, NX) do { _Pragma("unroll") for (int _i = 0; _i < 2; ++_i) { \
        const unsigned _o = GATHER ? (((NX) && last) ? vAn[h][_i] : vA[h][_i]) : (voffA0[_i] + (unsigned)((h) * hstep)); \
        __builtin_amdgcn_global_load_lds((const unsigned*)((const char*)(gbase) + _o), (LAS unsigned*)(lds + (bufoff) + ldsw + _i * 8192), 16, 0, 0); } } while (0)
#define PG8_ABASE(u) ((const char*)g.A + (GATHER ? (size_t)0 : (size_t)S.a_blk(u) * tstep))
    LAS unsigned* rtl = (LAS unsigned*)(lds + STAGE_BYTES) + wid * 256;
#define PG8_AOFFS_ASYNC(u) do { if constexpr (GATHER) { const int _rb = S.a_blk(u) * BM; int _t2 = tid; asm volatile("" : "+v"(_t2)); \
            _Pragma("unroll") for (int _h = 0; _h < 2; ++_h) _Pragma("unroll") for (int _i = 0; _i < 2; ++_i) { int _R, _C; stage_rc(_t2 * 16 + _i * 8192, _R, _C); \
            __builtin_amdgcn_global_load_lds((const unsigned*)(g.rowtok + _rb + _h * HALF + _R), (LAS unsigned*)(rtl + (_h * 2 + _i) * 64), 4, 0, 0); } } } while (0)
#define PG8_AOFFS_FINISH(dst) do { if constexpr (GATHER) { int _t2 = tid; asm volatile("" : "+v"(_t2)); \
            _Pragma("unroll") for (int _h = 0; _h < 2; ++_h) _Pragma("unroll") for (int _i = 0; _i < 2; ++_i) { int _R, _C; stage_rc(_t2 * 16 + _i * 8192, _R, _C); \
            dst[_h][_i] = (unsigned)((int)rtl[(_h * 2 + _i) * 64 + lane] * K + _C) * 2u; } } } while (0)
    Unit cur, nxt; int ui = 0;
    if (!S.next(0, cur)) return;
    f32x4 acc[2][2][4][2];
#pragma unroll
    for (int a = 0; a < 2; ++a)
#pragma unroll
        for (int b = 0; b < 2; ++b)
#pragma unroll
            for (int m = 0; m < 4; ++m)
#pragma unroll
                for (int n = 0; n < 2; ++n) acc[a][b][m][n] = (f32x4){0.f, 0.f, 0.f, 0.f};
    i32x8 At[4], B0[2], B1[2]; const int sc1 = 0x7f7f7f7f; (void)sc1;
    unsigned vA[2][2], vAn[2][2]; const bool last = false;
    PG8_AOFFS(vA, cur);
    const char* cA = PG8_ABASE(cur); const char* cB = (const char*)g.Bt + S.b_off(cur, tstep);
    PG8_STAGE(PG8_SB(0, 0), cB, voffB); PG8_STAGE(PG8_SB(0, 1), cB + hstep, voffB); PG8_STAGEA(PG8_SA(0, 0), cA, 0, false); PG8_STAGEA(PG8_SA(0, 1), cA, 1, false);
    if (wr == 1) PG8_BAR;
    PG8_WAIT_V(2); PG8_BAR;
    PG8_STAGE(PG8_SB(1, 0), cB + kstep, voffB); PG8_STAGEA(PG8_SA(1, 0), cA + kstep, 0, false); PG8_STAGE(PG8_SB(1, 1), cB + hstep + kstep, voffB);
    PG8_WAIT_V(6); PG8_BAR;
    for (;;) {
        const bool has_next = S.next(ui + 1, nxt);
        const char* nA = cA; const char* nB = cB;
        if (has_next) { nA = PG8_ABASE(nxt); nB = (const char*)g.Bt + S.b_off(nxt, tstep); PG8_AOFFS_ASYNC(nxt); }
        for (int t = 0; t < nt; t += 2) {
            const bool last = (t == nt - 2);
            if constexpr (GATHER) { if (last) { if (has_next) PG8_AOFFS_FINISH(vAn); else {
#pragma unroll
                for (int h = 0; h < 2; ++h)
#pragma unroll
                    for (int i = 0; i < 2; ++i) vAn[h][i] = vA[h][i]; } } }
            const char* a1 = cA + (size_t)(t + 1) * kstep;
            const char* a2 = last ? nA : cA + (size_t)(t + 2) * kstep; const char* b2 = last ? nB : cB + (size_t)(t + 2) * kstep;
            const char* a3 = a2 + kstep; const char* b3 = b2 + kstep;
            PG8_LDB(B0, 0, 0); PG8_LDB(B1, 0, 1); PG8_SCHED; PG8_LDA(At, 0, 0); PG8_STAGEA(PG8_SA(1, 1), a1, 1, false);
            PG8_WAIT_V(8); PG8_WAIT_L(0); PG8_BAR; PG8_MMA(0, 0, At, B0); PG8_MMA(0, 1, At, B1); PG8_BAR; PG8_SCHED;
            PG8_LDA(At, 0, 1); PG8_STAGE(PG8_SB(0, 0), b2, voffB); PG8_STAGE(PG8_SB(0, 1), b2 + hstep, voffB); PG8_STAGEA(PG8_SA(0, 0), a2, 0, true);
            PG8_WAIT_V(8); PG8_WAIT_L(0); PG8_BAR; PG8_MMA(1, 0, At, B0); PG8_MMA(1, 1, At, B1); PG8_BAR; PG8_SCHED;
            PG8_LDB(B0, 1, 0); PG8_LDB(B1, 1, 1); PG8_SCHED; PG8_LDA(At, 1, 0); PG8_STAGEA(PG8_SA(0, 1), a2, 1, true);
            PG8_WAIT_V(8); PG8_WAIT_L(0); PG8_BAR; PG8_MMA(0, 0, At, B0); PG8_MMA(0, 1, At, B1); PG8_BAR; PG8_SCHED;
            PG8_LDA(At, 1, 1); PG8_STAGE(PG8_SB(1, 0), b3, voffB); PG8_STAGE(PG8_SB(1, 1), b3 + hstep, voffB); PG8_STAGEA(PG8_SA(1, 0), a3, 0, true);
            PG8_WAIT_V(8); PG8_WAIT_L(0); PG8_BAR; PG8_MMA(1, 0, At, B0); PG8_MMA(1, 1, At, B1); PG8_BAR; PG8_SCHED;
        }
        if (wr == 0) PG8_BAR;
        E(acc, cur, wr, wc, fr, fq);
        if (!has_next) break;
#pragma unroll
        for (int a = 0; a < 2; ++a)
#pragma unroll
            for (int b = 0; b < 2; ++b)
#pragma unroll
                for (int m = 0; m < 4; ++m)
#pragma unroll
                    for (int n = 0; n < 2; ++n) acc[a][b][m][n] = (f32x4){0.f, 0.f, 0.f, 0.f};
        cur = nxt; cA = nA; cB = nB; ++ui;
        if constexpr (GATHER) {
#pragma unroll
        for (int h = 0; h < 2; ++h)
#pragma unroll
            for (int i = 0; i < 2; ++i) vA[h][i] = vAn[h][i]; }
        if (wr == 1) PG8_BAR;
    }
    PG8_WAIT_V(0);
    PG8_BAR;
#undef PG8_SA
#undef PG8_SB
#undef PG8_STAGE
#undef PG8_LDA
#undef PG8_LDB
#undef PG8_MMA
#undef PG8_WAIT_V
#undef PG8_WAIT_L
#undef PG8_BAR
#undef PG8_SCHED
#undef PG8_AOFFS
#undef PG8_AOFFS_ASYNC
#undef PG8_AOFFS_FINISH
#undef PG8_STAGEA
#undef PG8_ABASE
}
}

constexpr size_t MiB = 1u << 20;
constexpr size_t WS_CTL = 0, CTL_ZERO_BYTES = 64 * 1024;
constexpr size_t WS_MOD = 1 * MiB;
constexpr size_t WS_TOPI = 2 * MiB;
constexpr size_t WS_GATE = 2 * MiB + 512 * 1024;
constexpr size_t WS_DEST = 3 * MiB;
constexpr size_t WS_ROWTOK = 3 * MiB + 512 * 1024;
constexpr size_t WS_WGCNT = 4 * MiB;
constexpr size_t WS_MOEINFO = 4 * MiB + 64 * 1024;
constexpr size_t WS_SLAB = 8 * MiB;
constexpr size_t WS_WIN = 8 * MiB;
constexpr size_t WS_WOUT = 20 * MiB;
constexpr size_t WS_W13 = 24 * MiB;
constexpr size_t WS_W2 = 38 * MiB;
constexpr size_t WS_H = 48 * MiB;
constexpr size_t ARENA = 112 * MiB;
constexpr size_t WS_Z = ARENA;
constexpr size_t WS_YCAT = ARENA + 176 * MiB;
constexpr size_t WS_SCAN = ARENA + 240 * MiB;
constexpr size_t WS_CH = ARENA + 240 * MiB;
constexpr size_t WS_BONUS = ARENA + 432 * MiB;
constexpr size_t WS_SLG = ARENA + 448 * MiB;
constexpr size_t WS_Y = ARENA;
constexpr size_t WS_HID = ARENA + 64 * MiB;
constexpr size_t WS_WM13 = ARENA + 368 * MiB;
constexpr size_t WS_WM2 = ARENA + 424 * MiB;
constexpr size_t WS_YB = ARENA;
constexpr size_t WS_HIDM = ARENA + 132 * MiB;
constexpr size_t WS_END = ARENA + 454 * MiB;
static_assert(WS_SCAN + (size_t)2 * 8 * 4 * T * 384 * 2 <= WS_END && WS_HID + (size_t)M * FF * 2 <= WS_END && WS_HIDM + (size_t)PART_BLKS * 256 * FF <= WS_END, "ws map");
static_assert(WS_YB + (size_t)MOE_ROWS * D * 2 <= WS_HIDM && WS_HIDM + (size_t)PART_BLKS * 256 * FF <= WS_WM13 && WS_WM13 + (size_t)NE * 2 * FF * D <= WS_WM2 && WS_WM2 + (size_t)NE * D * FF <= WS_END && WS_CH + (size_t)4096 * 16384 * 2 <= WS_WM13, "ws map 2");

constexpr int LDS_BYTES = 163840;
constexpr int SCR_BYTES = 163840 - 512;
constexpr int MISC_OFF = SCR_BYTES;
constexpr int NWAVES = 8;

#define LDS_WAIT() asm volatile("s_waitcnt lgkmcnt(0)" ::: "memory")
#define VM_WAIT() asm volatile("s_waitcnt vmcnt(0)" ::: "memory")
__device__ __forceinline__ unsigned f2bf(float f) { return (unsigned)__builtin_bit_cast(unsigned short, (__bf16)f); }
__device__ __forceinline__ unsigned pk2(float lo, float hi) { bfx2 v; v[0] = (__bf16)lo; v[1] = (__bf16)hi; return __builtin_bit_cast(unsigned, v); }
__device__ __forceinline__ float bf2f(unsigned b) { return __builtin_bit_cast(float, b << 16); }
__device__ __forceinline__ float bflo(unsigned u) { return __builtin_bit_cast(float, u << 16); }
__device__ __forceinline__ float bfhi(unsigned u) { return __builtin_bit_cast(float, u & 0xffff0000u); }
__device__ __forceinline__ float row16_sum(float v);
__device__ __forceinline__ float wave_sum(float v) {
    const int r = __builtin_bit_cast(int, row16_sum(v));
    const float s0 = __builtin_bit_cast(float, __builtin_amdgcn_readlane(r, 0)), s1 = __builtin_bit_cast(float, __builtin_amdgcn_readlane(r, 16)),
                s2 = __builtin_bit_cast(float, __builtin_amdgcn_readlane(r, 32)), s3 = __builtin_bit_cast(float, __builtin_amdgcn_readlane(r, 48));
    return (s0 + s1) + (s2 + s3);
}
__device__ __forceinline__ float row16_sum(float v) {
    v += __builtin_bit_cast(float, __builtin_amdgcn_update_dpp(0, __builtin_bit_cast(int, v), 0x128, 0xf, 0xf, false));
    v += __builtin_bit_cast(float, __builtin_amdgcn_update_dpp(0, __builtin_bit_cast(int, v), 0x124, 0xf, 0xf, false));
    v += __builtin_bit_cast(float, __builtin_amdgcn_update_dpp(0, __builtin_bit_cast(int, v), 0x122, 0xf, 0xf, false));
    v += __builtin_bit_cast(float, __builtin_amdgcn_update_dpp(0, __builtin_bit_cast(int, v), 0x121, 0xf, 0xf, false));
    return v;
}
__device__ __forceinline__ float sigmoidf_(float x) { return __builtin_amdgcn_rcpf(1.0f + __expf(-x)); }

#define XB_TMO      128
#define XB_XCNT(j)  (256  + 64 * (j))
#define XB_XSUB(j)  (1280 + 64 * (j))
#define XB_XGEN(j)  (2304 + 64 * (j))
#define XB_TOP      3328
#define XB_TOPGEN   3392
#define XCD_BAR_WORDS 3456
#define XB_SPIN_CAP (1u << 22)
__device__ __forceinline__ unsigned xb_ld(unsigned* p)              { return __hip_atomic_load(p, __ATOMIC_RELAXED, __HIP_MEMORY_SCOPE_AGENT); }
__device__ __forceinline__ unsigned xb_add(unsigned* p, unsigned v) { return __hip_atomic_fetch_add(p, v, __ATOMIC_RELAXED, __HIP_MEMORY_SCOPE_AGENT); }
__device__ __forceinline__ unsigned xb_xcc_id() { return (unsigned)__builtin_amdgcn_s_getreg((3 << 11) | 20) & 0xFu; }
#define XB_SPIN(cond, bar) do { unsigned _sp = 0; while (cond) { __builtin_amdgcn_s_sleep(1); \
    if ((++_sp & 255u) == 0u) { if (xb_ld(&(bar)[XB_TMO])) break; if (_sp > XB_SPIN_CAP) { atomicAdd(&(bar)[XB_TMO], 1u); break; } } } } while (0)
struct XcdBarrier { unsigned* bar; unsigned x; volatile LAS unsigned* st; };
__device__ __forceinline__ XcdBarrier xcd_barrier_post(unsigned* bar, volatile LAS unsigned* st) {
    XcdBarrier b; b.bar = bar; b.x = xb_xcc_id(); b.st = st;
    if (threadIdx.x == 0) (void)xb_add(&bar[XB_XCNT(b.x)], 1u);
    return b;
}
__device__ __forceinline__ void xcd_barrier_complete(unsigned* bar, unsigned x, unsigned& nloc, unsigned& nx) {
    const unsigned G = gridDim.x * gridDim.y * gridDim.z;
    unsigned sum, cnt, mine, sp = 0u;
    for (;;) {
        sum = 0u; cnt = 0u; mine = 0u;
#pragma unroll
        for (unsigned j = 0; j < 16; ++j) { const unsigned c = xb_ld(&bar[XB_XCNT(j)]); sum += c; cnt += (c > 0u) ? 1u : 0u; mine = (j == x) ? c : mine; }
        if (sum == G) break;
        __builtin_amdgcn_s_sleep(1);
        if ((++sp & 255u) == 0u) { if (xb_ld(&bar[XB_TMO])) break; if (sp > XB_SPIN_CAP) { atomicAdd(&bar[XB_TMO], 1u); break; } }
    }
    nloc = mine > 0u ? mine : 1u; nx = cnt > 0u ? cnt : 1u;
}
__device__ __forceinline__ void xcd_barrier(const XcdBarrier& b) {
    asm volatile("s_waitcnt vmcnt(0)" ::: "memory");
    __syncthreads();
    if (threadIdx.x == 0) {
        unsigned* bar = b.bar;
        __builtin_amdgcn_s_waitcnt(0);
        unsigned nloc = b.st[0], nx = b.st[1];
        if (nloc == 0u) { xcd_barrier_complete(bar, b.x, nloc, nx); b.st[0] = nloc; b.st[1] = nx; }
        const unsigned old = xb_add(&bar[XB_XSUB(b.x)], 1u);
        const unsigned gen = old / nloc;
        if (old + 1u == (gen + 1u) * nloc) {
            __builtin_amdgcn_fence(__ATOMIC_RELEASE, "agent");
            asm volatile("s_waitcnt vmcnt(0)" ::: "memory");
            const unsigned og = xb_add(&bar[XB_TOP], 1u);
            const unsigned tg = og / nx;
            if (og + 1u == (tg + 1u) * nx) xb_add(&bar[XB_TOPGEN], 1u);
            else XB_SPIN(xb_ld(&bar[XB_TOPGEN]) == tg, bar);
            __builtin_amdgcn_fence(__ATOMIC_ACQUIRE, "agent");
            xb_add(&bar[XB_XGEN(b.x)], 1u);
            asm volatile("s_waitcnt vmcnt(0)" ::: "memory");
        } else {
            XB_SPIN(xb_ld(&bar[XB_XGEN(b.x)]) == gen, bar);
            __builtin_amdgcn_fence(__ATOMIC_ACQUIRE, "agent");
            asm volatile("s_waitcnt vmcnt(0)" ::: "memory");
        }
    }
    __syncthreads();
}

struct Args { const float* in[29]; float* out; unsigned char* ws; int ph_lo, ph_hi, sub, pad; };
enum { IN_X = 0, IN_C, IN_ADAW, IN_ADAB, IN_NORMG, IN_WIN, IN_WOUT, IN_RPB, IN_MU, IN_W0, IN_W2L, IN_A0, IN_A2L, IN_KK, IN_KA, IN_RK, IN_LNW, IN_LNB, IN_G2,
       IN_POOLW, IN_POOLS, IN_CONVW, IN_FW1, IN_FW3, IN_FW2, IN_ROUTER, IN_MW1, IN_MW3, IN_MW2 };

__device__ __forceinline__ void transpose_item(const float* W, int K, int N, bf16* WT, int drow0, int k0, int n0, LAS float* scr, int lane) {
#pragma unroll 8
    for (int i = 0; i < 32; ++i) { const int kk = 2 * i + (lane >> 5); scr[kk * 33 + (lane & 31)] = W[(size_t)(k0 + kk) * N + n0 + (lane & 31)]; }
    LDS_WAIT(); asm volatile("" ::: "memory");
    const int c = lane & 7;
#pragma unroll
    for (int j = 0; j < 4; ++j) { const int n = (lane >> 3) + 8 * j; const LAS float* s = scr + (8 * c) * 33 + n;
        u32x4 o; o.x = pk2(s[0 * 33], s[1 * 33]); o.y = pk2(s[2 * 33], s[3 * 33]); o.z = pk2(s[4 * 33], s[5 * 33]); o.w = pk2(s[6 * 33], s[7 * 33]);
        *(u32x4*)(WT + (size_t)(drow0 + n) * K + k0 + 8 * c) = o; }
    LDS_WAIT(); asm volatile("" ::: "memory");
}
__device__ __forceinline__ void transpose_item8(const float* W, int K, int N, unsigned char* WT, int drow0, int k0, int n0, LAS float* scr, int lane, float sc) {
#pragma unroll 8
    for (int i = 0; i < 32; ++i) { const int kk = 2 * i + (lane >> 5); scr[kk * 33 + (lane & 31)] = W[(size_t)(k0 + kk) * N + n0 + (lane & 31)]; }
    LDS_WAIT(); asm volatile("" ::: "memory");
    const int c = lane & 7;
#pragma unroll
    for (int j = 0; j < 4; ++j) { const int n = (lane >> 3) + 8 * j; const LAS float* s = scr + (8 * c) * 33 + n;
        u32x2 o; o.x = pg8::cvt4_fp8(s[0 * 33] * sc, s[1 * 33] * sc, s[2 * 33] * sc, s[3 * 33] * sc); o.y = pg8::cvt4_fp8(s[4 * 33] * sc, s[5 * 33] * sc, s[6 * 33] * sc, s[7 * 33] * sc);
        *(u32x2*)(WT + (size_t)(drow0 + n) * K + k0 + 8 * c) = o; }
    LDS_WAIT(); asm volatile("" ::: "memory");
}
template <int MODE> __device__ __forceinline__ void transpose_mat8(const float* W, int K, int N, unsigned char* WT, int gw, int NGW, LAS float* scr, int lane, float sc) {
    const int nblk = N / 32, nitems = (K / 64) * nblk;
    for (int it = gw; it < nitems; it += NGW) { const int kb = it / nblk, nb = it % nblk, n0 = 32 * nb;
        const int drow0 = MODE == 0 ? n0 : (256 * (n0 >> 7) + (n0 & 127) + (MODE == 2 ? 128 : 0));
        transpose_item8(W, K, N, WT, drow0, 64 * kb, n0, scr, lane, sc); }
}
template <int MODE> __device__ __forceinline__ void transpose_mat(const float* W, int K, int N, bf16* WT, int gw, int NGW, LAS float* scr, int lane) {
    const int nblk = N / 32, nitems = (K / 64) * nblk;
    for (int it = gw; it < nitems; it += NGW) { const int kb = it / nblk, nb = it % nblk, n0 = 32 * nb;
        const int drow0 = MODE == 0 ? n0 : (256 * (n0 >> 7) + (n0 & 127) + (MODE == 2 ? 128 : 0));
        transpose_item(W, K, N, WT, drow0, 64 * kb, n0, scr, lane); }
}

__device__ __forceinline__ void ld_row_f32(const float* p, int lane, f32x4 (&v)[4]) {
#pragma unroll
    for (int j = 0; j < 4; ++j) v[j] = *(const f32x4*)(p + 4 * lane + 256 * j);
}
__device__ __forceinline__ void ld_row_bf16(const bf16* p, int lane, f32x4 (&v)[4]) {
#pragma unroll
    for (int j = 0; j < 4; ++j) { const u32x2 u = *(const u32x2*)(p + 4 * lane + 256 * j); v[j] = (f32x4){bflo(u.x), bfhi(u.x), bflo(u.y), bfhi(u.y)}; }
}
__device__ __forceinline__ void ld_moe_row(const bf16* YB, const bf16* SLAB, int d, int lane, f32x4 (&v)[4]) {
    if (d < 256 * 256) { ld_row_bf16(YB + (size_t)d * D, lane, v); }
    else { const bf16* p = SLAB + (size_t)(d - 256 * 256) * D; ld_row_bf16(p, lane, v);
#pragma unroll 1
        for (int sl = 1; sl < 7; ++sl) { f32x4 t[4]; ld_row_bf16(p + (size_t)sl * 8 * 256 * D, lane, t);
#pragma unroll
            for (int j = 0; j < 4; ++j) v[j] = v[j] + t[j]; } }
}
__device__ __forceinline__ void st_row_bf16(bf16* p, int lane, const f32x4 (&v)[4]) {
#pragma unroll
    for (int j = 0; j < 4; ++j) { u32x2 u; u.x = pk2(v[j][0], v[j][1]); u.y = pk2(v[j][2], v[j][3]); *(u32x2*)(p + 4 * lane + 256 * j) = u; }
}
__device__ __forceinline__ void st_row_f32(float* p, int lane, const f32x4 (&v)[4]) {
#pragma unroll
    for (int j = 0; j < 4; ++j) *(f32x4*)(p + 4 * lane + 256 * j) = v[j];
}
__device__ __forceinline__ float row_rstd(const f32x4 (&v)[4]) {
    float s = 0.f;
#pragma unroll
    for (int j = 0; j < 4; ++j) s += (v[j][0] * v[j][0] + v[j][1] * v[j][1]) + (v[j][2] * v[j][2] + v[j][3] * v[j][3]);
    return 1.0f / sqrtf(wave_sum(s) * (1.0f / D) + RMS_EPS);
}
__device__ __forceinline__ void modulate(const f32x4 (&x)[4], float rstd, const float* g, const float* sc, const float* sh, int lane, f32x4 (&h)[4]) {
    f32x4 gv[4], scv[4], shv[4]; ld_row_f32(g, lane, gv); ld_row_f32(sc, lane, scv); ld_row_f32(sh, lane, shv);
#pragma unroll
    for (int j = 0; j < 4; ++j) h[j] = x[j] * rstd * gv[j] * (1.0f + scv[j]) + shv[j];
}

__device__ __forceinline__ const float* inp_ptr(const Args& a, int i) { asm volatile("" : "+s"(i)); return a.in[i]; }
#define INP(i) inp_ptr(args, (i))
#define mod_l (MOD + (size_t)l * 8 * 6 * D)
#define PHASE_PROLOGUE \
    int tid_l = threadIdx.x; asm volatile("" : "+v"(tid_l)); const int tid = tid_l, lane = tid & 63, wave = __builtin_amdgcn_readfirstlane(tid >> 6), gw = vcu * NWAVES + wave; (void)lane; (void)wave; (void)gw; (void)tid; \
    size_t zofs_ = 0; asm volatile("" : "+s"(zofs_)); unsigned char* const ws = ws0 + zofs_; float* const X = (float*)((unsigned char*)args.out + zofs_);   \
    float* const MOD = (float*)(ws + WS_MOD); bf16* const H = (bf16*)(ws + WS_H); float* const YS = (float*)(ws + WS_H); bf16* const Z = (bf16*)(ws + WS_Z); bf16* const YCAT = (bf16*)(ws + WS_YCAT); \
    bf16* const SCAN = (bf16*)(ws + WS_SCAN); bf16* const Y = (bf16*)(ws + WS_Y); bf16* const HID = (bf16*)(ws + WS_HID); int* const TOPI = (int*)(ws + WS_TOPI); float* const GATE = (float*)(ws + WS_GATE); \
    int* const DEST = (int*)(ws + WS_DEST); int* const ROWTOK = (int*)(ws + WS_ROWTOK); int* const WGCNT = (int*)(ws + WS_WGCNT); int* const MOEINFO = (int*)(ws + WS_MOEINFO); \
    bf16* const CH = (bf16*)(ws + WS_CH); bf16* const BONUS = (bf16*)(ws + WS_BONUS); bf16* const SLG = (bf16*)(ws + WS_SLG); (void)CH; (void)BONUS; (void)SLG; \
    (void)X; (void)MOD; (void)H; (void)YS; (void)Z; (void)YCAT; (void)SCAN; (void)Y; (void)HID; (void)TOPI; (void)GATE; (void)DEST; (void)ROWTOK; (void)WGCNT; (void)MOEINFO;
#ifndef PH_MASK
#define PH_MASK 0xffff
#endif
#define PHEN(i) (((PH_MASK) >> (i)) & 1)
#ifndef SUB_MASK
#define SUB_MASK 7
#endif
#define SUBEN(i) (((SUB_MASK) >> (i)) & 1)
#define IN(k) (lo <= (k) && (k) < hi)
#define SEAM(k) do { if (MK_N_LAUNCHES == 1 && IN((k) + 1)) xcd_barrier(bar); } while (0)
__device__ __forceinline__ void load_rowvecs(const float* g_a, const float* gate, const float* g_b, const float* sc, const float* sh, int lane, f32x4 (&a1)[4], f32x4 (&bv)[4], f32x4 (&cv)[4]) {
#pragma unroll
    for (int j = 0; j < 4; ++j) { const int o = 4 * lane + 256 * j; const f32x4 ga = *(const f32x4*)(g_a + o), gt = *(const f32x4*)(gate + o), gb = *(const f32x4*)(g_b + o), s = *(const f32x4*)(sc + o);
        a1[j] = ga * gt; bv[j] = gb * (1.0f + s); cv[j] = *(const f32x4*)(sh + o); }
}
template <int l> __device__ __forceinline__ void layer_phases(const Args& args, unsigned char* const ws0, LAS unsigned char* lds, const int vcu, const int G, const int bx, const int NGW, const int lo, const int hi, const XcdBarrier& bar) {
        const int P = 2 + 16 * l;
        if (PHEN(2) && IN(P + 0)) {
            PHASE_PROLOGUE
            pg8::Gemm g{H, (const bf16*)(ws + WS_WIN) + (size_t)l * ZW * D, M, ZW, D, nullptr, 0}; pg8::StaticOrder S; S.init(M, ZW, G, bx);
            pg8::EpiBf16 E{Z, ZW, 1.0f};
            pg8::gemm_phase<pg8::EpiBf16, pg8::StaticOrder, false>(lds, g, S, E);
            SEAM(P + 0);
        }
        if (PHEN(3) && IN(P + 1)) {
            PHASE_PROLOGUE
            if (SUBEN(0) && (args.sub & 1)) {
                LAS unsigned char* Ks = lds; LAS unsigned char* Vs = lds + 65536;
                LAS float* rp = (LAS float*)(lds + 131072);
                LAS float* xch = (LAS float*)(lds + 131072 + 2048);
                const float* rpb = INP(IN_RPB) + (size_t)l * 4 * 15 * 31;
                const int qt = wave & 3, half = wave >> 2, r16 = lane & 15, kq = lane >> 4;
                const int q = qt * 16 + r16;
                const int c0 = (qt == 0) ? 0 : (qt == 1) ? 8 : (qt == 2) ? 24 : 32;
                const int cs = min(max(q - 8, 0), 48);
                for (int ub = vcu * 8; ub < BATCH * 4 * 64; ub += G * 8) {
                    const int bh = ub >> 6, b = bh >> 2, hh = bh & 3, r0u = ub & 63;
                    for (int i = tid; i < 465; i += NWAVES * 64) rp[i] = rpb[hh * 465 + i];
                    { const int rs0 = min(max(r0u - 4, 0), 56);
                      for (int i = tid; i < 8192; i += NWAVES * 64) { const int kv = i >> 12, krow = rs0 + ((i >> 9) & 7), col = (i >> 3) & 63, ch = i & 7;
                          const bf16* src = Z + (size_t)(b * T + krow * 64 + col) * ZW + (kv ? ZV : ZK) + hh * 64 + ch * 8;
                          *(LAS u32x4*)((kv ? Vs : Ks) + ((((krow & 7) * 64 + col) << 7) + ((ch ^ (col & 7)) << 4))) = *(const u32x4*)src; } }
                    bf16x8 q0, q1;
                    { const bf16* qp = Z + (size_t)(b * T + r0u * 64 + q) * ZW + ZQ + hh * 64; q0 = *(const bf16x8*)(qp + kq * 8); q1 = *(const bf16x8*)(qp + 32 + kq * 8); }
                    __syncthreads();
#pragma unroll 1
                    for (int k8 = 0; k8 < 8; ++k8) {
                        const int r = r0u + k8;
                        const int rs = min(max(r - 4, 0), 56);
                        const int rn = min(r + 1, 63), rsn = min(max(rn - 4, 0), 56); const bool newrow = (k8 < 7) && (rsn != rs); const int krn = rsn + 7;
                        bf16x8 nq0, nq1; u32x4 st0 = (u32x4){0u, 0u, 0u, 0u}, st1 = st0;
                        { const bf16* qp = Z + (size_t)(b * T + rn * 64 + q) * ZW + ZQ + hh * 64; nq0 = *(const bf16x8*)(qp + kq * 8); nq1 = *(const bf16x8*)(qp + 32 + kq * 8); }
                        { const int col = (tid >> 3) & 63, ch = tid & 7; const bf16* src = Z + (size_t)(b * T + min(krn, 63) * 64 + col) * ZW + hh * 64 + ch * 8;
                            st0 = *(const u32x4*)(src + ZK); st1 = *(const u32x4*)(src + ZV); }
                        float sc[8][4]; float mx = -1e30f;
#pragma unroll
                        for (int kt = 0; kt < 8; ++kt) { const int il = kt >> 1, ch2 = kt & 1, krow = rs + half * 4 + il, colA = c0 + 16 * ch2 + r16;
                            const LAS unsigned char* ka = Ks + ((((krow & 7) * 64 + colA) << 7));
                            const bf16x8 a0 = *(const LAS bf16x8*)(ka + ((kq ^ (colA & 7)) << 4)), a1 = *(const LAS bf16x8*)(ka + (((4 + kq) ^ (colA & 7)) << 4));
                            f32x4 acc = (f32x4){0.f, 0.f, 0.f, 0.f};
                            acc = __builtin_amdgcn_mfma_f32_16x16x32_bf16(a0, q0, acc, 0, 0, 0); acc = __builtin_amdgcn_mfma_f32_16x16x32_bf16(a1, q1, acc, 0, 0, 0);
                            const LAS float* brow = rp + (krow - r + 7) * 31 + (15 - q);
#pragma unroll
                            for (int g = 0; g < 4; ++g) { const int col = c0 + 16 * ch2 + 4 * kq + g; const bool valid = (col >= cs) && (col < cs + 16);
                                const float bias = brow[valid ? col : (q - 15)];
                                const float v = valid ? (acc[g] * 0.125f + bias) : -1e30f; sc[kt][g] = v; mx = fmaxf(mx, v); } }
                        mx = fmaxf(mx, __shfl_xor(mx, 16)); mx = fmaxf(mx, __shfl_xor(mx, 32));
                        float ls = 0.f;
#pragma unroll
                        for (int kt = 0; kt < 8; ++kt)
#pragma unroll
                            for (int g = 0; g < 4; ++g) { const float pv = __expf(sc[kt][g] - mx); sc[kt][g] = pv; ls += pv; }
                        ls += __shfl_xor(ls, 16); ls += __shfl_xor(ls, 32);
                        f32x4 o[4];
#pragma unroll
                        for (int dt = 0; dt < 4; ++dt) o[dt] = (f32x4){0.f, 0.f, 0.f, 0.f};
                        const int qq = r16 >> 2, pp = r16 & 3;
#pragma unroll
                        for (int m2 = 0; m2 < 4; ++m2) { const int krow = rs + half * 4 + m2;
                            u32x4 pb; pb.x = pk2(sc[2 * m2][0], sc[2 * m2][1]); pb.y = pk2(sc[2 * m2][2], sc[2 * m2][3]); pb.z = pk2(sc[2 * m2 + 1][0], sc[2 * m2 + 1][1]); pb.w = pk2(sc[2 * m2 + 1][2], sc[2 * m2 + 1][3]);
                            const bf16x8 bfrag = __builtin_bit_cast(bf16x8, pb);
                            const int col0 = c0 + 4 * kq + qq, col1 = col0 + 16;
                            const LAS unsigned char* v0b = Vs + ((((krow & 7) * 64 + col0) << 7)) + (pp & 1) * 8; const LAS unsigned char* v1b = Vs + ((((krow & 7) * 64 + col1) << 7)) + (pp & 1) * 8;
#pragma unroll
                            for (int dt = 0; dt < 4; ++dt) { const int chn = 2 * dt + (pp >> 1);
                                const s16x4 t0 = __builtin_amdgcn_ds_read_tr16_b64_v4i16((LAS s16x4*)(v0b + ((chn ^ (col0 & 7)) << 4)));
                                const s16x4 t1 = __builtin_amdgcn_ds_read_tr16_b64_v4i16((LAS s16x4*)(v1b + ((chn ^ (col1 & 7)) << 4)));
                                const bf16x8 afrag = (bf16x8){t0[0], t0[1], t0[2], t0[3], t1[0], t1[1], t1[2], t1[3]};
                                o[dt] = __builtin_amdgcn_mfma_f32_16x16x32_bf16(afrag, bfrag, o[dt], 0, 0, 0); } }
                        LAS float* px = xch + q * 68;
                        if (half == 1) {
#pragma unroll
                            for (int dt = 0; dt < 4; ++dt) *(LAS f32x4*)(px + 16 * dt + 4 * kq) = o[dt];
                            if (kq == 0) { px[64] = mx; px[65] = ls; } }
                        __syncthreads();
                        if (half == 0) { const float m1 = px[64], l1 = px[65]; const float mm = fmaxf(mx, m1), f0 = __expf(mx - mm), f1 = __expf(m1 - mm); const float inv = __builtin_amdgcn_rcpf(f0 * ls + f1 * l1);
                            bf16* op = YCAT + (size_t)(b * T + r * 64 + q) * D + hh * 64 + 4 * kq;
#pragma unroll
                            for (int dt = 0; dt < 4; ++dt) { const f32x4 o1 = *(const LAS f32x4*)(px + 16 * dt + 4 * kq); const f32x4 res = (o[dt] * f0 + o1 * f1) * inv;
                                u32x2 w; w.x = pk2(res[0], res[1]); w.y = pk2(res[2], res[3]); *(u32x2*)(op + 16 * dt) = w; } }
                        if (newrow) { const int col = (tid >> 3) & 63, ch = tid & 7; const int off = ((((krn & 7) * 64 + col) << 7) + ((ch ^ (col & 7)) << 4));
                            *(LAS u32x4*)(Ks + off) = st0; *(LAS u32x4*)(Vs + off) = st1; }
                        q0 = nq0; q1 = nq1;
                        __syncthreads();
                    }
                }
            }
            if (SUBEN(1) && (args.sub & 2)) {
                LAS bf16* PWT = (LAS bf16*)lds;
                LAS bf16* DB = PWT + 4 * 64 * 72;
                const int ch = tid & 255, hf = tid >> 8, gq = ch >> 6, hw = 1 << gq;
                { const float* pwp = INP(IN_POOLW) + (size_t)l * 4 * 64 * 64;
                  for (int i = tid; i < 4 * 64 * 64; i += NWAVES * 64) { const int g = i >> 12, c = (i >> 6) & 63, dd = i & 63; PWT[(g * 64 + dd) * 72 + c] = (bf16)f2bf(pwp[i]); } }
                const int r16 = lane & 15, kq = lane >> 4, mg = wave & 3, mtk = wave >> 2;
                f32x4 psc[4];
                { const float* psp = INP(IN_POOLS) + l * GW + mg * 64;
#pragma unroll
                  for (int dt = 0; dt < 4; ++dt) psc[dt] = *(const f32x4*)(psp + dt * 16 + 4 * kq); }
                const float cw0 = INP(IN_CONVW)[(size_t)l * 3 * GW + ch], cw1 = INP(IN_CONVW)[(size_t)l * 3 * GW + GW + ch], cw2 = INP(IN_CONVW)[(size_t)l * 3 * GW + 2 * GW + ch];
                __syncthreads();
                for (int it = vcu; it < M / 32; it += G) {
                    const int b = it >> 7, tb = (it & 127) * 32, t0 = tb + hf * 16;
                    const bf16* zb = Z + (size_t)b * T * ZW;
                    float ps[33]; ps[0] = 0.f;
#pragma unroll
                    for (int i = 0; i < 32; ++i) { const int tp = t0 - 8 + i; const int tc = min(max(tp, 0), T - 1); const float zv = bf2f(zb[(size_t)tc * ZW + ZP + ch]) * ((tp == tc) ? 1.f : 0.f); ps[i + 1] = ps[i] + zv; }
                    float uu[18], bg[16];
#pragma unroll
                    for (int i = 0; i < 18; ++i) { const int tp = t0 - 1 + i; const int tc = min(max(tp, 0), T - 1); uu[i] = bf2f(zb[(size_t)tc * ZW + ZCC + ch]) * bf2f(zb[(size_t)tc * ZW + ZCH + ch]) * ((tp == tc) ? 1.f : 0.f); }
#pragma unroll
                    for (int k = 0; k < 16; ++k) bg[k] = bf2f(zb[(size_t)(t0 + k) * ZW + ZCB + ch]);
#pragma unroll
                    for (int k = 0; k < 16; ++k) { const int t = t0 + k;
                        const int lo_ = max(t - hw, 0), hi_ = min(t + hw, T);
                        float sw;
                        if (gq == 0) sw = ps[k + 9] - ps[k + 7]; else if (gq == 1) sw = ps[k + 10] - ps[k + 6]; else if (gq == 2) sw = ps[k + 12] - ps[k + 4]; else sw = ps[k + 16] - ps[k];
                        const float uq = ps[k + 9] - ps[k + 8];
                        DB[(hf * 16 + k) * 264 + ch] = (bf16)f2bf(sw * __builtin_amdgcn_rcpf((float)(hi_ - lo_)) - uq); }
                    __syncthreads();
                    { const LAS bf16* bp = DB + (mtk * 16 + r16) * 264 + mg * 64 + kq * 8;
                      const bf16x8 b0 = *(const LAS bf16x8*)bp, b1 = *(const LAS bf16x8*)(bp + 32);
                      bf16* op = YCAT + (size_t)(b * T + tb + mtk * 16 + r16) * D + 512 + mg * 64 + 4 * kq;
#pragma unroll
                      for (int dt = 0; dt < 4; ++dt) { const LAS bf16* ap = PWT + (mg * 64 + dt * 16 + r16) * 72 + kq * 8;
                          f32x4 acc = __builtin_amdgcn_mfma_f32_16x16x32_bf16(*(const LAS bf16x8*)ap, b0, (f32x4){0.f, 0.f, 0.f, 0.f}, 0, 0, 0);
                          acc = __builtin_amdgcn_mfma_f32_16x16x32_bf16(*(const LAS bf16x8*)(ap + 32), b1, acc, 0, 0, 0);
                          acc = acc * psc[dt];
                          u32x2 w; w.x = pk2(acc[0], acc[1]); w.y = pk2(acc[2], acc[3]); *(u32x2*)(op + dt * 16) = w; } }
#pragma unroll
                    for (int k = 0; k < 16; ++k) YCAT[(size_t)(b * T + t0 + k) * D + 768 + ch] = (bf16)f2bf(bg[k] * (cw0 * uu[k] + cw1 * uu[k + 1] + cw2 * uu[k + 2]));
                    __syncthreads();
                }
            }
        }
        if (PHEN(4) && IN(P + 2)) {
            PHASE_PROLOGUE
            constexpr int LP = 64, MS = 64 * LP;
            LAS bf16* At = (LAS bf16*)lds; LAS bf16* Rt = At + MS; LAS bf16* Bt = Rt + MS; LAS bf16* Kt = Bt + MS;
            LAS bf16* XT = Kt + MS;
            LAS bf16* BhT = XT + 2 * MS; LAS bf16* KhT = BhT + MS; LAS bf16* VT = KhT + MS;
            LAS bf16* Nb = VT + MS;
            LAS bf16* Mk = Nb + 4 * MS; LAS bf16* Pb = Mk + MS; LAS bf16* Pk = Pb + MS;
            LAS float* tot = (LAS float*)(Pk + MS);
            const int r16 = lane & 15, kq = lane >> 4, sw = r16 & 7;
            const int fo0 = r16 * LP + ((kq ^ sw) << 3), fo1 = r16 * LP + (((4 + kq) ^ sw) << 3);
#define TOFF(y0) (r16 * LP + (((((y0) >> 3) + (kq >> 1)) ^ sw) << 3) + 4 * (kq & 1))
#define LBAR() do { asm volatile("s_waitcnt lgkmcnt(0)" ::: "memory"); __builtin_amdgcn_s_barrier(); asm volatile("" ::: "memory"); } while (0)
#define MMA16H(acc, Ap, Bp, h) do { const bf16x8 _a = *(const LAS bf16x8*)((Ap) + ((h) ? fo1 : fo0)); const bf16x8 _b = *(const LAS bf16x8*)((Bp) + ((h) ? fo1 : fo0)); \
        acc = __builtin_amdgcn_mfma_f32_16x16x32_bf16(_a, _b, acc, 0, 0, 0); } while (0)
#define MMA16(acc, Ap, Bp) do { MMA16H(acc, Ap, Bp, 0); MMA16H(acc, Ap, Bp, 1); } while (0)
#define STORE_T(dst, x0, y0, acc) do { u32x2 _w; _w.x = pk2((acc)[0], (acc)[1]); _w.y = pk2((acc)[2], (acc)[3]); *(LAS u32x2*)((dst) + (x0) * LP + TOFF(y0)) = _w; } while (0)
            const int e = (vcu & 7) >> 2, hh = vcu & 3, cch = hh * 64 + lane;
            LAS bf16* LWT = (LAS bf16*)(tot + 1024);
            LAS bf16* LATW = Pb; LAS bf16* LATA = Pk;
            LAS float* WPA = (LAS float*)Nb;
            { const float* w2p = INP(IN_W2L); const float* a2p = INP(IN_A2L);
              for (int i = tid; i < 4096; i += NWAVES * 64) { const int wh = i >> 11, q = (i >> 6) & 31, cc = i & 63;
                  LWT[(wh * 64 + cc) * 40 + q] = (bf16)f2bf((wh ? a2p : w2p)[((size_t)(l * 2 + e) * 32 + q) * GW + hh * 64 + cc]); } }
            const float w0c = INP(IN_W0)[(size_t)(l * 2 + e) * GW + cch], a0c = INP(IN_A0)[(size_t)(l * 2 + e) * GW + cch];
            const float kkc = INP(IN_KK)[(size_t)l * GW + cch], kac = INP(IN_KA)[(size_t)l * GW + cch];
            float mur, muk, muv, mulat;
            { const float* mu = INP(IN_MU) + (size_t)(l * 2 + e) * RWS; mur = mu[cch]; muk = mu[256 + cch]; muv = mu[512 + cch]; mulat = mu[768 + lane]; }
            __syncthreads();
            float rz[9], kz[9], vz[9], lz[9];
#define E0_LOAD(idx_) do { const int _b = (idx_) >> 6, _ck = (idx_) & 63; int cl_ = cch, jl_ = lane; asm volatile("" : "+v"(cl_), "+v"(jl_)); \
        _Pragma("unroll") for (int x = 0; x < 9; ++x) { const int sidx = _ck * 64 + wave * 8 + x - 1; const int t = e ? (T - 1 - sidx) : sidx; \
            const float okf = (sidx >= 0) ? 1.f : 0.f; const int tcl = min(max(t, 0), T - 1); \
            const bf16* zp = Z + (size_t)(_b * T + tcl) * ZW + ZR; rz[x] = bf2f(zp[cl_]) * okf; kz[x] = bf2f(zp[256 + cl_]) * okf; vz[x] = bf2f(zp[512 + cl_]) * okf; lz[x] = bf2f(zp[768 + jl_]) * okf; } } while (0)
            E0_LOAD(vcu >> 3);
            for (int idx = vcu >> 3; idx < 512; idx += (G >> 3)) {
                const int b = idx >> 6, ck = idx & 63, chain = (e * 8 + b) * 4 + hh, u = chain * 64 + ck;
                for (int rep_ = 0; rep_ <= ((args.sub >> 8) & 1); ++rep_) {
                    const int j = lane, s0 = wave * 8;
#pragma unroll
                    for (int x = 0; x < 8; ++x) { const float zd = lz[x + 1] + mulat * (lz[x] - lz[x + 1]);
                        const float tv = 1.0f - 2.0f * __builtin_amdgcn_rcpf(1.0f + __expf(2.0f * zd));
                        ((j < 32) ? LATW : LATA)[(s0 + x) * LP + ((((j & 31) >> 3) ^ x) << 3) + (j & 7)] = (bf16)f2bf((j < 32) ? tv : zd); }
                    LBAR();
                    { const int wh = wave >> 2, ty = wave & 3;
                      const bf16x8 af = *(const LAS bf16x8*)((wh ? LATA : LATW) + ty * 16 * LP + fo0);
#pragma unroll
                      for (int tx = 0; tx < 4; ++tx) { const bf16x8 bfr = *(const LAS bf16x8*)(LWT + (wh * 64 + tx * 16 + r16) * 40 + kq * 8);
                          const f32x4 acc = __builtin_amdgcn_mfma_f32_16x16x32_bf16(af, bfr, (f32x4){0.f, 0.f, 0.f, 0.f}, 0, 0, 0);
                          *(LAS f32x4*)(WPA + (wh * 64 + tx * 16 + r16) * 68 + ty * 16 + 4 * kq) = acc; } }
                    LBAR();
                    f32x4 wpv[2], apv[2];
                    wpv[0] = *(const LAS f32x4*)(WPA + j * 68 + s0); wpv[1] = *(const LAS f32x4*)(WPA + j * 68 + s0 + 4); apv[0] = *(const LAS f32x4*)(WPA + (64 + j) * 68 + s0); apv[1] = *(const LAS f32x4*)(WPA + (64 + j) * 68 + s0 + 4);
                    float cw[8], lwv[8], rr[8], kk_[8], aa[8], bb[8];
                    float run = 0.f;
#pragma unroll
                    for (int x = 0; x < 8; ++x) {
                        const float r_ = rz[x + 1] + mur * (rz[x] - rz[x + 1]), kk0 = kz[x + 1] + muk * (kz[x] - kz[x + 1]);
                        const float wp = w0c + wpv[x >> 2][x & 3], ap = a0c + apv[x >> 2][x & 3];
                        const float nx = -wp; const float sp = fmaxf(nx, 0.f) + __logf(1.0f + __expf(-fabsf(nx)));
                        lwv[x] = -__expf(-sp - 0.5f);
                        const float av = sigmoidf_(ap);
                        float kk = kk0 * kkc; const float ss = wave_sum(kk * kk); kk *= __builtin_amdgcn_rsqf(fmaxf(ss, 1e-12f));
                        rr[x] = r_; kk_[x] = kk0 * (1.0f + (av - 1.0f) * kac); aa[x] = -kk; bb[x] = kk * av;
                        run += lwv[x]; cw[x] = run; }
                    tot[wave * 64 + j] = run;
                    LBAR();
                    float pre = 0.f, all = 0.f;
#pragma unroll
                    for (int w = 0; w < 8; ++w) { const float v = tot[w * 64 + j]; all += v; pre += (w < wave) ? v : 0.f; }
                    unsigned xt[8], bh[8], kh[8], vt[8];
                    const int rm = (j >> 3) << 3, jl = j & 7;
                    const float wlall = __expf(all); float ewp = __expf(pre); if (wave == 0) tot[512 + j] = wlall;
#pragma unroll
                    for (int x = 0; x < 8; ++x) { const float c = cw[x] + pre; const float ew = __expf(c), ewx = ewp, einv = __builtin_amdgcn_rcpf(ew), eL = wlall * einv; ewp = ew;
                        xt[x] = f2bf(aa[x] * ewx); bh[x] = f2bf(bb[x] * eL); kh[x] = f2bf(kk_[x] * eL); vt[x] = f2bf(vz[x + 1] + muv * (vz[x] - vz[x + 1]));
                        const int ro = (s0 + x) * LP + ((rm ^ (x << 3))) + jl;
                        At[ro] = (bf16)xt[x]; Rt[ro] = (bf16)f2bf(rr[x] * ew); Bt[ro] = (bf16)f2bf(bb[x] * einv); Kt[ro] = (bf16)f2bf(kk_[x] * einv); }
                    const int to = j * LP + ((wave ^ (j & 7)) << 3);
                    u32x4 w4;
                    w4.x = xt[0] | (xt[1] << 16); w4.y = xt[2] | (xt[3] << 16); w4.z = xt[4] | (xt[5] << 16); w4.w = xt[6] | (xt[7] << 16); *(LAS u32x4*)(XT + to) = w4;
                    w4.x = bh[0] | (bh[1] << 16); w4.y = bh[2] | (bh[3] << 16); w4.z = bh[4] | (bh[5] << 16); w4.w = bh[6] | (bh[7] << 16); *(LAS u32x4*)(BhT + to) = w4;
                    w4.x = kh[0] | (kh[1] << 16); w4.y = kh[2] | (kh[3] << 16); w4.z = kh[4] | (kh[5] << 16); w4.w = kh[6] | (kh[7] << 16); *(LAS u32x4*)(KhT + to) = w4;
                    w4.x = vt[0] | (vt[1] << 16); w4.y = vt[2] | (vt[3] << 16); w4.z = vt[4] | (vt[5] << 16); w4.w = vt[6] | (vt[7] << 16); *(LAS u32x4*)(VT + to) = w4;
                    LBAR();
                    if (rep_ == ((args.sub >> 8) & 1)) E0_LOAD(min(idx + (G >> 3), 511));
                }
                for (int rep_ = 0; rep_ <= ((args.sub >> 9) & 1); ++rep_) {
#pragma unroll
                for (int n2 = 0; n2 < 2; ++n2) {
                    const int ty = n2 * 2 + (wave >> 2), tx = wave & 3;
                    const f32x4 z4 = (f32x4){0.f, 0.f, 0.f, 0.f};
                    f32x4 aN = z4, aNT = z4, aMk = z4, aPb = z4, aPk = z4;
                    const LAS bf16* yA = At + ty * 16 * LP; const LAS bf16* yB = Bt + ty * 16 * LP; const LAS bf16* yK = Kt + ty * 16 * LP;
                    const LAS bf16* xA = At + tx * 16 * LP; const LAS bf16* xB = Bt + tx * 16 * LP; const LAS bf16* xR = Rt + tx * 16 * LP;
                    if (ty <= tx) {
                        const bf16x8 yb0 = *(const LAS bf16x8*)(yB + fo0), yb1 = *(const LAS bf16x8*)(yB + fo1), yk0 = *(const LAS bf16x8*)(yK + fo0), yk1 = *(const LAS bf16x8*)(yK + fo1);
                        const bf16x8 xa0 = *(const LAS bf16x8*)(xA + fo0), xa1 = *(const LAS bf16x8*)(xA + fo1), xr0 = *(const LAS bf16x8*)(xR + fo0), xr1 = *(const LAS bf16x8*)(xR + fo1);
                        aN = __builtin_amdgcn_mfma_f32_16x16x32_bf16(yb0, xa0, aN, 0, 0, 0); aMk = __builtin_amdgcn_mfma_f32_16x16x32_bf16(yk0, xa0, aMk, 0, 0, 0);
                        aPb = __builtin_amdgcn_mfma_f32_16x16x32_bf16(yb0, xr0, aPb, 0, 0, 0); aPk = __builtin_amdgcn_mfma_f32_16x16x32_bf16(yk0, xr0, aPk, 0, 0, 0);
                        aN = __builtin_amdgcn_mfma_f32_16x16x32_bf16(yb1, xa1, aN, 0, 0, 0); aMk = __builtin_amdgcn_mfma_f32_16x16x32_bf16(yk1, xa1, aMk, 0, 0, 0);
                        aPb = __builtin_amdgcn_mfma_f32_16x16x32_bf16(yb1, xr1, aPb, 0, 0, 0); aPk = __builtin_amdgcn_mfma_f32_16x16x32_bf16(yk1, xr1, aPk, 0, 0, 0); }
                    if (tx <= ty) {
                        const bf16x8 ya0 = *(const LAS bf16x8*)(yA + fo0), ya1 = *(const LAS bf16x8*)(yA + fo1), xb0 = *(const LAS bf16x8*)(xB + fo0), xb1 = *(const LAS bf16x8*)(xB + fo1);
                        aNT = __builtin_amdgcn_mfma_f32_16x16x32_bf16(ya0, xb0, aNT, 0, 0, 0); aNT = __builtin_amdgcn_mfma_f32_16x16x32_bf16(ya1, xb1, aNT, 0, 0, 0); }
                    if (ty == tx) {
#pragma unroll
                        for (int q = 0; q < 4; ++q) { const int yy = 4 * kq + q; const bool lt = yy < r16, le = yy <= r16;
                            aN[q] = lt ? aN[q] : 0.f; aMk[q] = lt ? aMk[q] : 0.f; aPb[q] = le ? aPb[q] : 0.f; aPk[q] = le ? aPk[q] : 0.f; aNT[q] = (r16 < yy) ? aNT[q] : 0.f; } }
                    STORE_T(Nb, tx * 16, ty * 16, aN); STORE_T(Nb + MS, tx * 16, ty * 16, aNT); STORE_T(Mk, tx * 16, ty * 16, aMk); STORE_T(Pb, tx * 16, ty * 16, aPb); STORE_T(Pk, tx * 16, ty * 16, aPk); asm volatile("" ::: "memory"); }
                LBAR();
                for (int id = wave; id < 16; id += 8) { const int ty = id >> 2, tx = id & 3;
                    f32x4 acc = (f32x4){0.f, 0.f, 0.f, 0.f};
                    MMA16H(acc, Mk + ty * 16 * LP, VT + tx * 16 * LP, 0); if (ty >= 2) MMA16H(acc, Mk + ty * 16 * LP, VT + tx * 16 * LP, 1);
                    STORE_T(XT + MS, tx * 16, ty * 16, acc); }
                LBAR();
                }
                {
                    LAS bf16* Nc = Nb; LAS bf16* NcT = Nb + MS; LAS bf16* Nn = Nb + 2 * MS; LAS bf16* NnT = Nb + 3 * MS;
                    const int which = wave >> 2, wq = wave & 3;
                    const int tt0 = (wq == 0) ? 0 : (wq == 1) ? 3 : (wq == 2) ? 1 : 2, st0 = (wq == 0) ? 0 : (wq == 1) ? 0 : (wq == 2) ? 1 : 2;
                    const int tt1 = (wq == 0) ? 1 : (wq == 1) ? 3 : (wq == 2) ? 2 : 3, st1 = (wq == 0) ? 0 : (wq == 1) ? 1 : (wq == 2) ? 1 : 3;
                    const int tt2 = (wq == 0) ? 2 : (wq == 1) ? 3 : (wq == 2) ? 3 : 1, st2 = (wq == 0) ? 0 : (wq == 1) ? 2 : (wq == 2) ? 3 : 1;
                    const int ty0 = which ? tt0 : st0, tx0 = which ? st0 : tt0, ty1 = which ? tt1 : st1, tx1 = which ? st1 : tt1, ty2 = which ? tt2 : st2, tx2 = which ? st2 : tt2;
                    for (int k = 0; k < 6; ++k) {
                        LAS bf16* Xw = XT + wave * 16 * LP;
                        const bf16x8 b0 = *(const LAS bf16x8*)(Xw + fo0), b1 = *(const LAS bf16x8*)(Xw + fo1);
                        u32x2 c0[4]; bf16x8 a0[4], a1[4];
#pragma unroll
                        for (int ty = 0; ty < 4; ++ty) { c0[ty] = *(const LAS u32x2*)(Xw + TOFF(ty * 16)); a0[ty] = *(const LAS bf16x8*)(Nc + ty * 16 * LP + fo0); a1[ty] = *(const LAS bf16x8*)(Nc + ty * 16 * LP + fo1); }
                        const LAS bf16* sA = which ? Nc : NcT; const LAS bf16* sB = which ? NcT : Nc;
                        const bf16x8 p0 = *(const LAS bf16x8*)(sA + ty0 * 16 * LP + fo0), p1 = *(const LAS bf16x8*)(sA + ty0 * 16 * LP + fo1), q0 = *(const LAS bf16x8*)(sB + tx0 * 16 * LP + fo0), q1 = *(const LAS bf16x8*)(sB + tx0 * 16 * LP + fo1);
                        const bf16x8 p2 = *(const LAS bf16x8*)(sA + ty1 * 16 * LP + fo0), p3 = *(const LAS bf16x8*)(sA + ty1 * 16 * LP + fo1), q2 = *(const LAS bf16x8*)(sB + tx1 * 16 * LP + fo0), q3 = *(const LAS bf16x8*)(sB + tx1 * 16 * LP + fo1);
                        const bf16x8 p4 = *(const LAS bf16x8*)(sA + ty2 * 16 * LP + fo0), p5 = *(const LAS bf16x8*)(sA + ty2 * 16 * LP + fo1), q4 = *(const LAS bf16x8*)(sB + tx2 * 16 * LP + fo0), q5 = *(const LAS bf16x8*)(sB + tx2 * 16 * LP + fo1);
                        f32x4 acc[4];
#pragma unroll
                        for (int ty = 0; ty < 4; ++ty) { acc[ty] = (f32x4){bflo(c0[ty].x), bfhi(c0[ty].x), bflo(c0[ty].y), bfhi(c0[ty].y)};
                            acc[ty] = __builtin_amdgcn_mfma_f32_16x16x32_bf16(a0[ty], b0, acc[ty], 0, 0, 0); acc[ty] = __builtin_amdgcn_mfma_f32_16x16x32_bf16(a1[ty], b1, acc[ty], 0, 0, 0); }
                        const f32x4 z4 = (f32x4){0.f, 0.f, 0.f, 0.f};
                        f32x4 s0a = __builtin_amdgcn_mfma_f32_16x16x32_bf16(p0, q0, z4, 0, 0, 0), s1a = __builtin_amdgcn_mfma_f32_16x16x32_bf16(p2, q2, z4, 0, 0, 0), s2a = __builtin_amdgcn_mfma_f32_16x16x32_bf16(p4, q4, z4, 0, 0, 0);
                        s0a = __builtin_amdgcn_mfma_f32_16x16x32_bf16(p1, q1, s0a, 0, 0, 0); s1a = __builtin_amdgcn_mfma_f32_16x16x32_bf16(p3, q3, s1a, 0, 0, 0); s2a = __builtin_amdgcn_mfma_f32_16x16x32_bf16(p5, q5, s2a, 0, 0, 0);
#pragma unroll
                        for (int ty = 0; ty < 4; ++ty) STORE_T(Xw, 0, ty * 16, acc[ty]);
                        if (k < 5) { LAS bf16* dst = which ? NnT : Nn;
                            STORE_T(dst, tx0 * 16, ty0 * 16, s0a); STORE_T(dst, tx1 * 16, ty1 * 16, s1a); STORE_T(dst, tx2 * 16, ty2 * 16, s2a);
                            if (k == 0) {
                                if (wq < 3) { for (int st = wq + 1; st < 4; ++st) { const int tt = wq; const int tyz = which ? tt : st, txz = which ? st : tt; STORE_T(dst, txz * 16, tyz * 16, z4); } } } }
                        LBAR();
                        { LAS bf16* t0 = Nc; Nc = Nn; Nn = t0; t0 = NcT; NcT = NnT; NnT = t0; }
                    }
                }
                for (int rep_ = 0; rep_ <= ((args.sub >> 10) & 1); ++rep_) {
                    bf16* cho = CH + (size_t)u * 16384;
#pragma unroll
                    for (int n2 = 0; n2 < 2; ++n2) {
                        const int ty = n2 * 2 + (wave >> 2), tx = wave & 3;
                        const int xg = tx * 16 + r16, yg = ty * 16 + 4 * kq;
                        const f32x4 z4 = (f32x4){0.f, 0.f, 0.f, 0.f};
                        f32x4 aRp = z4, aPm = z4, aYl = z4, aQm = z4;
#pragma unroll
                        for (int h = 0; h < 2; ++h) { const int fo = h ? fo1 : fo0;
                            const bf16x8 yU = *(const LAS bf16x8*)(XT + ty * 16 * LP + fo), yPb = *(const LAS bf16x8*)(Pb + ty * 16 * LP + fo), yPk = *(const LAS bf16x8*)(Pk + ty * 16 * LP + fo),
                                         yBh = *(const LAS bf16x8*)(BhT + ty * 16 * LP + fo), yKh = *(const LAS bf16x8*)(KhT + ty * 16 * LP + fo);
                            const bf16x8 xPb = *(const LAS bf16x8*)(Pb + tx * 16 * LP + fo), xBh = *(const LAS bf16x8*)(BhT + tx * 16 * LP + fo), xUv = *(const LAS bf16x8*)(XT + MS + tx * 16 * LP + fo), xV = *(const LAS bf16x8*)(VT + tx * 16 * LP + fo);
                            aRp = __builtin_amdgcn_mfma_f32_16x16x32_bf16(yU, xPb, aRp, 0, 0, 0);
                            aPm = __builtin_amdgcn_mfma_f32_16x16x32_bf16(yU, xBh, aPm, 0, 0, 0);
                            aYl = __builtin_amdgcn_mfma_f32_16x16x32_bf16(yPb, xUv, aYl, 0, 0, 0);
                            aYl = __builtin_amdgcn_mfma_f32_16x16x32_bf16(yPk, xV, aYl, 0, 0, 0);
                            aQm = __builtin_amdgcn_mfma_f32_16x16x32_bf16(yBh, xUv, aQm, 0, 0, 0);
                            aQm = __builtin_amdgcn_mfma_f32_16x16x32_bf16(yKh, xV, aQm, 0, 0, 0); }
                        { const u32x2 c0 = *(const LAS u32x2*)(Rt + tx * 16 * LP + TOFF(ty * 16)); aRp[0] += bflo(c0.x); aRp[1] += bfhi(c0.x); aRp[2] += bflo(c0.y); aRp[3] += bfhi(c0.y); }
                        { const float wl = tot[512 + xg];
#pragma unroll
                          for (int q = 0; q < 4; ++q) aPm[q] += (yg + q == xg) ? wl : 0.f; }
                        u32x2 w2; int lofs = xg * 64 + yg; asm volatile("" : "+v"(lofs));
                        bf16* const cl = cho + lofs;
                        w2.x = pk2(aRp[0], aRp[1]); w2.y = pk2(aRp[2], aRp[3]); *(u32x2*)(cl + 0 * 4096) = w2;
                        w2.x = pk2(aPm[0], aPm[1]); w2.y = pk2(aPm[2], aPm[3]); *(u32x2*)(cl + 1 * 4096) = w2;
                        w2.x = pk2(aYl[0], aYl[1]); w2.y = pk2(aYl[2], aYl[3]); *(u32x2*)(cl + 2 * 4096) = w2;
                        w2.x = pk2(aQm[0], aQm[1]); w2.y = pk2(aQm[2], aQm[3]); *(u32x2*)(cl + 3 * 4096) = w2; asm volatile("" ::: "memory"); }
                }
                LBAR();
            }
#undef E0_LOAD
#undef MMA16
#undef MMA16H
#undef STORE_T
#undef TOFF
#undef LBAR
            SEAM(P + 2);
        }
        if (PHEN(15) && IN(P + 3)) {
            PHASE_PROLOGUE
            constexpr int LP = 72, MS = 16 * LP;
            LAS bf16* Sb = (LAS bf16*)lds;
            const int r16 = lane & 15, kq = lane >> 4, ty = wave & 3, role = wave >> 2;
            for (int wu = bx; wu < 256; wu += G) {
                const int chain = (wu & 7) + 8 * (wu >> 5), it = (wu >> 3) & 3;
                const int e = chain >> 5, b = (chain >> 2) & 7, hh = chain & 3;
                for (int i = tid; i < 2 * MS / 2; i += NWAVES * 64) ((LAS unsigned*)Sb)[i] = 0u;
                __syncthreads();
                const bf16* ch0 = CH + (size_t)chain * 64 * 16384;
                float* ysb = YS + ((size_t)(e * 8 + b) * T) * 256 + hh * 64 + it * 16 + r16;
#define SQ_LOAD(Aq, Cq, c) do { const bf16* _ab = ch0 + (size_t)(c) * 16384 + (role ? 0 : 4096) + (ty * 16 + r16) * 64 + kq * 8; \
        Aq[0] = *(const bf16x8*)_ab; Aq[1] = *(const bf16x8*)(_ab + 32); \
        Cq = *(const u32x2*)(ch0 + (size_t)(c) * 16384 + (role ? 8192 : 12288) + (it * 16 + r16) * 64 + ty * 16 + 4 * kq); } while (0)
#define SQ_STEP(Aq, Cq, c) do { const LAS bf16* _Sc = Sb + ((c) & 1) * MS; LAS bf16* _Sn = Sb + (((c) + 1) & 1) * MS; \
        const bf16x8 _b0 = *(const LAS bf16x8*)(_Sc + r16 * LP + kq * 8), _b1 = *(const LAS bf16x8*)(_Sc + r16 * LP + 32 + kq * 8); \
        f32x4 _acc = (f32x4){bflo(Cq.x), bfhi(Cq.x), bflo(Cq.y), bfhi(Cq.y)}; \
        _acc = __builtin_amdgcn_mfma_f32_16x16x32_bf16(Aq[0], _b0, _acc, 0, 0, 0); _acc = __builtin_amdgcn_mfma_f32_16x16x32_bf16(Aq[1], _b1, _acc, 0, 0, 0); \
        if (role == 0) { u32x2 _w; _w.x = pk2(_acc[0], _acc[1]); _w.y = pk2(_acc[2], _acc[3]); *(LAS u32x2*)(_Sn + r16 * LP + ty * 16 + 4 * kq) = _w; } \
        else { _Pragma("unroll") for (int _q = 0; _q < 4; ++_q) { const int _s = (c) * 64 + ty * 16 + 4 * kq + _q; const int _t = e ? (T - 1 - _s) : _s; ysb[(size_t)_t * 256] = _acc[_q]; } } \
        asm volatile("s_waitcnt lgkmcnt(0)" ::: "memory"); __builtin_amdgcn_s_barrier(); asm volatile("" ::: "memory"); } while (0)
                bf16x8 A0[2], A1[2], A2[2], A3[2], A4[2], A5[2], A6[2], A7[2]; u32x2 C0, C1, C2, C3, C4, C5, C6, C7;
                if constexpr (l == 0) {
                SQ_LOAD(A0, C0, 0); SQ_LOAD(A1, C1, 1); SQ_LOAD(A2, C2, 2); SQ_LOAD(A3, C3, 3); SQ_LOAD(A4, C4, 4); SQ_LOAD(A5, C5, 5); SQ_LOAD(A6, C6, 6);
                for (int c = 0; c < 64; c += 8) {
                    SQ_LOAD(A7, C7, c + 7);
                    SQ_STEP(A0, C0, c);
                    SQ_LOAD(A0, C0, min(c + 8, 63));
                    SQ_STEP(A1, C1, c + 1);
                    SQ_LOAD(A1, C1, min(c + 9, 63));
                    SQ_STEP(A2, C2, c + 2);
                    SQ_LOAD(A2, C2, min(c + 10, 63));
                    SQ_STEP(A3, C3, c + 3);
                    SQ_LOAD(A3, C3, min(c + 11, 63));
                    SQ_STEP(A4, C4, c + 4);
                    SQ_LOAD(A4, C4, min(c + 12, 63));
                    SQ_STEP(A5, C5, c + 5);
                    SQ_LOAD(A5, C5, min(c + 13, 63));
                    SQ_STEP(A6, C6, c + 6);
                    SQ_LOAD(A6, C6, min(c + 14, 63));
                    SQ_STEP(A7, C7, c + 7);
                }
                } else {
                LAS float* scr = (LAS float*)(lds + 8192 + wave * 8448);
                const float* mw1 = INP(IN_MW1); const float* mw3 = INP(IN_MW3); const float* mw2 = INP(IN_MW2);
                float rv[32];
#define CV_DECODE(j_) const int _g = gw + NGW * (j_), _e = _g / 5376, _r = _g % 5376, _wh = _r / 1792, _it = _r % 1792; \
        const int _nblk = (_wh == 2) ? 32 : 112, _kb = _it / _nblk, _nb = _it % _nblk, _N = (_wh == 2) ? D : FF, _K = (_wh == 2) ? FF : D; \
        const float* _src = ((_wh == 0) ? mw1 : (_wh == 1) ? mw3 : mw2) + (size_t)_e * D * FF
#define CV_LOAD(j_) do { CV_DECODE(j_); const float* _w = _src + (size_t)(64 * _kb + (lane >> 5)) * _N + 32 * _nb + (lane & 31); \
        _Pragma("unroll") for (int i = 0; i < 32; ++i) rv[i] = _w[(size_t)(2 * i) * _N]; } while (0)
#define CV_FINISH(j_) do { CV_DECODE(j_); const int _n0 = 32 * _nb, _k0 = 64 * _kb; const float _sc = (_wh == 2) ? SC_W2 : SC_W13; \
        const int _drow0 = (_wh == 2) ? _n0 : (256 * (_n0 >> 7) + (_n0 & 127) + (_wh == 1 ? 128 : 0)); \
        unsigned char* _dst = (_wh == 2) ? (ws + WS_WM2 + (size_t)_e * D * FF) : (ws + WS_WM13 + (size_t)_e * 2 * FF * D); \
        _Pragma("unroll") for (int i = 0; i < 32; ++i) scr[(2 * i + (lane >> 5)) * 33 + (lane & 31)] = rv[i]; \
        LDS_WAIT(); asm volatile("" ::: "memory"); \
        { const int c_ = lane & 7; \
          _Pragma("unroll") for (int j = 0; j < 4; ++j) { const int n = (lane >> 3) + 8 * j; const LAS float* s_ = scr + (8 * c_) * 33 + n; \
            u32x2 o; o.x = pg8::cvt4_fp8(s_[0 * 33] * _sc, s_[1 * 33] * _sc, s_[2 * 33] * _sc, s_[3 * 33] * _sc); o.y = pg8::cvt4_fp8(s_[4 * 33] * _sc, s_[5 * 33] * _sc, s_[6 * 33] * _sc, s_[7 * 33] * _sc); \
            *(u32x2*)(_dst + (size_t)(_drow0 + n) * _K + _k0 + 8 * c_) = o; } } \
        LDS_WAIT(); asm volatile("" ::: "memory"); } while (0)
                SQ_LOAD(A0, C0, 0); SQ_LOAD(A1, C1, 1); SQ_LOAD(A2, C2, 2); SQ_LOAD(A3, C3, 3); SQ_LOAD(A4, C4, 4);
                for (int c = 0; c < 60; c += 6) { const int j0 = (c / 6) * 2;
                    CV_LOAD(j0);
                    SQ_LOAD(A5, C5, c + 5);
                    SQ_STEP(A0, C0, c);     SQ_LOAD(A0, C0, min(c + 6, 63));
                    SQ_STEP(A1, C1, c + 1); SQ_LOAD(A1, C1, min(c + 7, 63));
                    CV_FINISH(j0); CV_LOAD(j0 + 1);
                    SQ_STEP(A2, C2, c + 2); SQ_LOAD(A2, C2, min(c + 8, 63));
                    SQ_STEP(A3, C3, c + 3); SQ_LOAD(A3, C3, min(c + 9, 63));
                    SQ_STEP(A4, C4, c + 4); SQ_LOAD(A4, C4, min(c + 10, 63));
                    CV_FINISH(j0 + 1);
                    SQ_STEP(A5, C5, c + 5);
                }
                CV_LOAD(20);
                SQ_STEP(A0, C0, 60); SQ_STEP(A1, C1, 61);
                CV_FINISH(20);
                SQ_STEP(A2, C2, 62); SQ_STEP(A3, C3, 63);
#undef CV_DECODE
#undef CV_LOAD
#undef CV_FINISH
                }
#undef SQ_LOAD
#undef SQ_STEP
                __syncthreads();
            }
            SEAM(P + 3);
        }
        if (PHEN(5) && IN(P + 4)) {
            PHASE_PROLOGUE
            LAS bf16* G2T = (LAS bf16*)lds;
            LAS bf16* SGB = G2T + 256 * 72;
            LAS float* GT = (LAS float*)(SGB + 16 * 72);
            const int c = tid & 255, hf = tid >> 8, r16 = lane & 15, kq = lane >> 4;
            { const float* g2p = INP(IN_G2) + (size_t)l * 64 * GW;
              for (int i = tid; i < 64 * 256; i += NWAVES * 64) G2T[(i & 255) * 72 + (i >> 8)] = (bf16)f2bf(g2p[i]); }
            const float lw = INP(IN_LNW)[(size_t)l * GW + c], lb = INP(IN_LNB)[(size_t)l * GW + c], rk = INP(IN_RK)[(size_t)l * GW + c];
            for (int it = vcu; it < M / 16; it += G) {
                const int m0 = it * 16;
                for (int i = tid; i < 1024; i += NWAVES * 64) SGB[(i >> 6) * 72 + (i & 63)] = (bf16)f2bf(sigmoidf_(bf2f(Z[(size_t)(m0 + (i >> 6)) * ZW + ZLG + (i & 63)])));
                __syncthreads();
                { const bf16x8 b0 = *(const LAS bf16x8*)(SGB + r16 * 72 + kq * 8), b1 = *(const LAS bf16x8*)(SGB + r16 * 72 + 32 + kq * 8);
#pragma unroll
                  for (int n2 = 0; n2 < 2; ++n2) { const int ct = wave * 2 + n2; const LAS bf16* ap = G2T + (ct * 16 + r16) * 72 + kq * 8;
                      f32x4 acc = __builtin_amdgcn_mfma_f32_16x16x32_bf16(*(const LAS bf16x8*)ap, b0, (f32x4){0.f, 0.f, 0.f, 0.f}, 0, 0, 0);
                      acc = __builtin_amdgcn_mfma_f32_16x16x32_bf16(*(const LAS bf16x8*)(ap + 32), b1, acc, 0, 0, 0);
                      *(LAS f32x4*)(GT + r16 * 260 + ct * 16 + 4 * kq) = acc; } }
                __syncthreads();
                float ya[8], yb[8], r0[8], k0[8], v0[8], res[8];
#pragma unroll
                for (int k = 0; k < 8; ++k) { const int m = m0 + hf * 8 + k; const bf16* zc = Z + (size_t)m * ZW + ZR;
                    ya[k] = YS[(size_t)m * 256 + c]; yb[k] = YS[(size_t)(M + m) * 256 + c]; r0[k] = bf2f(zc[c]); k0[k] = bf2f(zc[256 + c]); v0[k] = bf2f(zc[512 + c]); }
#pragma unroll
                for (int k = 0; k < 8; ++k) { const int tt = hf * 8 + k;
                    const float y = ya[k] + yb[k];
                    const float mean = wave_sum(y) * (1.0f / 64.0f); const float dv = y - mean;
                    const float var = wave_sum(dv * dv) * (1.0f / 64.0f);
                    float yn = dv * __builtin_amdgcn_rsqf(var + LNX_EPS) * lw + lb;
                    yn += wave_sum(r0[k] * k0[k] * rk) * v0[k];
                    res[k] = yn * GT[tt * 260 + c]; }
#pragma unroll
                for (int k = 0; k < 8; ++k) YCAT[(size_t)(m0 + hf * 8 + k) * D + 256 + c] = (bf16)f2bf(res[k]);
                __syncthreads();
            }
            SEAM(P + 4);
        }
        if (PHEN(6) && IN(P + 5)) {
            PHASE_PROLOGUE
            pg8::Gemm g{YCAT, (const bf16*)(ws + WS_WOUT) + (size_t)l * D * D, M, D, D, nullptr, 0}; pg8::StaticOrder S; S.init(M, D, G, bx);
            pg8::EpiBf16 E{Y, D, 1.0f};
            pg8::gemm_phase<pg8::EpiBf16, pg8::StaticOrder, false>(lds, g, S, E);
            SEAM(P + 5);
        }
        if (PHEN(7) && IN(P + 6)) {
            PHASE_PROLOGUE
            LAS float* rw = (LAS float*)lds;
            LAS int* lcnt = (LAS int*)(lds + 32768);
            if (l == 1) { const float* rwp = INP(IN_ROUTER); for (int i = tid; i < D * NE; i += NWAVES * 64) rw[i] = rwp[i]; if (tid < 8) lcnt[tid] = 0; __syncthreads(); }
            const float* xsrc = (l == 0) ? INP(IN_X) : X; const float* ng = INP(IN_NORMG) + (size_t)l * 4 * D;
            const int m0 = bx * 128 + wave * 16;
            f32x4 a1[4], bvv[4], cvv[4];
            { const float* mod = mod_l + (size_t)(m0 / T) * 6 * D; load_rowvecs(ng + 1 * D, mod + 2 * D, ng + 2 * D, mod + 4 * D, mod + 3 * D, lane, a1, bvv, cvv); }
            f32x4 yn[4], xn[4];
            ld_row_bf16(Y + (size_t)m0 * D, lane, yn); ld_row_f32(xsrc + (size_t)m0 * D, lane, xn);
#pragma unroll 1
            for (int r = 0; r < 16; ++r) { const int m = m0 + r, mn = m0 + min(r + 1, 15);
                f32x4 yv[4], xv[4], hv[4];
#pragma unroll
                for (int j = 0; j < 4; ++j) { yv[j] = yn[j]; xv[j] = xn[j]; }
                ld_row_bf16(Y + (size_t)mn * D, lane, yn); ld_row_f32(xsrc + (size_t)mn * D, lane, xn);
                const float rs = row_rstd(yv);
#pragma unroll
                for (int j = 0; j < 4; ++j) xv[j] = xv[j] + a1[j] * (yv[j] * rs);
                st_row_f32(X + (size_t)m * D, lane, xv);
                { const float rs2 = row_rstd(xv);
#pragma unroll
                  for (int j = 0; j < 4; ++j) hv[j] = xv[j] * rs2 * bvv[j] + cvv[j]; }
                if (l == 0) st_row_bf16(H + (size_t)m * D, lane, hv);
                else {
#pragma unroll
                    for (int j = 0; j < 4; ++j) *(unsigned*)((unsigned char*)H + (size_t)m * D + 4 * lane + 256 * j) = pg8::cvt4_fp8(hv[j][0] * SC_H8, hv[j][1] * SC_H8, hv[j][2] * SC_H8, hv[j][3] * SC_H8); }
                if (l == 1) {
                    float lg[8];
#pragma unroll
                    for (int e = 0; e < 8; ++e) lg[e] = 0.f;
#pragma unroll
                    for (int j = 0; j < 4; ++j)
#pragma unroll
                        for (int x = 0; x < 4; ++x) { const LAS float* rr = rw + (4 * lane + 256 * j + x) * 8; const f32x4 w0 = *(const LAS f32x4*)rr, w1 = *(const LAS f32x4*)(rr + 4); const float hx = hv[j][x];
                            lg[0] += hx * w0[0]; lg[1] += hx * w0[1]; lg[2] += hx * w0[2]; lg[3] += hx * w0[3]; lg[4] += hx * w1[0]; lg[5] += hx * w1[1]; lg[6] += hx * w1[2]; lg[7] += hx * w1[3]; }
#pragma unroll
                    for (int e = 0; e < 8; ++e) lg[e] = wave_sum(lg[e]);
                    int i1 = 0; float v1 = lg[0];
#pragma unroll
                    for (int e = 1; e < 8; ++e) if (lg[e] > v1) { v1 = lg[e]; i1 = e; }
                    int i2 = -1; float v2 = -3.0e38f;
#pragma unroll
                    for (int e = 0; e < 8; ++e) if (e != i1 && lg[e] > v2) { v2 = lg[e]; i2 = e; }
                    if (lane == 0) { const float g2 = 1.0f / (1.0f + __expf(v1 - v2)); TOPI[2 * m] = i1; TOPI[2 * m + 1] = i2; GATE[2 * m] = 1.0f - g2; GATE[2 * m + 1] = g2;
                        __hip_atomic_fetch_add(lcnt + i1, 1, __ATOMIC_RELAXED, __HIP_MEMORY_SCOPE_WORKGROUP); __hip_atomic_fetch_add(lcnt + i2, 1, __ATOMIC_RELAXED, __HIP_MEMORY_SCOPE_WORKGROUP); }
                }
            }
            if (l == 1) { __syncthreads(); if (tid < 8) WGCNT[bx * 8 + tid] = lcnt[tid]; }
            SEAM(P + 6);
        }
        if (l == 0) {
            if (PHEN(8) && IN(P + 7)) {
            PHASE_PROLOGUE
                pg8::Gemm g{H, (const bf16*)(ws + WS_W13), M, 2 * FF, D, nullptr, 0}; pg8::StaticOrder S; S.init(M, 2 * FF, G, bx);
                pg8::EpiSwiGLU E{HID, FF};
                pg8::gemm_phase<pg8::EpiSwiGLU, pg8::StaticOrder, false>(lds, g, S, E);
                SEAM(P + 7);
            }
            if (PHEN(9) && IN(P + 8)) {
            PHASE_PROLOGUE
                pg8::Gemm g{HID, (const bf16*)(ws + WS_W2), M, D, FF, nullptr, 0}; pg8::StaticOrder S; S.init(M, D, G, bx);
                pg8::EpiBf16 E{Y, D, 1.0f};
                pg8::gemm_phase<pg8::EpiBf16, pg8::StaticOrder, false>(lds, g, S, E);
                SEAM(P + 8);
            }
            if (PHEN(10) && IN(P + 9)) {
            PHASE_PROLOGUE
                const float* ng = INP(IN_NORMG) + (size_t)l * 4 * D; const float* ng1 = INP(IN_NORMG) + 4 * D;
                const int m0 = bx * 128 + wave * 16;
                f32x4 a1[4], bvv[4], cvv[4];
                { const float* mod = mod_l + (size_t)(m0 / T) * 6 * D; const float* mod1 = MOD + (size_t)(8 + m0 / T) * 6 * D; load_rowvecs(ng + 3 * D, mod + 5 * D, ng1, mod1 + D, mod1, lane, a1, bvv, cvv); }
                f32x4 yn[4], xn[4];
                ld_row_bf16(Y + (size_t)m0 * D, lane, yn); ld_row_f32(X + (size_t)m0 * D, lane, xn);
#pragma unroll 1
                for (int r = 0; r < 16; ++r) { const int m = m0 + r, mn = m0 + min(r + 1, 15);
                    f32x4 yv[4], xv[4], hv[4];
#pragma unroll
                    for (int j = 0; j < 4; ++j) { yv[j] = yn[j]; xv[j] = xn[j]; }
                    ld_row_bf16(Y + (size_t)mn * D, lane, yn); ld_row_f32(X + (size_t)mn * D, lane, xn);
                    const float rs = row_rstd(yv);
#pragma unroll
                    for (int j = 0; j < 4; ++j) xv[j] = xv[j] + a1[j] * (yv[j] * rs);
                    st_row_f32(X + (size_t)m * D, lane, xv);
                    const float rs2 = row_rstd(xv);
#pragma unroll
                    for (int j = 0; j < 4; ++j) hv[j] = xv[j] * rs2 * bvv[j] + cvv[j];
                    st_row_bf16(H + (size_t)m * D, lane, hv); }
                SEAM(P + 9);
            }
        } else {
            if (PHEN(11) && IN(P + 7)) {
            PHASE_PROLOGUE
                LAS int* sh = (LAS int*)lds;
                if (tid < 8) { int tot = 0, before = 0; for (int w = 0; w < G; ++w) { const int c = WGCNT[w * 8 + tid]; if (w < bx) before += c; tot += c; } sh[24 + tid] = tot; sh[tid] = before; sh[8 + tid] = 0; }
                __syncthreads();
                if (tid == 0) { int ps = 0; for (int e = 0; e < 8; ++e) { sh[16 + e] = ps; ps += (sh[24 + e] + 255) / 256 * 256; }
                    if (bx == 0) { MOEINFO[0] = ps / 256; { int pe = 0; for (int e = 0; e < 7; ++e) { pe += (sh[24 + e] + 255) / 256; MOEINFO[1 + e] = pe; } } int blk = 0; for (int e = 0; e < 8; ++e) { const int nb = (sh[24 + e] + 255) / 256; for (int q = 0; q < nb; ++q) MOEINFO[8 + blk++] = e; } for (; blk < MOE_BLKS; ++blk) MOEINFO[8 + blk] = 7; } }
                __syncthreads();
                if (tid < 256) { const int tok = bx * 128 + (tid >> 1), e = TOPI[bx * 256 + tid];
                    const int rank = __hip_atomic_fetch_add(sh + 8 + e, 1, __ATOMIC_RELAXED, __HIP_MEMORY_SCOPE_WORKGROUP); const int dest = sh[16 + e] + sh[e] + rank;
                    DEST[bx * 256 + tid] = dest; ROWTOK[dest] = tok; }
                if (bx < 8 && tid < 256) { const int e = bx, cnt = sh[24 + e], pe = sh[16 + e] + (cnt + 255) / 256 * 256; const int d = sh[16 + e] + cnt + tid; if (d < pe) ROWTOK[d] = 0; }
                __syncthreads();
                SEAM(P + 7);
            }
            for (int part = 0; part < NPART; ++part) {
                const int pm0 = part * PART_BLKS;
                if (PHEN(12) && IN(P + 8 + 2 * part)) {
            PHASE_PROLOGUE
                    const int nblk = MOEINFO[0]; const int nb = min(max(nblk - pm0, 0), PART_BLKS);
                    pg8::Gemm g{H, (const bf16*)(ws + WS_WM13), nb * 256, 2 * FF, D / 2, ROWTOK, 0}; pg8::MoeOrder S; S.init(nb * 256, 2 * FF, G, bx); S.ee.load(MOEINFO); S.pm0 = pm0; S.apm0 = pm0; S.estride = (size_t)2 * FF * D;
                    pg8::EpiSwiGLU8 E{ws + WS_HIDM, FF, 1.0f / (SC_H8 * SC_W13), SC_HID};
                    pg8::gemm_phase<pg8::EpiSwiGLU8, pg8::MoeOrder, true, true>(lds, g, S, E);
                    SEAM(P + 8 + 2 * part);
                }
                if (PHEN(13) && IN(P + 9 + 2 * part)) {
            PHASE_PROLOGUE
                    const int nblk = MOEINFO[0]; const int nb = min(max(nblk - pm0, 0), PART_BLKS);
                    const int fb = min(nb, 256);
                    { pg8::Gemm g{(const bf16*)(ws + WS_HIDM), (const bf16*)(ws + WS_WM2), fb * 256, D, FF / 2, nullptr, 0}; pg8::MoeOrder S; S.init(fb * 256, D, G, bx); S.ee.load(MOEINFO); S.pm0 = pm0; S.apm0 = 0; S.estride = (size_t)D * FF;
                      pg8::EpiBf16 E{(bf16*)(ws + WS_YB) + (size_t)pm0 * 256 * D, D, 1.0f / (SC_HID * SC_W2)};
                      pg8::gemm_phase<pg8::EpiBf16, pg8::MoeOrder, false, true>(lds, g, S, E); }
                    if (nb > 256) {
                        const int ntask = (nb - 256) * 4 * 7, tk = bx, unit = tk / 7, sl = tk % 7;
                        pg8::Gemm g{(const bf16*)(ws + WS_HIDM + (size_t)256 * 256 * FF + (size_t)sl * 512), (const bf16*)(ws + WS_WM2 + (size_t)sl * 512), (nb - 256) * 256, D, 256, nullptr, FF / 2};
                        pg8::TailOrder S; S.ee.load(MOEINFO); S.pm0 = 256; S.unit = unit; S.has = tk < ntask; S.estride = (size_t)D * FF;
                        pg8::EpiBf16 E{(bf16*)(ws + WS_SLAB) + (size_t)sl * 8 * 256 * D, D, 1.0f / (SC_HID * SC_W2)};
                        pg8::gemm_phase<pg8::EpiBf16, pg8::TailOrder, false, true>(lds, g, S, E); }
                    SEAM(P + 9 + 2 * part);
                }
            }
            if (PHEN(14) && IN(P + 8 + 2 * NPART)) {
            PHASE_PROLOGUE
                const bf16* YB = (const bf16*)(ws + WS_YB); const float* ng = INP(IN_NORMG) + (size_t)l * 4 * D;
                const int m0 = bx * 128 + wave * 16;
                f32x4 a1[4];
                { const float* mod = mod_l + (size_t)(m0 / T) * 6 * D;
#pragma unroll
                  for (int j = 0; j < 4; ++j) a1[j] = *(const f32x4*)(ng + 3 * D + 4 * lane + 256 * j) * *(const f32x4*)(mod + 5 * D + 4 * lane + 256 * j); }
                const int dlane = DEST[2 * m0 + (lane & 31)]; const float glane = GATE[2 * m0 + (lane & 31)];
                f32x4 y0n[4], y1n[4], xn[4];
                const bf16* SLAB = (const bf16*)(ws + WS_SLAB);
                { const int d0 = __builtin_amdgcn_readlane(dlane, 0), d1 = __builtin_amdgcn_readlane(dlane, 1);
                  ld_moe_row(YB, SLAB, d0, lane, y0n); ld_moe_row(YB, SLAB, d1, lane, y1n); ld_row_f32(X + (size_t)m0 * D, lane, xn); }
#pragma unroll 1
                for (int r = 0; r < 16; ++r) { const int m = m0 + r, rn = min(r + 1, 15);
                    const float g0 = __builtin_bit_cast(float, __builtin_amdgcn_readlane(__builtin_bit_cast(int, glane), 2 * r)), g1 = __builtin_bit_cast(float, __builtin_amdgcn_readlane(__builtin_bit_cast(int, glane), 2 * r + 1));
                    f32x4 y0[4], y1[4], xv[4];
#pragma unroll
                    for (int j = 0; j < 4; ++j) { y0[j] = y0n[j]; y1[j] = y1n[j]; xv[j] = xn[j]; }
                    { const int d0 = __builtin_amdgcn_readlane(dlane, 2 * rn), d1 = __builtin_amdgcn_readlane(dlane, 2 * rn + 1);
                      ld_moe_row(YB, SLAB, d0, lane, y0n); ld_moe_row(YB, SLAB, d1, lane, y1n); ld_row_f32(X + (size_t)(m0 + rn) * D, lane, xn); }
#pragma unroll
                    for (int j = 0; j < 4; ++j) y0[j] = g0 * y0[j] + g1 * y1[j];
                    const float rs = row_rstd(y0);
#pragma unroll
                    for (int j = 0; j < 4; ++j) xv[j] = xv[j] + a1[j] * (y0[j] * rs);
                    st_row_f32(X + (size_t)m * D, lane, xv); }
            }
        }
}
__global__ void __launch_bounds__(NWAVES * 64, 2) skel_fwd(Args args) {
    extern __shared__ __attribute__((aligned(16))) unsigned char lds_raw[];
    LAS unsigned char* lds = (LAS unsigned char*)lds_raw;
    volatile LAS unsigned* MISC = (volatile LAS unsigned*)(lds + MISC_OFF);
    const int tid0 = threadIdx.x;
    const int G = gridDim.x, bx = blockIdx.x;
    const int vcu = (G % 8 == 0) ? (bx % 8) * (G / 8) + bx / 8 : bx;
    const int NGW = G * NWAVES;
    unsigned char* const ws0 = args.ws;
    unsigned* ctl = (unsigned*)(ws0 + WS_CTL);
    for (int u = tid0; u < 128; u += NWAVES * 64) ((LAS unsigned*)(lds + MISC_OFF))[u] = 0u;
    __syncthreads();
    XcdBarrier bar; bar.bar = ctl; bar.x = 0; bar.st = nullptr;
    if (MK_N_LAUNCHES == 1) bar = xcd_barrier_post(ctl, MISC + 8);
    const int lo = args.ph_lo, hi = args.ph_hi;


    if (PHEN(0) && IN(0)) {
            PHASE_PROLOGUE
        LAS float* scr = (LAS float*)(lds + wave * 16384);
        for (int l = 0; l < 2; ++l) {
            transpose_mat<0>(INP(IN_WIN) + (size_t)l * D * INW, D, INW, (bf16*)(ws + WS_WIN) + (size_t)l * ZW * D, gw, NGW, scr, lane);
            transpose_mat<0>(INP(IN_WOUT) + (size_t)l * D * D, D, D, (bf16*)(ws + WS_WOUT) + (size_t)l * D * D, gw, NGW, scr, lane);
            bf16* pad = (bf16*)(ws + WS_WIN) + (size_t)l * ZW * D + (size_t)INW * D;
            for (int i = gw * 64 + lane; i < (ZW - INW) * D / 8; i += NGW * 64) *(u32x4*)(pad + (size_t)i * 8) = (u32x4){0u, 0u, 0u, 0u};
        }
        transpose_mat<1>(INP(IN_FW1), D, FF, (bf16*)(ws + WS_W13), gw, NGW, scr, lane);
        transpose_mat<2>(INP(IN_FW3), D, FF, (bf16*)(ws + WS_W13), gw, NGW, scr, lane);
        transpose_mat<0>(INP(IN_FW2), FF, D, (bf16*)(ws + WS_W2), gw, NGW, scr, lane);
        __syncthreads();
        {
            LAS float* sc = (LAS float*)lds;
            LAS float* red = (LAS float*)(lds + 32768);
            bool have = false;
            for (int it = vcu; it < 2 * 96; it += G) {
                if (!have) { const float* cin = INP(IN_C); for (int i = tid; i < BATCH * D; i += NWAVES * 64) { const float c = cin[i]; sc[i] = c / (1.0f + __expf(-c)); } __syncthreads(); have = true; }
                const int l = it / 96, n = (it % 96) * 64 + (tid & 63), kg = tid >> 6;
                const float* w = INP(IN_ADAW) + (size_t)l * D * 6 * D + (size_t)(kg * 128) * 6 * D + n;
                float a[8];
#pragma unroll
                for (int b = 0; b < 8; ++b) a[b] = 0.f;
#pragma unroll 1
                for (int k0 = 0; k0 < 128; k0 += 16) { float wv[16];
#pragma unroll
                    for (int q = 0; q < 16; ++q) wv[q] = w[(size_t)(k0 + q) * 6 * D];
#pragma unroll
                    for (int q = 0; q < 16; ++q)
#pragma unroll
                        for (int b = 0; b < 8; ++b) a[b] += sc[b * D + kg * 128 + k0 + q] * wv[q]; }
#pragma unroll
                for (int b = 0; b < 8; ++b) red[(kg * 8 + b) * 64 + (tid & 63)] = a[b];
                __syncthreads();
                if (tid < 512) { const int b = tid >> 6, c = tid & 63; float s_ = 0.f;
#pragma unroll
                    for (int q = 0; q < 8; ++q) s_ += red[(q * 8 + b) * 64 + c];
                    const int nn = (it % 96) * 64 + c;
                    MOD[((size_t)l * 8 + b) * 6 * D + nn] = s_ + INP(IN_ADAB)[(size_t)l * 6 * D + nn]; }
                __syncthreads();
            }
        }
        SEAM(0);
    }
    if (PHEN(1) && IN(1)) {
            PHASE_PROLOGUE
        const float* x_in = INP(IN_X); const float* ng0 = INP(IN_NORMG);
        const int m0 = bx * 128 + wave * 16;
        f32x4 bvv[4], cvv[4], xn[4];
        { const float* mod = MOD + (size_t)(m0 / T) * 6 * D;
#pragma unroll
          for (int j = 0; j < 4; ++j) { const int o = 4 * lane + 256 * j; bvv[j] = *(const f32x4*)(ng0 + o) * (1.0f + *(const f32x4*)(mod + D + o)); cvv[j] = *(const f32x4*)(mod + o); } }
        ld_row_f32(x_in + (size_t)m0 * D, lane, xn);
#pragma unroll 1
        for (int r = 0; r < 16; ++r) { const int m = m0 + r;
            f32x4 xv[4], hv[4];
#pragma unroll
            for (int j = 0; j < 4; ++j) xv[j] = xn[j];
            ld_row_f32(x_in + (size_t)(m0 + min(r + 1, 15)) * D, lane, xn);
            const float rs = row_rstd(xv);
#pragma unroll
            for (int j = 0; j < 4; ++j) hv[j] = xv[j] * rs * bvv[j] + cvv[j];
            st_row_bf16(H + (size_t)m * D, lane, hv); }
        SEAM(1);
    }
    layer_phases<0>(args, ws0, lds, vcu, G, bx, NGW, lo, hi, bar);
    layer_phases<1>(args, ws0, lds, vcu, G, bx, NGW, lo, hi, bar);
#undef IN
#undef SEAM
}
constexpr int N_PHASES = 18 + 8 + 2 * NPART + 1;

extern "C" void kernel_launch(void* const* d_in, const int* in_sizes, int n_in, void* d_out, int out_size, void* d_ws, size_t ws_size, hipStream_t stream) {
    static int grid = 0;
    if (grid == 0) {
        if (n_in != 29 || out_size != M * D || ws_size < WS_END) { fprintf(stderr, "kernel_launch: unexpected shapes (n_in %d out %d ws %zu)\n", n_in, out_size, ws_size); grid = -1; return; }
        int dev = 0, cus = 0;
        if (hipGetDevice(&dev) != hipSuccess || hipDeviceGetAttribute(&cus, hipDeviceAttributeMultiprocessorCount, dev) != hipSuccess) { grid = -1; return; }
        if (hipFuncSetAttribute((const void*)skel_fwd, hipFuncAttributeMaxDynamicSharedMemorySize, LDS_BYTES) != hipSuccess) { fprintf(stderr, "kernel_launch: hipFuncSetAttribute failed\n"); grid = -1; return; }
        int per_cu = 0;
        if (hipOccupancyMaxActiveBlocksPerMultiprocessor(&per_cu, (const void*)skel_fwd, NWAVES * 64, LDS_BYTES) != hipSuccess || per_cu < 1) fprintf(stderr, "kernel_launch: occupancy query reports %d\n", per_cu);
        (void)hipGetLastError();
        grid = cus;
        if (grid != 256) { fprintf(stderr, "kernel_launch: built for 256 CUs, found %d\n", grid); grid = 256; }
    }
    if (grid < 0) return;
    (void)hipMemsetAsync((char*)d_ws + WS_CTL, 0, CTL_ZERO_BYTES, stream);
    Args a{};
    for (int i = 0; i < 29; ++i) a.in[i] = (const float*)d_in[i];
    a.out = (float*)d_out; a.ws = (unsigned char*)d_ws; a.sub = 7;
    if (MK_N_LAUNCHES == 1) {
        a.ph_lo = 0; a.ph_hi = N_PHASES;
        hipLaunchKernelGGL(skel_fwd, dim3(grid), dim3(NWAVES * 64), LDS_BYTES, stream, a);
    } else {
        static const int phases[] = {0, 1, 2, 3, 4, 5, 6, 7, 8, 9, 10, 11, 18, 19, 20, 21, 22, 23, 24, 25, 26, 27, 28};
        for (int p : phases) { a.ph_lo = p % 100; a.ph_hi = p % 100 + 1; a.sub = p >= 100 ? p / 100 : 7; hipLaunchKernelGGL(skel_fwd, dim3(grid), dim3(NWAVES * 64), LDS_BYTES, stream, a); }
    }
}
```

```cpp
#include <hip/hip_runtime.h>
#include <cstdio>
#include <cstdint>

#ifndef MK_N_LAUNCHES
#define MK_N_LAUNCHES 1
#endif

#define GAS __attribute__((address_space(1)))
#define LAS __attribute__((address_space(3)))
typedef unsigned short bf16;
typedef float f32x4 __attribute__((ext_vector_type(4)));
typedef float f32x2 __attribute__((ext_vector_type(2)));
typedef unsigned u32x4 __attribute__((ext_vector_type(4)));
typedef unsigned u32x2 __attribute__((ext_vector_type(2)));
typedef short bf16x8 __attribute__((ext_vector_type(8)));
typedef __bf16 bfx2 __attribute__((ext_vector_type(2)));
typedef short s16x4 __attribute__((ext_vector_type(4)));
typedef int i32x8 __attribute__((ext_vector_type(8)));
typedef int i32x4 __attribute__((ext_vector_type(4)));

constexpr int BATCH = 8, T = 4096, D = 1024, M = BATCH * T;
constexpr int GRID_W = 64, GW = 256;
constexpr int INW = 2688, ZW = 2816;
constexpr int FF = 3584, NE = 8;
constexpr int ZQ = 0, ZK = 256, ZV = 512, ZR = 768, ZLG = 1600, ZP = 1664, ZCB = 1920, ZCC = 2176, ZCH = 2432;
constexpr int RWS = 832;
constexpr float RMS_EPS = 1e-6f, LNX_EPS = 64e-5f;
constexpr int MOE_ROWS = 2 * M + NE * 256, MOE_BLKS = MOE_ROWS / 256;
constexpr int NPART = 1, PART_BLKS = MOE_BLKS;
constexpr float SC_H8 = 8.f, SC_W13 = 32.f, SC_W2 = 64.f, SC_HID = 4.f;

namespace pg8 {
typedef unsigned short bf16_t;
constexpr int BM = 256, BK = 64, HALF = 128, HTB = HALF * BK * 2, STAGE_BYTES = 8 * HTB, NXCD = 8, WGM = 8;
__host__ __device__ __forceinline__ int lds_byte(int r, int c) { const int st = (r >> 4) * 2 + (c >> 5), rr = r & 15, cc = c & 31, ob = rr * 64 + cc * 2; return st * 1024 + (ob ^ (((ob >> 9) & 1) << 5)); }
__host__ __device__ __forceinline__ void stage_rc(int b, int& R, int& C) { const int st = b / 1024, sb = b % 1024, swz = sb ^ (((sb >> 9) & 1) << 5); R = (st >> 1) * 16 + swz / 64; C = (st & 1) * 32 + (swz % 64) / 2; }
__host__ __device__ __forceinline__ int perm32(int rho) { const int n = rho >> 4, i = rho & 15; return 8 * (i >> 2) + 4 * n + (i & 3); }

struct Unit { int pm, pn; };
struct Gemm { const bf16_t* A; const bf16_t* Bt; int M, N, K; const int* rowtok; int ld; };

struct StaticOrder {
    int nM, nN, nwg, G, c;
    __device__ void init(int M_, int N_, int G_, int c_) { nM = M_ / BM; nN = N_ / BM; nwg = nM * nN; G = G_; c = c_; }
    __device__ bool next(int i, Unit& u) const {
        const long L = (long)i * G + c; if (L >= nwg) return false;
        int wgid = (int)L; { const int q = nwg / NXCD, r = nwg % NXCD, xcd = wgid % NXCD, off = wgid / NXCD; wgid = (xcd < r ? xcd * (q + 1) : r * (q + 1) + (xcd - r) * q) + off; }
        const int nig = WGM * nN, gid = wgid / nig, fm = gid * WGM, gsz = (nM - fm) < WGM ? (nM - fm) : WGM;
        u.pm = fm + ((wgid % nig) % gsz); u.pn = (wgid % nig) / gsz; return true;
    }
    __device__ __forceinline__ size_t b_off(const Unit& u, size_t tstep) const { return (size_t)u.pn * tstep; }
    __device__ __forceinline__ int a_blk(const Unit& u) const { return u.pm; }
};
struct ExpertEnds { int e0, e1, e2, e3, e4, e5, e6;
    __device__ __forceinline__ void load(const int* info) { e0 = __builtin_amdgcn_readfirstlane(info[1]); e1 = __builtin_amdgcn_readfirstlane(info[2]); e2 = __builtin_amdgcn_readfirstlane(info[3]); e3 = __builtin_amdgcn_readfirstlane(info[4]);
        e4 = __builtin_amdgcn_readfirstlane(info[5]); e5 = __builtin_amdgcn_readfirstlane(info[6]); e6 = __builtin_amdgcn_readfirstlane(info[7]); }
    __device__ __forceinline__ int expert(int blk) const { return (blk >= e0) + (blk >= e1) + (blk >= e2) + (blk >= e3) + (blk >= e4) + (blk >= e5) + (blk >= e6); } };
struct MoeOrder : StaticOrder {
    ExpertEnds ee; int pm0, apm0; size_t estride;
    __device__ __forceinline__ size_t b_off(const Unit& u, size_t tstep) const { return (size_t)ee.expert(pm0 + u.pm) * estride + (size_t)u.pn * tstep; }
    __device__ __forceinline__ int a_blk(const Unit& u) const { return apm0 + u.pm; }
};

struct TailOrder {
    ExpertEnds ee; int pm0, unit; bool has; size_t estride;
    __device__ bool next(int i, Unit& u) const { if (i > 0 || !has) return false; u.pm = unit >> 2; u.pn = unit & 3; return true; }
    __device__ __forceinline__ size_t b_off(const Unit& u, size_t tstep) const { return (size_t)ee.expert(pm0 + u.pm) * estride + (size_t)u.pn * tstep; }
    __device__ __forceinline__ int a_blk(const Unit& u) const { return u.pm; }
};
__device__ __forceinline__ unsigned cvt_pk_bf16(float lo, float hi) { unsigned r; asm volatile("v_cvt_pk_bf16_f32 %0, %1, %2" : "=v"(r) : "v"(lo), "v"(hi)); return r; }

struct EpiBf16 {
    static constexpr bool PERM = true;
    bf16_t* O; int ldc; float scale;
    __device__ __forceinline__ void operator()(const f32x4 (&acc)[2][2][4][2], const Unit& u, int wr, int wc, int fr, int fq) const {
        const int row0 = u.pm * BM + wr * 64 + fr; const int col0 = u.pn * BM + wc * 32 + 8 * fq;
#pragma unroll
        for (int ai = 0; ai < 2; ++ai)
#pragma unroll
            for (int m = 0; m < 4; ++m) { bf16_t* rowp = O + (size_t)(row0 + ai * HALF + m * 16) * ldc + col0;
#pragma unroll
                for (int bj = 0; bj < 2; ++bj) { const f32x4 v0 = acc[ai][bj][m][0] * scale, v1 = acc[ai][bj][m][1] * scale;
                    u32x4 w; w.x = cvt_pk_bf16(v0[0], v0[1]); w.y = cvt_pk_bf16(v0[2], v0[3]); w.z = cvt_pk_bf16(v1[0], v1[1]); w.w = cvt_pk_bf16(v1[2], v1[3]);
                    *(u32x4*)(rowp + bj * HALF) = w; } }
    }
};
struct EpiSwiGLU {
    static constexpr bool PERM = true;
    bf16_t* O; int ldc;
    __device__ __forceinline__ void operator()(const f32x4 (&acc)[2][2][4][2], const Unit& u, int wr, int wc, int fr, int fq) const {
        const int row0 = u.pm * BM + wr * 64 + fr; const int col0 = u.pn * HALF + wc * 32 + 8 * fq;
#pragma unroll
        for (int ai = 0; ai < 2; ++ai)
#pragma unroll
            for (int m = 0; m < 4; ++m) { bf16_t* rowp = O + (size_t)(row0 + ai * HALF + m * 16) * ldc + col0;
                float h[8];
#pragma unroll
                for (int n = 0; n < 2; ++n)
#pragma unroll
                    for (int x = 0; x < 4; ++x) { const float a = acc[ai][0][m][n][x], b = acc[ai][1][m][n][x]; h[4 * n + x] = a * b * __builtin_amdgcn_rcpf(1.0f + __expf(-a)); }
                u32x4 w; w.x = cvt_pk_bf16(h[0], h[1]); w.y = cvt_pk_bf16(h[2], h[3]); w.z = cvt_pk_bf16(h[4], h[5]); w.w = cvt_pk_bf16(h[6], h[7]);
                *(u32x4*)rowp = w; }
    }
};

__device__ __forceinline__ unsigned cvt4_fp8(float a, float b, float c, float d) {
    a = fminf(fmaxf(a, -448.f), 448.f); b = fminf(fmaxf(b, -448.f), 448.f); c = fminf(fmaxf(c, -448.f), 448.f); d = fminf(fmaxf(d, -448.f), 448.f);
    int r = 0; r = __builtin_amdgcn_cvt_pk_fp8_f32(a, b, r, false); r = __builtin_amdgcn_cvt_pk_fp8_f32(c, d, r, true); return (unsigned)r; }
struct EpiSwiGLU8 {
    static constexpr bool PERM = true;
    unsigned char* O; int ldc; float in_scale, out_scale;
    __device__ __forceinline__ void operator()(const f32x4 (&acc)[2][2][4][2], const Unit& u, int wr, int wc, int fr, int fq) const {
        const int row0 = u.pm * BM + wr * 64 + fr; const int col0 = u.pn * HALF + wc * 32 + 8 * fq;
#pragma unroll
        for (int ai = 0; ai < 2; ++ai)
#pragma unroll
            for (int m = 0; m < 4; ++m) { unsigned char* rowp = O + (size_t)(row0 + ai * HALF + m * 16) * ldc + col0;
                float h[8];
#pragma unroll
                for (int n = 0; n < 2; ++n)
#pragma unroll
                    for (int x = 0; x < 4; ++x) { const float a = acc[ai][0][m][n][x] * in_scale, b = acc[ai][1][m][n][x] * in_scale; h[4 * n + x] = out_scale * a * b * __builtin_amdgcn_rcpf(1.0f + __expf(-a)); }
                u32x2 w; w.x = cvt4_fp8(h[0], h[1], h[2], h[3]); w.y = cvt4_fp8(h[4], h[5], h[6], h[7]);
                *(u32x2*)rowp = w; }
    }
};

template <class Epi, class Sched, bool GATHER, bool FP8 = false>
__device__ __forceinline__ void gemm_phase(LAS unsigned char* lds, const Gemm g, const Sched& S, const Epi& E) {
    int tid_ = threadIdx.x; asm volatile("" : "+v"(tid_));
    const int tid = tid_, wid = __builtin_amdgcn_readfirstlane(tid >> 6), lane = tid & 63, wr = wid >> 2, wc = wid & 3, fr = lane & 15, fq = lane >> 4;
    const int K = g.ld ? g.ld : g.K, nt = g.K / BK;
    const size_t kstep = (size_t)(BK * 2);
    const size_t hstep = (size_t)HALF * K * 2;
    const size_t tstep = 2 * hstep;
    unsigned voffB[2], voffA0[2];
#pragma unroll
    for (int i = 0; i < 2; ++i) { int R, C; stage_rc(tid * 16 + i * 8192, R, C); const int Rb = Epi::PERM ? ((R & ~31) + perm32(R & 31)) : R;
        voffA0[i] = (unsigned)(R * K + C) * 2u; voffB[i] = (unsigned)(Rb * K + C) * 2u; }
    const unsigned ldsw = (unsigned)wid * 1024u;
    const int aoff = lds_byte(wr * 64 + fr, fq * 8), boff = lds_byte(wc * 32 + fr, fq * 8);
#define PG8_SA(b, h) (((b) * 2 + (h)) * HTB)
#define PG8_SB(b, h) ((4 + (b) * 2 + (h)) * HTB)
#define PG8_STAGE(bufoff, gbase, voff) do { _Pragma("unroll") for (int _i = 0; _i < 2; ++_i) \
        __builtin_amdgcn_global_load_lds((const unsigned*)((const char*)(gbase) + (voff)[_i]), (LAS unsigned*)(lds + (bufoff) + ldsw + _i * 8192), 16, 0, 0); } while (0)
#define PG8_LDA(dst, b, h) do { _Pragma("unroll") for (int m = 0; m < 4; ++m) dst[m] = __builtin_shufflevector(*(const LAS i32x4*)(lds + PG8_SA(b, h) + aoff + m * 2048), *(const LAS i32x4*)(lds + PG8_SA(b, h) + aoff + m * 2048 + 1024), 0, 1, 2, 3, 4, 5, 6, 7); } while (0)
#define PG8_LDB(dst, b, h) do { _Pragma("unroll") for (int n = 0; n < 2; ++n) dst[n] = __builtin_shufflevector(*(const LAS i32x4*)(lds + PG8_SB(b, h) + boff + n * 2048), *(const LAS i32x4*)(lds + PG8_SB(b, h) + boff + n * 2048 + 1024), 0, 1, 2, 3, 4, 5, 6, 7); } while (0)
#define PG8_MMA(ai, bj, At, Bt) do { __builtin_amdgcn_s_setprio(1); _Pragma("unroll") for (int m = 0; m < 4; ++m) _Pragma("unroll") for (int n = 0; n < 2; ++n) { \
        if constexpr (FP8) { asm volatile("v_mfma_scale_f32_16x16x128_f8f6f4 %0, %1, %2, %0, %3, %3 op_sel_hi:[0,0,0]" : "+v"(acc[ai][bj][m][n]) : "v"(Bt[n]), "v"(At[m]), "v"(sc1)); } \
        else { acc[ai][bj][m][n] = __builtin_amdgcn_mfma_f32_16x16x32_bf16(__builtin_bit_cast(bf16x8, __builtin_shufflevector(Bt[n], Bt[n], 0, 1, 2, 3)), __builtin_bit_cast(bf16x8, __builtin_shufflevector(At[m], At[m], 0, 1, 2, 3)), acc[ai][bj][m][n], 0, 0, 0); \
               acc[ai][bj][m][n] = __builtin_amdgcn_mfma_f32_16x16x32_bf16(__builtin_bit_cast(bf16x8, __builtin_shufflevector(Bt[n], Bt[n], 4, 5, 6, 7)), __builtin_bit_cast(bf16x8, __builtin_shufflevector(At[m], At[m], 4, 5, 6, 7)), acc[ai][bj][m][n], 0, 0, 0); } } \
        __builtin_amdgcn_s_setprio(0); } while (0)
#define PG8_WAIT_V(n) asm volatile("s_waitcnt vmcnt(" #n ")" ::: "memory")
#define PG8_WAIT_L(n) asm volatile("s_waitcnt lgkmcnt(" #n ")" ::: "memory")
#define PG8_BAR __builtin_amdgcn_s_barrier()
#define PG8_SCHED __builtin_amdgcn_sched_barrier(0)
#define PG8_AOFFS(dst, u) do { if constexpr (GATHER) { const int _rb = S.a_blk(u) * BM; int _t2 = tid; asm volatile("" : "+v"(_t2)); \
            _Pragma("unroll") for (int _h = 0; _h < 2; ++_h) _Pragma("unroll") for (int _i = 0; _i < 2; ++_i) { int _R, _C; stage_rc(_t2 * 16 + _i * 8192, _R, _C); \
            dst[_h][_i] = (unsigned)(g.rowtok[_rb + _h * HALF + _R] * K + _C) * 2u; } } } while (0)
#define PG8_STAGEA(bufoff, gbase, h, NX) do { _Pragma("unroll") for (int _i = 0; _i < 2; ++_i) { \
        const unsigned _o = GATHER ? (((NX) && last) ? vAn[h][_i] : vA[h][_i]) : (voffA0[_i] + (unsigned)((h) * hstep)); \
        __builtin_amdgcn_global_load_lds((const unsigned*)((const char*)(gbase) + _o), (LAS unsigned*)(lds + (bufoff) + ldsw + _i * 8192), 16, 0, 0); } } while (0)
#define PG8_ABASE(u) ((const char*)g.A + (GATHER ? (size_t)0 : (size_t)S.a_blk(u) * tstep))
    LAS unsigned* rtl = (LAS unsigned*)(lds + STAGE_BYTES) + wid * 256;
#define PG8_AOFFS_ASYNC(u) do { if constexpr (GATHER) { const int _rb = S.a_blk(u) * BM; int _t2 = tid; asm volatile("" : "+v"(_t2)); \
            _Pragma("unroll") for (int _h = 0; _h < 2; ++_h) _Pragma("unroll") for (int _i = 0; _i < 2; ++_i) { int _R, _C; stage_rc(_t2 * 16 + _i * 8192, _R, _C); \
            __builtin_amdgcn_global_load_lds((const unsigned*)(g.rowtok + _rb + _h * HALF + _R), (LAS unsigned*)(rtl + (_h * 2 + _i) * 64), 4, 0, 0); } } } while (0)
#define PG8_AOFFS_FINISH(dst) do { if constexpr (GATHER) { int _t2 = tid; asm volatile("" : "+v"(_t2)); \
            _Pragma("unroll") for (int _h = 0; _h < 2; ++_h) _Pragma("unroll") for (int _i = 0; _i < 2; ++_i) { int _R, _C; stage_rc(_t2 * 16 + _i * 8192, _R, _C); \
            dst[_h][_i] = (unsigned)((int)rtl[(_h * 2 + _i) * 64 + lane] * K + _C) * 2u; } } } while (0)
    Unit cur, nxt; int ui = 0;
    if (!S.next(0, cur)) return;
    f32x4 acc[2][2][4][2];
#pragma unroll
    for (int a = 0; a < 2; ++a)
#pragma unroll
        for (int b = 0; b < 2; ++b)
#pragma unroll
            for (int m = 0; m < 4; ++m)
#pragma unroll
                for (int n = 0; n < 2; ++n) acc[a][b][m][n] = (f32x4){0.f, 0.f, 0.f, 0.f};
    i32x8 At[4], B0[2], B1[2]; const int sc1 = 0x7f7f7f7f; (void)sc1;
    unsigned vA[2][2], vAn[2][2]; const bool last = false;
    PG8_AOFFS(vA, cur);
    const char* cA = PG8_ABASE(cur); const char* cB = (const char*)g.Bt + S.b_off(cur, tstep);
    PG8_STAGE(PG8_SB(0, 0), cB, voffB); PG8_STAGE(PG8_SB(0, 1), cB + hstep, voffB); PG8_STAGEA(PG8_SA(0, 0), cA, 0, false); PG8_STAGEA(PG8_SA(0, 1), cA, 1, false);
    if (wr == 1) PG8_BAR;
    PG8_WAIT_V(2); PG8_BAR;
    PG8_STAGE(PG8_SB(1, 0), cB + kstep, voffB); PG8_STAGEA(PG8_SA(1, 0), cA + kstep, 0, false); PG8_STAGE(PG8_SB(1, 1), cB + hstep + kstep, voffB);
    PG8_WAIT_V(6); PG8_BAR;
    for (;;) {
        const bool has_next = S.next(ui + 1, nxt);
        const char* nA = cA; const char* nB = cB;
        if (has_next) { nA = PG8_ABASE(nxt); nB = (const char*)g.Bt + S.b_off(nxt, tstep); PG8_AOFFS_ASYNC(nxt); }
        for (int t = 0; t < nt; t += 2) {
            const bool last = (t == nt - 2);
            if constexpr (GATHER) { if (last) { if (has_next) PG8_AOFFS_FINISH(vAn); else {
#pragma unroll
                for (int h = 0; h < 2; ++h)
#pragma unroll
                    for (int i = 0; i < 2; ++i) vAn[h][i] = vA[h][i]; } } }
            const char* a1 = cA + (size_t)(t + 1) * kstep;
            const char* a2 = last ? nA : cA + (size_t)(t + 2) * kstep; const char* b2 = last ? nB : cB + (size_t)(t + 2) * kstep;
            const char* a3 = a2 + kstep; const char* b3 = b2 + kstep;
            PG8_LDB(B0, 0, 0); PG8_LDB(B1, 0, 1); PG8_SCHED; PG8_LDA(At, 0, 0); PG8_STAGEA(PG8_SA(1, 1), a1, 1, false);
            PG8_WAIT_V(8); PG8_WAIT_L(0); PG8_BAR; PG8_MMA(0, 0, At, B0); PG8_MMA(0, 1, At, B1); PG8_BAR; PG8_SCHED;
            PG8_LDA(At, 0, 1); PG8_STAGE(PG8_SB(0, 0), b2, voffB); PG8_STAGE(PG8_SB(0, 1), b2 + hstep, voffB); PG8_STAGEA(PG8_SA(0, 0), a2, 0, true);
            PG8_WAIT_V(8); PG8_WAIT_L(0); PG8_BAR; PG8_MMA(1, 0, At, B0); PG8_MMA(1, 1, At, B1); PG8_BAR; PG8_SCHED;
            PG8_LDB(B0, 1, 0); PG8_LDB(B1, 1, 1); PG8_SCHED; PG8_LDA(At, 1, 0); PG8_STAGEA(PG8_SA(0, 1), a2, 1, true);
            PG8_WAIT_V(8); PG8_WAIT_L(0); PG8_BAR; PG8_MMA(0, 0, At, B0); PG8_MMA(0, 1, At, B1); PG8_BAR; PG8_SCHED;
            PG8_LDA(At, 1, 1); PG8_STAGE(PG8_SB(1, 0), b3, voffB); PG8_STAGE(PG8_SB(1, 1), b3 + hstep, voffB); PG8_STAGEA(PG8_SA(1, 0), a3, 0, true);
            PG8_WAIT_V(8); PG8_WAIT_L(0); PG8_BAR; PG8_MMA(1, 0, At, B0); PG8_MMA(1, 1, At, B1); PG8_BAR; PG8_SCHED;
        }
        if (wr == 0) PG8_BAR;
        E(acc, cur, wr, wc, fr, fq);
        if (!has_next) break;
#pragma unroll
        for (int a = 0; a < 2; ++a)
#pragma unroll
            for (int b = 0; b < 2; ++b)
#pragma unroll
                for (int m = 0; m < 4; ++m)
#pragma unroll
                    for (int n = 0; n < 2; ++n) acc[a][b][m][n] = (f32x4){0.f, 0.f, 0.f, 0.f};
        cur = nxt; cA = nA; cB = nB; ++ui;
        if constexpr (GATHER) {
#pragma unroll
        for (int h = 0; h < 2; ++h)
#pragma unroll
            for (int i = 0; i < 2; ++i) vA[h][i] = vAn[h][i]; }
        if (wr == 1) PG8_BAR;
    }
    PG8_WAIT_V(0);
    PG8_BAR;
#undef PG8_SA
#undef PG8_SB
#undef PG8_STAGE
#undef PG8_LDA
#undef PG8_LDB
#undef PG8_MMA
#undef PG8_WAIT_V
#undef PG8_WAIT_L
#undef PG8_BAR
#undef PG8_SCHED
#undef PG8_AOFFS
#undef PG8_AOFFS_ASYNC
#undef PG8_AOFFS_FINISH
#undef PG8_STAGEA
#undef PG8_ABASE
}
}

constexpr size_t MiB = 1u << 20;
constexpr size_t WS_CTL = 0, CTL_ZERO_BYTES = 64 * 1024;
constexpr size_t WS_MOD = 1 * MiB;
constexpr size_t WS_TOPI = 2 * MiB;
constexpr size_t WS_GATE = 2 * MiB + 512 * 1024;
constexpr size_t WS_DEST = 3 * MiB;
constexpr size_t WS_ROWTOK = 3 * MiB + 512 * 1024;
constexpr size_t WS_WGCNT = 4 * MiB;
constexpr size_t WS_MOEINFO = 4 * MiB + 64 * 1024;
constexpr size_t WS_SLAB = 8 * MiB;
constexpr size_t WS_WIN = 8 * MiB;
constexpr size_t WS_WOUT = 20 * MiB;
constexpr size_t WS_W13 = 24 * MiB;
constexpr size_t WS_W2 = 38 * MiB;
constexpr size_t WS_H = 48 * MiB;
constexpr size_t ARENA = 112 * MiB;
constexpr size_t WS_Z = ARENA;
constexpr size_t WS_YCAT = ARENA + 176 * MiB;
constexpr size_t WS_SCAN = ARENA + 240 * MiB;
constexpr size_t WS_CH = ARENA + 240 * MiB;
constexpr size_t WS_BONUS = ARENA + 432 * MiB;
constexpr size_t WS_SLG = ARENA + 448 * MiB;
constexpr size_t WS_Y = ARENA;
constexpr size_t WS_HID = ARENA + 64 * MiB;
constexpr size_t WS_WM13 = ARENA + 368 * MiB;
constexpr size_t WS_WM2 = ARENA + 424 * MiB;
constexpr size_t WS_YB = ARENA;
constexpr size_t WS_HIDM = ARENA + 132 * MiB;
constexpr size_t WS_END = ARENA + 454 * MiB;
static_assert(WS_SCAN + (size_t)2 * 8 * 4 * T * 384 * 2 <= WS_END && WS_HID + (size_t)M * FF * 2 <= WS_END && WS_HIDM + (size_t)PART_BLKS * 256 * FF <= WS_END, "ws map");
static_assert(WS_YB + (size_t)MOE_ROWS * D * 2 <= WS_HIDM && WS_HIDM + (size_t)PART_BLKS * 256 * FF <= WS_WM13 && WS_WM13 + (size_t)NE * 2 * FF * D <= WS_WM2 && WS_WM2 + (size_t)NE * D * FF <= WS_END && WS_CH + (size_t)4096 * 16384 * 2 <= WS_WM13, "ws map 2");

constexpr int LDS_BYTES = 163840;
constexpr int SCR_BYTES = 163840 - 512;
constexpr int MISC_OFF = SCR_BYTES;
constexpr int NWAVES = 8;

#define LDS_WAIT() asm volatile("s_waitcnt lgkmcnt(0)" ::: "memory")
#define VM_WAIT() asm volatile("s_waitcnt vmcnt(0)" ::: "memory")
__device__ __forceinline__ unsigned f2bf(float f) { return (unsigned)__builtin_bit_cast(unsigned short, (__bf16)f); }
__device__ __forceinline__ unsigned pk2(float lo, float hi) { bfx2 v; v[0] = (__bf16)lo; v[1] = (__bf16)hi; return __builtin_bit_cast(unsigned, v); }
__device__ __forceinline__ float bf2f(unsigned b) { return __builtin_bit_cast(float, b << 16); }
__device__ __forceinline__ float bflo(unsigned u) { return __builtin_bit_cast(float, u << 16); }
__device__ __forceinline__ float bfhi(unsigned u) { return __builtin_bit_cast(float, u & 0xffff0000u); }
__device__ __forceinline__ float row16_sum(float v);
__device__ __forceinline__ float wave_sum(float v) {
    const int r = __builtin_bit_cast(int, row16_sum(v));
    const float s0 = __builtin_bit_cast(float, __builtin_amdgcn_readlane(r, 0)), s1 = __builtin_bit_cast(float, __builtin_amdgcn_readlane(r, 16)),
                s2 = __builtin_bit_cast(float, __builtin_amdgcn_readlane(r, 32)), s3 = __builtin_bit_cast(float, __builtin_amdgcn_readlane(r, 48));
    return (s0 + s1) + (s2 + s3);
}
__device__ __forceinline__ float row16_sum(float v) {
    v += __builtin_bit_cast(float, __builtin_amdgcn_update_dpp(0, __builtin_bit_cast(int, v), 0x128, 0xf, 0xf, false));
    v += __builtin_bit_cast(float, __builtin_amdgcn_update_dpp(0, __builtin_bit_cast(int, v), 0x124, 0xf, 0xf, false));
    v += __builtin_bit_cast(float, __builtin_amdgcn_update_dpp(0, __builtin_bit_cast(int, v), 0x122, 0xf, 0xf, false));
    v += __builtin_bit_cast(float, __builtin_amdgcn_update_dpp(0, __builtin_bit_cast(int, v), 0x121, 0xf, 0xf, false));
    return v;
}
__device__ __forceinline__ float sigmoidf_(float x) { return __builtin_amdgcn_rcpf(1.0f + __expf(-x)); }

#define XB_TMO      128
#define XB_XCNT(j)  (256  + 64 * (j))
#define XB_XSUB(j)  (1280 + 64 * (j))
#define XB_XGEN(j)  (2304 + 64 * (j))
#define XB_TOP      3328
#define XB_TOPGEN   3392
#define XCD_BAR_WORDS 3456
#define XB_SPIN_CAP (1u << 22)
__device__ __forceinline__ unsigned xb_ld(unsigned* p)              { return __hip_atomic_load(p, __ATOMIC_RELAXED, __HIP_MEMORY_SCOPE_AGENT); }
__device__ __forceinline__ unsigned xb_add(unsigned* p, unsigned v) { return __hip_atomic_fetch_add(p, v, __ATOMIC_RELAXED, __HIP_MEMORY_SCOPE_AGENT); }
__device__ __forceinline__ unsigned xb_xcc_id() { return (unsigned)__builtin_amdgcn_s_getreg((3 << 11) | 20) & 0xFu; }
#define XB_SPIN(cond, bar) do { unsigned _sp = 0; while (cond) { __builtin_amdgcn_s_sleep(1); \
    if ((++_sp & 255u) == 0u) { if (xb_ld(&(bar)[XB_TMO])) break; if (_sp > XB_SPIN_CAP) { atomicAdd(&(bar)[XB_TMO], 1u); break; } } } } while (0)
struct XcdBarrier { unsigned* bar; unsigned x; volatile LAS unsigned* st; };
__device__ __forceinline__ XcdBarrier xcd_barrier_post(unsigned* bar, volatile LAS unsigned* st) {
    XcdBarrier b; b.bar = bar; b.x = xb_xcc_id(); b.st = st;
    if (threadIdx.x == 0) (void)xb_add(&bar[XB_XCNT(b.x)], 1u);
    return b;
}
__device__ __forceinline__ void xcd_barrier_complete(unsigned* bar, unsigned x, unsigned& nloc, unsigned& nx) {
    const unsigned G = gridDim.x * gridDim.y * gridDim.z;
    unsigned sum, cnt, mine, sp = 0u;
    for (;;) {
        sum = 0u; cnt = 0u; mine = 0u;
#pragma unroll
        for (unsigned j = 0; j < 16; ++j) { const unsigned c = xb_ld(&bar[XB_XCNT(j)]); sum += c; cnt += (c > 0u) ? 1u : 0u; mine = (j == x) ? c : mine; }
        if (sum == G) break;
        __builtin_amdgcn_s_sleep(1);
        if ((++sp & 255u) == 0u) { if (xb_ld(&bar[XB_TMO])) break; if (sp > XB_SPIN_CAP) { atomicAdd(&bar[XB_TMO], 1u); break; } }
    }
    nloc = mine > 0u ? mine : 1u; nx = cnt > 0u ? cnt : 1u;
}
__device__ __forceinline__ void xcd_barrier(const XcdBarrier& b) {
    asm volatile("s_waitcnt vmcnt(0)" ::: "memory");
    __syncthreads();
    if (threadIdx.x == 0) {
        unsigned* bar = b.bar;
        __builtin_amdgcn_s_waitcnt(0);
        unsigned nloc = b.st[0], nx = b.st[1];
        if (nloc == 0u) { xcd_barrier_complete(bar, b.x, nloc, nx); b.st[0] = nloc; b.st[1] = nx; }
        const unsigned old = xb_add(&bar[XB_XSUB(b.x)], 1u);
        const unsigned gen = old / nloc;
        if (old + 1u == (gen + 1u) * nloc) {
            __builtin_amdgcn_fence(__ATOMIC_RELEASE, "agent");
            asm volatile("s_waitcnt vmcnt(0)" ::: "memory");
            const unsigned og = xb_add(&bar[XB_TOP], 1u);
            const unsigned tg = og / nx;
            if (og + 1u == (tg + 1u) * nx) xb_add(&bar[XB_TOPGEN], 1u);
            else XB_SPIN(xb_ld(&bar[XB_TOPGEN]) == tg, bar);
            __builtin_amdgcn_fence(__ATOMIC_ACQUIRE, "agent");
            xb_add(&bar[XB_XGEN(b.x)], 1u);
            asm volatile("s_waitcnt vmcnt(0)" ::: "memory");
        } else {
            XB_SPIN(xb_ld(&bar[XB_XGEN(b.x)]) == gen, bar);
            __builtin_amdgcn_fence(__ATOMIC_ACQUIRE, "agent");
            asm volatile("s_waitcnt vmcnt(0)" ::: "memory");
        }
    }
    __syncthreads();
}

struct Args { const float* in[29]; float* out; unsigned char* ws; int ph_lo, ph_hi, sub, pad; };
enum { IN_X = 0, IN_C, IN_ADAW, IN_ADAB, IN_NORMG, IN_WIN, IN_WOUT, IN_RPB, IN_MU, IN_W0, IN_W2L, IN_A0, IN_A2L, IN_KK, IN_KA, IN_RK, IN_LNW, IN_LNB, IN_G2,
       IN_POOLW, IN_POOLS, IN_CONVW, IN_FW1, IN_FW3, IN_FW2, IN_ROUTER, IN_MW1, IN_MW3, IN_MW2 };

__device__ __forceinline__ void transpose_item(const float* W, int K, int N, bf16* WT, int drow0, int k0, int n0, LAS float* scr, int lane) {
#pragma unroll 8
    for (int i = 0; i < 32; ++i) { const int kk = 2 * i + (lane >> 5); scr[kk * 33 + (lane & 31)] = W[(size_t)(k0 + kk) * N + n0 + (lane & 31)]; }
    LDS_WAIT(); asm volatile("" ::: "memory");
    const int c = lane & 7;
#pragma unroll
    for (int j = 0; j < 4; ++j) { const int n = (lane >> 3) + 8 * j; const LAS float* s = scr + (8 * c) * 33 + n;
        u32x4 o; o.x = pk2(s[0 * 33], s[1 * 33]); o.y = pk2(s[2 * 33], s[3 * 33]); o.z = pk2(s[4 * 33], s[5 * 33]); o.w = pk2(s[6 * 33], s[7 * 33]);
        *(u32x4*)(WT + (size_t)(drow0 + n) * K + k0 + 8 * c) = o; }
    LDS_WAIT(); asm volatile("" ::: "memory");
}
__device__ __forceinline__ void transpose_item8(const float* W, int K, int N, unsigned char* WT, int drow0, int k0, int n0, LAS float* scr, int lane, float sc) {
#pragma unroll 8
    for (int i = 0; i < 32; ++i) { const int kk = 2 * i + (lane >> 5); scr[kk * 33 + (lane & 31)] = W[(size_t)(k0 + kk) * N + n0 + (lane & 31)]; }
    LDS_WAIT(); asm volatile("" ::: "memory");
    const int c = lane & 7;
#pragma unroll
    for (int j = 0; j < 4; ++j) { const int n = (lane >> 3) + 8 * j; const LAS float* s = scr + (8 * c) * 33 + n;
        u32x2 o; o.x = pg8::cvt4_fp8(s[0 * 33] * sc, s[1 * 33] * sc, s[2 * 33] * sc, s[3 * 33] * sc); o.y = pg8::cvt4_fp8(s[4 * 33] * sc, s[5 * 33] * sc, s[6 * 33] * sc, s[7 * 33] * sc);
        *(u32x2*)(WT + (size_t)(drow0 + n) * K + k0 + 8 * c) = o; }
    LDS_WAIT(); asm volatile("" ::: "memory");
}
template <int MODE> __device__ __forceinline__ void transpose_mat8(const float* W, int K, int N, unsigned char* WT, int gw, int NGW, LAS float* scr, int lane, float sc) {
    const int nblk = N / 32, nitems = (K / 64) * nblk;
    for (int it = gw; it < nitems; it += NGW) { const int kb = it / nblk, nb = it % nblk, n0 = 32 * nb;
        const int drow0 = MODE == 0 ? n0 : (256 * (n0 >> 7) + (n0 & 127) + (MODE == 2 ? 128 : 0));
        transpose_item8(W, K, N, WT, drow0, 64 * kb, n0, scr, lane, sc); }
}
template <int MODE> __device__ __forceinline__ void transpose_mat(const float* W, int K, int N, bf16* WT, int gw, int NGW, LAS float* scr, int lane) {
    const int nblk = N / 32, nitems = (K / 64) * nblk;
    for (int it = gw; it < nitems; it += NGW) { const int kb = it / nblk, nb = it % nblk, n0 = 32 * nb;
        const int drow0 = MODE == 0 ? n0 : (256 * (n0 >> 7) + (n0 & 127) + (MODE == 2 ? 128 : 0));
        transpose_item(W, K, N, WT, drow0, 64 * kb, n0, scr, lane); }
}

__device__ __forceinline__ void ld_row_f32(const float* p, int lane, f32x4 (&v)[4]) {
#pragma unroll
    for (int j = 0; j < 4; ++j) v[j] = *(const f32x4*)(p + 4 * lane + 256 * j);
}
__device__ __forceinline__ void ld_row_bf16(const bf16* p, int lane, f32x4 (&v)[4]) {
#pragma unroll
    for (int j = 0; j < 4; ++j) { const u32x2 u = *(const u32x2*)(p + 4 * lane + 256 * j); v[j] = (f32x4){bflo(u.x), bfhi(u.x), bflo(u.y), bfhi(u.y)}; }
}
__device__ __forceinline__ void ld_moe_row(const bf16* YB, const bf16* SLAB, int d, int lane, f32x4 (&v)[4]) {
    if (d < 256 * 256) { ld_row_bf16(YB + (size_t)d * D, lane, v); }
    else { const bf16* p = SLAB + (size_t)(d - 256 * 256) * D; ld_row_bf16(p, lane, v);
#pragma unroll 1
        for (int sl = 1; sl < 7; ++sl) { f32x4 t[4]; ld_row_bf16(p + (size_t)sl * 8 * 256 * D, lane, t);
#pragma unroll
            for (int j = 0; j < 4; ++j) v[j] = v[j] + t[j]; } }
}
__device__ __forceinline__ void st_row_bf16(bf16* p, int lane, const f32x4 (&v)[4]) {
#pragma unroll
    for (int j = 0; j < 4; ++j) { u32x2 u; u.x = pk2(v[j][0], v[j][1]); u.y = pk2(v[j][2], v[j][3]); *(u32x2*)(p + 4 * lane + 256 * j) = u; }
}
__device__ __forceinline__ void st_row_f32(float* p, int lane, const f32x4 (&v)[4]) {
#pragma unroll
    for (int j = 0; j < 4; ++j) *(f32x4*)(p + 4 * lane + 256 * j) = v[j];
}
__device__ __forceinline__ float row_rstd(const f32x4 (&v)[4]) {
    float s = 0.f;
#pragma unroll
    for (int j = 0; j < 4; ++j) s += (v[j][0] * v[j][0] + v[j][1] * v[j][1]) + (v[j][2] * v[j][2] + v[j][3] * v[j][3]);
    return 1.0f / sqrtf(wave_sum(s) * (1.0f / D) + RMS_EPS);
}
__device__ __forceinline__ void modulate(const f32x4 (&x)[4], float rstd, const float* g, const float* sc, const float* sh, int lane, f32x4 (&h)[4]) {
    f32x4 gv[4], scv[4], shv[4]; ld_row_f32(g, lane, gv); ld_row_f32(sc, lane, scv); ld_row_f32(sh, lane, shv);
#pragma unroll
    for (int j = 0; j < 4; ++j) h[j] = x[j] * rstd * gv[j] * (1.0f + scv[j]) + shv[j];
}

__device__ __forceinline__ const float* inp_ptr(const Args& a, int i) { asm volatile("" : "+s"(i)); return a.in[i]; }
#define INP(i) inp_ptr(args, (i))
#define mod_l (MOD + (size_t)l * 8 * 6 * D)
#define PHASE_PROLOGUE \
    int tid_l = threadIdx.x; asm volatile("" : "+v"(tid_l)); const int tid = tid_l, lane = tid & 63, wave = __builtin_amdgcn_readfirstlane(tid >> 6), gw = vcu * NWAVES + wave; (void)lane; (void)wave; (void)gw; (void)tid; \
    size_t zofs_ = 0; asm volatile("" : "+s"(zofs_)); unsigned char* const ws = ws0 + zofs_; float* const X = (float*)((unsigned char*)args.out + zofs_);   \
    float* const MOD = (float*)(ws + WS_MOD); bf16* const H = (bf16*)(ws + WS_H); float* const YS = (float*)(ws + WS_H); bf16* const Z = (bf16*)(ws + WS_Z); bf16* const YCAT = (bf16*)(ws + WS_YCAT); \
    bf16* const SCAN = (bf16*)(ws + WS_SCAN); bf16* const Y = (bf16*)(ws + WS_Y); bf16* const HID = (bf16*)(ws + WS_HID); int* const TOPI = (int*)(ws + WS_TOPI); float* const GATE = (float*)(ws + WS_GATE); \
    int* const DEST = (int*)(ws + WS_DEST); int* const ROWTOK = (int*)(ws + WS_ROWTOK); int* const WGCNT = (int*)(ws + WS_WGCNT); int* const MOEINFO = (int*)(ws + WS_MOEINFO); \
    bf16* const CH = (bf16*)(ws + WS_CH); bf16* const BONUS = (bf16*)(ws + WS_BONUS); bf16* const SLG = (bf16*)(ws + WS_SLG); (void)CH; (void)BONUS; (void)SLG; \
    (void)X; (void)MOD; (void)H; (void)YS; (void)Z; (void)YCAT; (void)SCAN; (void)Y; (void)HID; (void)TOPI; (void)GATE; (void)DEST; (void)ROWTOK; (void)WGCNT; (void)MOEINFO;
#ifndef PH_MASK
#define PH_MASK 0xffff
#endif
#define PHEN(i) (((PH_MASK) >> (i)) & 1)
#ifndef SUB_MASK
#define SUB_MASK 7
#endif
#define SUBEN(i) (((SUB_MASK) >> (i)) & 1)
#define IN(k) (lo <= (k) && (k) < hi)
#define SEAM(k) do { if (MK_N_LAUNCHES == 1 && IN((k) + 1)) xcd_barrier(bar); } while (0)
__device__ __forceinline__ void load_rowvecs(const float* g_a, const float* gate, const float* g_b, const float* sc, const float* sh, int lane, f32x4 (&a1)[4], f32x4 (&bv)[4], f32x4 (&cv)[4]) {
#pragma unroll
    for (int j = 0; j < 4; ++j) { const int o = 4 * lane + 256 * j; const f32x4 ga = *(const f32x4*)(g_a + o), gt = *(const f32x4*)(gate + o), gb = *(const f32x4*)(g_b + o), s = *(const f32x4*)(sc + o);
        a1[j] = ga * gt; bv[j] = gb * (1.0f + s); cv[j] = *(const f32x4*)(sh + o); }
}
template <int l> __device__ __forceinline__ void layer_phases(const Args& args, unsigned char* const ws0, LAS unsigned char* lds, const int vcu, const int G, const int bx, const int NGW, const int lo, const int hi, const XcdBarrier& bar) {
        const int P = 2 + 16 * l;
        if (PHEN(2) && IN(P + 0)) {
            PHASE_PROLOGUE
            pg8::Gemm g{H, (const bf16*)(ws + WS_WIN) + (size_t)l * ZW * D, M, ZW, D, nullptr, 0}; pg8::StaticOrder S; S.init(M, ZW, G, bx);
            pg8::EpiBf16 E{Z, ZW, 1.0f};
            pg8::gemm_phase<pg8::EpiBf16, pg8::StaticOrder, false>(lds, g, S, E);
            SEAM(P + 0);
        }
        if (PHEN(3) && IN(P + 1)) {
            PHASE_PROLOGUE
            if (SUBEN(0) && (args.sub & 1)) {
                LAS unsigned char* Ks = lds; LAS unsigned char* Vs = lds + 65536;
                LAS float* rp = (LAS float*)(lds + 131072);
                LAS float* xch = (LAS float*)(lds + 131072 + 2048);
                const float* rpb = INP(IN_RPB) + (size_t)l * 4 * 15 * 31;
                const int qt = wave & 3, half = wave >> 2, r16 = lane & 15, kq = lane >> 4;
                const int q = qt * 16 + r16;
                const int c0 = (qt == 0) ? 0 : (qt == 1) ? 8 : (qt == 2) ? 24 : 32;
                const int cs = min(max(q - 8, 0), 48);
                for (int ub = vcu * 8; ub < BATCH * 4 * 64; ub += G * 8) {
                    const int bh = ub >> 6, b = bh >> 2, hh = bh & 3, r0u = ub & 63;
                    for (int i = tid; i < 465; i += NWAVES * 64) rp[i] = rpb[hh * 465 + i];
                    { const int rs0 = min(max(r0u - 4, 0), 56);
                      for (int i = tid; i < 8192; i += NWAVES * 64) { const int kv = i >> 12, krow = rs0 + ((i >> 9) & 7), col = (i >> 3) & 63, ch = i & 7;
                          const bf16* src = Z + (size_t)(b * T + krow * 64 + col) * ZW + (kv ? ZV : ZK) + hh * 64 + ch * 8;
                          *(LAS u32x4*)((kv ? Vs : Ks) + ((((krow & 7) * 64 + col) << 7) + ((ch ^ (col & 7)) << 4))) = *(const u32x4*)src; } }
                    bf16x8 q0, q1;
                    { const bf16* qp = Z + (size_t)(b * T + r0u * 64 + q) * ZW + ZQ + hh * 64; q0 = *(const bf16x8*)(qp + kq * 8); q1 = *(const bf16x8*)(qp + 32 + kq * 8); }
                    __syncthreads();
#pragma unroll 1
                    for (int k8 = 0; k8 < 8; ++k8) {
                        const int r = r0u + k8;
                        const int rs = min(max(r - 4, 0), 56);
                        const int rn = min(r + 1, 63), rsn = min(max(rn - 4, 0), 56); const bool newrow = (k8 < 7) && (rsn != rs); const int krn = rsn + 7;
                        bf16x8 nq0, nq1; u32x4 st0 = (u32x4){0u, 0u, 0u, 0u}, st1 = st0;
                        { const bf16* qp = Z + (size_t)(b * T + rn * 64 + q) * ZW + ZQ + hh * 64; nq0 = *(const bf16x8*)(qp + kq * 8); nq1 = *(const bf16x8*)(qp + 32 + kq * 8); }
                        { const int col = (tid >> 3) & 63, ch = tid & 7; const bf16* src = Z + (size_t)(b * T + min(krn, 63) * 64 + col) * ZW + hh * 64 + ch * 8;
                            st0 = *(const u32x4*)(src + ZK); st1 = *(const u32x4*)(src + ZV); }
                        float sc[8][4]; float mx = -1e30f;
#pragma unroll
                        for (int kt = 0; kt < 8; ++kt) { const int il = kt >> 1, ch2 = kt & 1, krow = rs + half * 4 + il, colA = c0 + 16 * ch2 + r16;
                            const LAS unsigned char* ka = Ks + ((((krow & 7) * 64 + colA) << 7));
                            const bf16x8 a0 = *(const LAS bf16x8*)(ka + ((kq ^ (colA & 7)) << 4)), a1 = *(const LAS bf16x8*)(ka + (((4 + kq) ^ (colA & 7)) << 4));
                            f32x4 acc = (f32x4){0.f, 0.f, 0.f, 0.f};
                            acc = __builtin_amdgcn_mfma_f32_16x16x32_bf16(a0, q0, acc, 0, 0, 0); acc = __builtin_amdgcn_mfma_f32_16x16x32_bf16(a1, q1, acc, 0, 0, 0);
                            const LAS float* brow = rp + (krow - r + 7) * 31 + (15 - q);
#pragma unroll
                            for (int g = 0; g < 4; ++g) { const int col = c0 + 16 * ch2 + 4 * kq + g; const bool valid = (col >= cs) && (col < cs + 16);
                                const float bias = brow[valid ? col : (q - 15)];
                                const float v = valid ? (acc[g] * 0.125f + bias) : -1e30f; sc[kt][g] = v; mx = fmaxf(mx, v); } }
                        mx = fmaxf(mx, __shfl_xor(mx, 16)); mx = fmaxf(mx, __shfl_xor(mx, 32));
                        float ls = 0.f;
#pragma unroll
                        for (int kt = 0; kt < 8; ++kt)
#pragma unroll
                            for (int g = 0; g < 4; ++g) { const float pv = __expf(sc[kt][g] - mx); sc[kt][g] = pv; ls += pv; }
                        ls += __shfl_xor(ls, 16); ls += __shfl_xor(ls, 32);
                        f32x4 o[4];
#pragma unroll
                        for (int dt = 0; dt < 4; ++dt) o[dt] = (f32x4){0.f, 0.f, 0.f, 0.f};
                        const int qq = r16 >> 2, pp = r16 & 3;
#pragma unroll
                        for (int m2 = 0; m2 < 4; ++m2) { const int krow = rs + half * 4 + m2;
                            u32x4 pb; pb.x = pk2(sc[2 * m2][0], sc[2 * m2][1]); pb.y = pk2(sc[2 * m2][2], sc[2 * m2][3]); pb.z = pk2(sc[2 * m2 + 1][0], sc[2 * m2 + 1][1]); pb.w = pk2(sc[2 * m2 + 1][2], sc[2 * m2 + 1][3]);
                            const bf16x8 bfrag = __builtin_bit_cast(bf16x8, pb);
                            const int col0 = c0 + 4 * kq + qq, col1 = col0 + 16;
                            const LAS unsigned char* v0b = Vs + ((((krow & 7) * 64 + col0) << 7)) + (pp & 1) * 8; const LAS unsigned char* v1b = Vs + ((((krow & 7) * 64 + col1) << 7)) + (pp & 1) * 8;
#pragma unroll
                            for (int dt = 0; dt < 4; ++dt) { const int chn = 2 * dt + (pp >> 1);
                                const s16x4 t0 = __builtin_amdgcn_ds_read_tr16_b64_v4i16((LAS s16x4*)(v0b + ((chn ^ (col0 & 7)) << 4)));
                                const s16x4 t1 = __builtin_amdgcn_ds_read_tr16_b64_v4i16((LAS s16x4*)(v1b + ((chn ^ (col1 & 7)) << 4)));
                                const bf16x8 afrag = (bf16x8){t0[0], t0[1], t0[2], t0[3], t1[0], t1[1], t1[2], t1[3]};
                                o[dt] = __builtin_amdgcn_mfma_f32_16x16x32_bf16(afrag, bfrag, o[dt], 0, 0, 0); } }
                        LAS float* px = xch + q * 68;
                        if (half == 1) {
#pragma unroll
                            for (int dt = 0; dt < 4; ++dt) *(LAS f32x4*)(px + 16 * dt + 4 * kq) = o[dt];
                            if (kq == 0) { px[64] = mx; px[65] = ls; } }
                        __syncthreads();
                        if (half == 0) { const float m1 = px[64], l1 = px[65]; const float mm = fmaxf(mx, m1), f0 = __expf(mx - mm), f1 = __expf(m1 - mm); const float inv = __builtin_amdgcn_rcpf(f0 * ls + f1 * l1);
                            bf16* op = YCAT + (size_t)(b * T + r * 64 + q) * D + hh * 64 + 4 * kq;
#pragma unroll
                            for (int dt = 0; dt < 4; ++dt) { const f32x4 o1 = *(const LAS f32x4*)(px + 16 * dt + 4 * kq); const f32x4 res = (o[dt] * f0 + o1 * f1) * inv;
                                u32x2 w; w.x = pk2(res[0], res[1]); w.y = pk2(res[2], res[3]); *(u32x2*)(op + 16 * dt) = w; } }
                        if (newrow) { const int col = (tid >> 3) & 63, ch = tid & 7; const int off = ((((krn & 7) * 64 + col) << 7) + ((ch ^ (col & 7)) << 4));
                            *(LAS u32x4*)(Ks + off) = st0; *(LAS u32x4*)(Vs + off) = st1; }
                        q0 = nq0; q1 = nq1;
                        __syncthreads();
                    }
                }
            }
            if (SUBEN(1) && (args.sub & 2)) {
                LAS bf16* PWT = (LAS bf16*)lds;
                LAS bf16* DB = PWT + 4 * 64 * 72;
                const int ch = tid & 255, hf = tid >> 8, gq = ch >> 6, hw = 1 << gq;
                { const float* pwp = INP(IN_POOLW) + (size_t)l * 4 * 64 * 64;
                  for (int i = tid; i < 4 * 64 * 64; i += NWAVES * 64) { const int g = i >> 12, c = (i >> 6) & 63, dd = i & 63; PWT[(g * 64 + dd) * 72 + c] = (bf16)f2bf(pwp[i]); } }
                const int r16 = lane & 15, kq = lane >> 4, mg = wave & 3, mtk = wave >> 2;
                f32x4 psc[4];
                { const float* psp = INP(IN_POOLS) + l * GW + mg * 64;
#pragma unroll
                  for (int dt = 0; dt < 4; ++dt) psc[dt] = *(const f32x4*)(psp + dt * 16 + 4 * kq); }
                const float cw0 = INP(IN_CONVW)[(size_t)l * 3 * GW + ch], cw1 = INP(IN_CONVW)[(size_t)l * 3 * GW + GW + ch], cw2 = INP(IN_CONVW)[(size_t)l * 3 * GW + 2 * GW + ch];
                __syncthreads();
                for (int it = vcu; it < M / 32; it += G) {
                    const int b = it >> 7, tb = (it & 127) * 32, t0 = tb + hf * 16;
                    const bf16* zb = Z + (size_t)b * T * ZW;
                    float ps[33]; ps[0] = 0.f;
#pragma unroll
                    for (int i = 0; i < 32; ++i) { const int tp = t0 - 8 + i; const int tc = min(max(tp, 0), T - 1); const float zv = bf2f(zb[(size_t)tc * ZW + ZP + ch]) * ((tp == tc) ? 1.f : 0.f); ps[i + 1] = ps[i] + zv; }
                    float uu[18], bg[16];
#pragma unroll
                    for (int i = 0; i < 18; ++i) { const int tp = t0 - 1 + i; const int tc = min(max(tp, 0), T - 1); uu[i] = bf2f(zb[(size_t)tc * ZW + ZCC + ch]) * bf2f(zb[(size_t)tc * ZW + ZCH + ch]) * ((tp == tc) ? 1.f : 0.f); }
#pragma unroll
                    for (int k = 0; k < 16; ++k) bg[k] = bf2f(zb[(size_t)(t0 + k) * ZW + ZCB + ch]);
#pragma unroll
                    for (int k = 0; k < 16; ++k) { const int t = t0 + k;
                        const int lo_ = max(t - hw, 0), hi_ = min(t + hw, T);
                        float sw;
                        if (gq == 0) sw = ps[k + 9] - ps[k + 7]; else if (gq == 1) sw = ps[k + 10] - ps[k + 6]; else if (gq == 2) sw = ps[k + 12] - ps[k + 4]; else sw = ps[k + 16] - ps[k];
                        const float uq = ps[k + 9] - ps[k + 8];
                        DB[(hf * 16 + k) * 264 + ch] = (bf16)f2bf(sw * __builtin_amdgcn_rcpf((float)(hi_ - lo_)) - uq); }
                    __syncthreads();
                    { const LAS bf16* bp = DB + (mtk * 16 + r16) * 264 + mg * 64 + kq * 8;
                      const bf16x8 b0 = *(const LAS bf16x8*)bp, b1 = *(const LAS bf16x8*)(bp + 32);
                      bf16* op = YCAT + (size_t)(b * T + tb + mtk * 16 + r16) * D + 512 + mg * 64 + 4 * kq;
#pragma unroll
                      for (int dt = 0; dt < 4; ++dt) { const LAS bf16* ap = PWT + (mg * 64 + dt * 16 + r16) * 72 + kq * 8;
                          f32x4 acc = __builtin_amdgcn_mfma_f32_16x16x32_bf16(*(const LAS bf16x8*)ap, b0, (f32x4){0.f, 0.f, 0.f, 0.f}, 0, 0, 0);
                          acc = __builtin_amdgcn_mfma_f32_16x16x32_bf16(*(const LAS bf16x8*)(ap + 32), b1, acc, 0, 0, 0);
                          acc = acc * psc[dt];
                          u32x2 w; w.x = pk2(acc[0], acc[1]); w.y = pk2(acc[2], acc[3]); *(u32x2*)(op + dt * 16) = w; } }
#pragma unroll
                    for (int k = 0; k < 16; ++k) YCAT[(size_t)(b * T + t0 + k) * D + 768 + ch] = (bf16)f2bf(bg[k] * (cw0 * uu[k] + cw1 * uu[k + 1] + cw2 * uu[k + 2]));
                    __syncthreads();
                }
            }
        }
        if (PHEN(4) && IN(P + 2)) {
            PHASE_PROLOGUE
            constexpr int LP = 64, MS = 64 * LP;
            LAS bf16* At = (LAS bf16*)lds; LAS bf16* Rt = At + MS; LAS bf16* Bt = Rt + MS; LAS bf16* Kt = Bt + MS;
            LAS bf16* XT = Kt + MS;
            LAS bf16* BhT = XT + 2 * MS; LAS bf16* KhT = BhT + MS; LAS bf16* VT = KhT + MS;
            LAS bf16* Nb = VT + MS;
            LAS bf16* Mk = Nb + 4 * MS; LAS bf16* Pb = Mk + MS; LAS bf16* Pk = Pb + MS;
            LAS float* tot = (LAS float*)(Pk + MS);
            const int r16 = lane & 15, kq = lane >> 4, sw = r16 & 7;
            const int fo0 = r16 * LP + ((kq ^ sw) << 3), fo1 = r16 * LP + (((4 + kq) ^ sw) << 3);
#define TOFF(y0) (r16 * LP + (((((y0) >> 3) + (kq >> 1)) ^ sw) << 3) + 4 * (kq & 1))
#define LBAR() do { asm volatile("s_waitcnt lgkmcnt(0)" ::: "memory"); __builtin_amdgcn_s_barrier(); asm volatile("" ::: "memory"); } while (0)
#define MMA16H(acc, Ap, Bp, h) do { const bf16x8 _a = *(const LAS bf16x8*)((Ap) + ((h) ? fo1 : fo0)); const bf16x8 _b = *(const LAS bf16x8*)((Bp) + ((h) ? fo1 : fo0)); \
        acc = __builtin_amdgcn_mfma_f32_16x16x32_bf16(_a, _b, acc, 0, 0, 0); } while (0)
#define MMA16(acc, Ap, Bp) do { MMA16H(acc, Ap, Bp, 0); MMA16H(acc, Ap, Bp, 1); } while (0)
#define STORE_T(dst, x0, y0, acc) do { u32x2 _w; _w.x = pk2((acc)[0], (acc)[1]); _w.y = pk2((acc)[2], (acc)[3]); *(LAS u32x2*)((dst) + (x0) * LP + TOFF(y0)) = _w; } while (0)
            const int e = (vcu & 7) >> 2, hh = vcu & 3, cch = hh * 64 + lane;
            LAS bf16* LWT = (LAS bf16*)(tot + 1024);
            LAS bf16* LATW = Pb; LAS bf16* LATA = Pk;
            LAS float* WPA = (LAS float*)Nb;
            { const float* w2p = INP(IN_W2L); const float* a2p = INP(IN_A2L);
              for (int i = tid; i < 4096; i += NWAVES * 64) { const int wh = i >> 11, q = (i >> 6) & 31, cc = i & 63;
                  LWT[(wh * 64 + cc) * 40 + q] = (bf16)f2bf((wh ? a2p : w2p)[((size_t)(l * 2 + e) * 32 + q) * GW + hh * 64 + cc]); } }
            const float w0c = INP(IN_W0)[(size_t)(l * 2 + e) * GW + cch], a0c = INP(IN_A0)[(size_t)(l * 2 + e) * GW + cch];
            const float kkc = INP(IN_KK)[(size_t)l * GW + cch], kac = INP(IN_KA)[(size_t)l * GW + cch];
            float mur, muk, muv, mulat;
            { const float* mu = INP(IN_MU) + (size_t)(l * 2 + e) * RWS; mur = mu[cch]; muk = mu[256 + cch]; muv = mu[512 + cch]; mulat = mu[768 + lane]; }
            __syncthreads();
            float rz[9], kz[9], vz[9], lz[9];
#define E0_LOAD(idx_) do { const int _b = (idx_) >> 6, _ck = (idx_) & 63; int cl_ = cch, jl_ = lane; asm volatile("" : "+v"(cl_), "+v"(jl_)); \
        _Pragma("unroll") for (int x = 0; x < 9; ++x) { const int sidx = _ck * 64 + wave * 8 + x - 1; const int t = e ? (T - 1 - sidx) : sidx; \
            const float okf = (sidx >= 0) ? 1.f : 0.f; const int tcl = min(max(t, 0), T - 1); \
            const bf16* zp = Z + (size_t)(_b * T + tcl) * ZW + ZR; rz[x] = bf2f(zp[cl_]) * okf; kz[x] = bf2f(zp[256 + cl_]) * okf; vz[x] = bf2f(zp[512 + cl_]) * okf; lz[x] = bf2f(zp[768 + jl_]) * okf; } } while (0)
            E0_LOAD(vcu >> 3);
            for (int idx = vcu >> 3; idx < 512; idx += (G >> 3)) {
                const int b = idx >> 6, ck = idx & 63, chain = (e * 8 + b) * 4 + hh, u = chain * 64 + ck;
                for (int rep_ = 0; rep_ <= ((args.sub >> 8) & 1); ++rep_) {
                    const int j = lane, s0 = wave * 8;
#pragma unroll
                    for (int x = 0; x < 8; ++x) { const float zd = lz[x + 1] + mulat * (lz[x] - lz[x + 1]);
                        const float tv = 1.0f - 2.0f * __builtin_amdgcn_rcpf(1.0f + __expf(2.0f * zd));
                        ((j < 32) ? LATW : LATA)[(s0 + x) * LP + ((((j & 31) >> 3) ^ x) << 3) + (j & 7)] = (bf16)f2bf((j < 32) ? tv : zd); }
                    LBAR();
                    { const int wh = wave >> 2, ty = wave & 3;
                      const bf16x8 af = *(const LAS bf16x8*)((wh ? LATA : LATW) + ty * 16 * LP + fo0);
#pragma unroll
                      for (int tx = 0; tx < 4; ++tx) { const bf16x8 bfr = *(const LAS bf16x8*)(LWT + (wh * 64 + tx * 16 + r16) * 40 + kq * 8);
                          const f32x4 acc = __builtin_amdgcn_mfma_f32_16x16x32_bf16(af, bfr, (f32x4){0.f, 0.f, 0.f, 0.f}, 0, 0, 0);
                          *(LAS f32x4*)(WPA + (wh * 64 + tx * 16 + r16) * 68 + ty * 16 + 4 * kq) = acc; } }
                    LBAR();
                    f32x4 wpv[2], apv[2];
                    wpv[0] = *(const LAS f32x4*)(WPA + j * 68 + s0); wpv[1] = *(const LAS f32x4*)(WPA + j * 68 + s0 + 4); apv[0] = *(const LAS f32x4*)(WPA + (64 + j) * 68 + s0); apv[1] = *(const LAS f32x4*)(WPA + (64 + j) * 68 + s0 + 4);
                    float cw[8], lwv[8], rr[8], kk_[8], aa[8], bb[8];
                    float run = 0.f;
#pragma unroll
                    for (int x = 0; x < 8; ++x) {
                        const float r_ = rz[x + 1] + mur * (rz[x] - rz[x + 1]), kk0 = kz[x + 1] + muk * (kz[x] - kz[x + 1]);
                        const float wp = w0c + wpv[x >> 2][x & 3], ap = a0c + apv[x >> 2][x & 3];
                        const float nx = -wp; const float sp = fmaxf(nx, 0.f) + __logf(1.0f + __expf(-fabsf(nx)));
                        lwv[x] = -__expf(-sp - 0.5f);
                        const float av = sigmoidf_(ap);
                        float kk = kk0 * kkc; const float ss = wave_sum(kk * kk); kk *= __builtin_amdgcn_rsqf(fmaxf(ss, 1e-12f));
                        rr[x] = r_; kk_[x] = kk0 * (1.0f + (av - 1.0f) * kac); aa[x] = -kk; bb[x] = kk * av;
                        run += lwv[x]; cw[x] = run; }
                    tot[wave * 64 + j] = run;
                    LBAR();
                    float pre = 0.f, all = 0.f;
#pragma unroll
                    for (int w = 0; w < 8; ++w) { const float v = tot[w * 64 + j]; all += v; pre += (w < wave) ? v : 0.f; }
                    unsigned xt[8], bh[8], kh[8], vt[8];
                    const int rm = (j >> 3) << 3, jl = j & 7;
                    const float wlall = __expf(all); float ewp = __expf(pre); if (wave == 0) tot[512 + j] = wlall;
#pragma unroll
                    for (int x = 0; x < 8; ++x) { const float c = cw[x] + pre; const float ew = __expf(c), ewx = ewp, einv = __builtin_amdgcn_rcpf(ew), eL = wlall * einv; ewp = ew;
                        xt[x] = f2bf(aa[x] * ewx); bh[x] = f2bf(bb[x] * eL); kh[x] = f2bf(kk_[x] * eL); vt[x] = f2bf(vz[x + 1] + muv * (vz[x] - vz[x + 1]));
                        const int ro = (s0 + x) * LP + ((rm ^ (x << 3))) + jl;
                        At[ro] = (bf16)xt[x]; Rt[ro] = (bf16)f2bf(rr[x] * ew); Bt[ro] = (bf16)f2bf(bb[x] * einv); Kt[ro] = (bf16)f2bf(kk_[x] * einv); }
                    const int to = j * LP + ((wave ^ (j & 7)) << 3);
                    u32x4 w4;
                    w4.x = xt[0] | (xt[1] << 16); w4.y = xt[2] | (xt[3] << 16); w4.z = xt[4] | (xt[5] << 16); w4.w = xt[6] | (xt[7] << 16); *(LAS u32x4*)(XT + to) = w4;
                    w4.x = bh[0] | (bh[1] << 16); w4.y = bh[2] | (bh[3] << 16); w4.z = bh[4] | (bh[5] << 16); w4.w = bh[6] | (bh[7] << 16); *(LAS u32x4*)(BhT + to) = w4;
                    w4.x = kh[0] | (kh[1] << 16); w4.y = kh[2] | (kh[3] << 16); w4.z = kh[4] | (kh[5] << 16); w4.w = kh[6] | (kh[7] << 16); *(LAS u32x4*)(KhT + to) = w4;
                    w4.x = vt[0] | (vt[1] << 16); w4.y = vt[2] | (vt[3] << 16); w4.z = vt[4] | (vt[5] << 16); w4.w = vt[6] | (vt[7] << 16); *(LAS u32x4*)(VT + to) = w4;
                    LBAR();
                    if (rep_ == ((args.sub >> 8) & 1)) E0_LOAD(min(idx + (G >> 3), 511));
                }
                for (int rep_ = 0; rep_ <= ((args.sub >> 9) & 1); ++rep_) {
#pragma unroll
                for (int n2 = 0; n2 < 2; ++n2) {
                    const int ty = n2 * 2 + (wave >> 2), tx = wave & 3;
                    const f32x4 z4 = (f32x4){0.f, 0.f, 0.f, 0.f};
                    f32x4 aN = z4, aNT = z4, aMk = z4, aPb = z4, aPk = z4;
                    const LAS bf16* yA = At + ty * 16 * LP; const LAS bf16* yB = Bt + ty * 16 * LP; const LAS bf16* yK = Kt + ty * 16 * LP;
                    const LAS bf16* xA = At + tx * 16 * LP; const LAS bf16* xB = Bt + tx * 16 * LP; const LAS bf16* xR = Rt + tx * 16 * LP;
                    if (ty <= tx) {
                        const bf16x8 yb0 = *(const LAS bf16x8*)(yB + fo0), yb1 = *(const LAS bf16x8*)(yB + fo1), yk0 = *(const LAS bf16x8*)(yK + fo0), yk1 = *(const LAS bf16x8*)(yK + fo1);
                        const bf16x8 xa0 = *(const LAS bf16x8*)(xA + fo0), xa1 = *(const LAS bf16x8*)(xA + fo1), xr0 = *(const LAS bf16x8*)(xR + fo0), xr1 = *(const LAS bf16x8*)(xR + fo1);
                        aN = __builtin_amdgcn_mfma_f32_16x16x32_bf16(yb0, xa0, aN, 0, 0, 0); aMk = __builtin_amdgcn_mfma_f32_16x16x32_bf16(yk0, xa0, aMk, 0, 0, 0);
                        aPb = __builtin_amdgcn_mfma_f32_16x16x32_bf16(yb0, xr0, aPb, 0, 0, 0); aPk = __builtin_amdgcn_mfma_f32_16x16x32_bf16(yk0, xr0, aPk, 0, 0, 0);
                        aN = __builtin_amdgcn_mfma_f32_16x16x32_bf16(yb1, xa1, aN, 0, 0, 0); aMk = __builtin_amdgcn_mfma_f32_16x16x32_bf16(yk1, xa1, aMk, 0, 0, 0);
                        aPb = __builtin_amdgcn_mfma_f32_16x16x32_bf16(yb1, xr1, aPb, 0, 0, 0); aPk = __builtin_amdgcn_mfma_f32_16x16x32_bf16(yk1, xr1, aPk, 0, 0, 0); }
                    if (tx <= ty) {
                        const bf16x8 ya0 = *(const LAS bf16x8*)(yA + fo0), ya1 = *(const LAS bf16x8*)(yA + fo1), xb0 = *(const LAS bf16x8*)(xB + fo0), xb1 = *(const LAS bf16x8*)(xB + fo1);
                        aNT = __builtin_amdgcn_mfma_f32_16x16x32_bf16(ya0, xb0, aNT, 0, 0, 0); aNT = __builtin_amdgcn_mfma_f32_16x16x32_bf16(ya1, xb1, aNT, 0, 0, 0); }
                    if (ty == tx) {
#pragma unroll
                        for (int q = 0; q < 4; ++q) { const int yy = 4 * kq + q; const bool lt = yy < r16, le = yy <= r16;
                            aN[q] = lt ? aN[q] : 0.f; aMk[q] = lt ? aMk[q] : 0.f; aPb[q] = le ? aPb[q] : 0.f; aPk[q] = le ? aPk[q] : 0.f; aNT[q] = (r16 < yy) ? aNT[q] : 0.f; } }
                    STORE_T(Nb, tx * 16, ty * 16, aN); STORE_T(Nb + MS, tx * 16, ty * 16, aNT); STORE_T(Mk, tx * 16, ty * 16, aMk); STORE_T(Pb, tx * 16, ty * 16, aPb); STORE_T(Pk, tx * 16, ty * 16, aPk); asm volatile("" ::: "memory"); }
                LBAR();
                for (int id = wave; id < 16; id += 8) { const int ty = id >> 2, tx = id & 3;
                    f32x4 acc = (f32x4){0.f, 0.f, 0.f, 0.f};
                    MMA16H(acc, Mk + ty * 16 * LP, VT + tx * 16 * LP, 0); if (ty >= 2) MMA16H(acc, Mk + ty * 16 * LP, VT + tx * 16 * LP, 1);
                    STORE_T(XT + MS, tx * 16, ty * 16, acc); }
                LBAR();
                }
                {
                    LAS bf16* Nc = Nb; LAS bf16* NcT = Nb + MS; LAS bf16* Nn = Nb + 2 * MS; LAS bf16* NnT = Nb + 3 * MS;
                    const int which = wave >> 2, wq = wave & 3;
                    const int tt0 = (wq == 0) ? 0 : (wq == 1) ? 3 : (wq == 2) ? 1 : 2, st0 = (wq == 0) ? 0 : (wq == 1) ? 0 : (wq == 2) ? 1 : 2;
                    const int tt1 = (wq == 0) ? 1 : (wq == 1) ? 3 : (wq == 2) ? 2 : 3, st1 = (wq == 0) ? 0 : (wq == 1) ? 1 : (wq == 2) ? 1 : 3;
                    const int tt2 = (wq == 0) ? 2 : (wq == 1) ? 3 : (wq == 2) ? 3 : 1, st2 = (wq == 0) ? 0 : (wq == 1) ? 2 : (wq == 2) ? 3 : 1;
                    const int ty0 = which ? tt0 : st0, tx0 = which ? st0 : tt0, ty1 = which ? tt1 : st1, tx1 = which ? st1 : tt1, ty2 = which ? tt2 : st2, tx2 = which ? st2 : tt2;
                    for (int k = 0; k < 6; ++k) {
                        LAS bf16* Xw = XT + wave * 16 * LP;
                        const bf16x8 b0 = *(const LAS bf16x8*)(Xw + fo0), b1 = *(const LAS bf16x8*)(Xw + fo1);
                        u32x2 c0[4]; bf16x8 a0[4], a1[4];
#pragma unroll
                        for (int ty = 0; ty < 4; ++ty) { c0[ty] = *(const LAS u32x2*)(Xw + TOFF(ty * 16)); a0[ty] = *(const LAS bf16x8*)(Nc + ty * 16 * LP + fo0); a1[ty] = *(const LAS bf16x8*)(Nc + ty * 16 * LP + fo1); }
                        const LAS bf16* sA = which ? Nc : NcT; const LAS bf16* sB = which ? NcT : Nc;
                        const bf16x8 p0 = *(const LAS bf16x8*)(sA + ty0 * 16 * LP + fo0), p1 = *(const LAS bf16x8*)(sA + ty0 * 16 * LP + fo1), q0 = *(const LAS bf16x8*)(sB + tx0 * 16 * LP + fo0), q1 = *(const LAS bf16x8*)(sB + tx0 * 16 * LP + fo1);
                        const bf16x8 p2 = *(const LAS bf16x8*)(sA + ty1 * 16 * LP + fo0), p3 = *(const LAS bf16x8*)(sA + ty1 * 16 * LP + fo1), q2 = *(const LAS bf16x8*)(sB + tx1 * 16 * LP + fo0), q3 = *(const LAS bf16x8*)(sB + tx1 * 16 * LP + fo1);
                        const bf16x8 p4 = *(const LAS bf16x8*)(sA + ty2 * 16 * LP + fo0), p5 = *(const LAS bf16x8*)(sA + ty2 * 16 * LP + fo1), q4 = *(const LAS bf16x8*)(sB + tx2 * 16 * LP + fo0), q5 = *(const LAS bf16x8*)(sB + tx2 * 16 * LP + fo1);
                        f32x4 acc[4];
#pragma unroll
                        for (int ty = 0; ty < 4; ++ty) { acc[ty] = (f32x4){bflo(c0[ty].x), bfhi(c0[ty].x), bflo(c0[ty].y), bfhi(c0[ty].y)};
                            acc[ty] = __builtin_amdgcn_mfma_f32_16x16x32_bf16(a0[ty], b0, acc[ty], 0, 0, 0); acc[ty] = __builtin_amdgcn_mfma_f32_16x16x32_bf16(a1[ty], b1, acc[ty], 0, 0, 0); }
                        const f32x4 z4 = (f32x4){0.f, 0.f, 0.f, 0.f};
                        f32x4 s0a = __builtin_amdgcn_mfma_f32_16x16x32_bf16(p0, q0, z4, 0, 0, 0), s1a = __builtin_amdgcn_mfma_f32_16x16x32_bf16(p2, q2, z4, 0, 0, 0), s2a = __builtin_amdgcn_mfma_f32_16x16x32_bf16(p4, q4, z4, 0, 0, 0);
                        s0a = __builtin_amdgcn_mfma_f32_16x16x32_bf16(p1, q1, s0a, 0, 0, 0); s1a = __builtin_amdgcn_mfma_f32_16x16x32_bf16(p3, q3, s1a, 0, 0, 0); s2a = __builtin_amdgcn_mfma_f32_16x16x32_bf16(p5, q5, s2a, 0, 0, 0);
#pragma unroll
                        for (int ty = 0; ty < 4; ++ty) STORE_T(Xw, 0, ty * 16, acc[ty]);
                        if (k < 5) { LAS bf16* dst = which ? NnT : Nn;
                            STORE_T(dst, tx0 * 16, ty0 * 16, s0a); STORE_T(dst, tx1 * 16, ty1 * 16, s1a); STORE_T(dst, tx2 * 16, ty2 * 16, s2a);
                            if (k == 0) {
                                if (wq < 3) { for (int st = wq + 1; st < 4; ++st) { const int tt = wq; const int tyz = which ? tt : st, txz = which ? st : tt; STORE_T(dst, txz * 16, tyz * 16, z4); } } } }
                        LBAR();
                        { LAS bf16* t0 = Nc; Nc = Nn; Nn = t0; t0 = NcT; NcT = NnT; NnT = t0; }
                    }
                }
                for (int rep_ = 0; rep_ <= ((args.sub >> 10) & 1); ++rep_) {
                    bf16* cho = CH + (size_t)u * 16384;
#pragma unroll
                    for (int n2 = 0; n2 < 2; ++n2) {
                        const int ty = n2 * 2 + (wave >> 2), tx = wave & 3;
                        const int xg = tx * 16 + r16, yg = ty * 16 + 4 * kq;
                        const f32x4 z4 = (f32x4){0.f, 0.f, 0.f, 0.f};
                        f32x4 aRp = z4, aPm = z4, aYl = z4, aQm = z4;
#pragma unroll
                        for (int h = 0; h < 2; ++h) { const int fo = h ? fo1 : fo0;
                            const bf16x8 yU = *(const LAS bf16x8*)(XT + ty * 16 * LP + fo), yPb = *(const LAS bf16x8*)(Pb + ty * 16 * LP + fo), yPk = *(const LAS bf16x8*)(Pk + ty * 16 * LP + fo),
                                         yBh = *(const LAS bf16x8*)(BhT + ty * 16 * LP + fo), yKh = *(const LAS bf16x8*)(KhT + ty * 16 * LP + fo);
                            const bf16x8 xPb = *(const LAS bf16x8*)(Pb + tx * 16 * LP + fo), xBh = *(const LAS bf16x8*)(BhT + tx * 16 * LP + fo), xUv = *(const LAS bf16x8*)(XT + MS + tx * 16 * LP + fo), xV = *(const LAS bf16x8*)(VT + tx * 16 * LP + fo);
                            aRp = __builtin_amdgcn_mfma_f32_16x16x32_bf16(yU, xPb, aRp, 0, 0, 0);
                            aPm = __builtin_amdgcn_mfma_f32_16x16x32_bf16(yU, xBh, aPm, 0, 0, 0);
                            aYl = __builtin_amdgcn_mfma_f32_16x16x32_bf16(yPb, xUv, aYl, 0, 0, 0);
                            aYl = __builtin_amdgcn_mfma_f32_16x16x32_bf16(yPk, xV, aYl, 0, 0, 0);
                            aQm = __builtin_amdgcn_mfma_f32_16x16x32_bf16(yBh, xUv, aQm, 0, 0, 0);
                            aQm = __builtin_amdgcn_mfma_f32_16x16x32_bf16(yKh, xV, aQm, 0, 0, 0); }
                        { const u32x2 c0 = *(const LAS u32x2*)(Rt + tx * 16 * LP + TOFF(ty * 16)); aRp[0] += bflo(c0.x); aRp[1] += bfhi(c0.x); aRp[2] += bflo(c0.y); aRp[3] += bfhi(c0.y); }
                        { const float wl = tot[512 + xg];
#pragma unroll
                          for (int q = 0; q < 4; ++q) aPm[q] += (yg + q == xg) ? wl : 0.f; }
                        u32x2 w2; int lofs = xg * 64 + yg; asm volatile("" : "+v"(lofs));
                        bf16* const cl = cho + lofs;
                        w2.x = pk2(aRp[0], aRp[1]); w2.y = pk2(aRp[2], aRp[3]); *(u32x2*)(cl + 0 * 4096) = w2;
                        w2.x = pk2(aPm[0], aPm[1]); w2.y = pk2(aPm[2], aPm[3]); *(u32x2*)(cl + 1 * 4096) = w2;
                        w2.x = pk2(aYl[0], aYl[1]); w2.y = pk2(aYl[2], aYl[3]); *(u32x2*)(cl + 2 * 4096) = w2;
                        w2.x = pk2(aQm[0], aQm[1]); w2.y = pk2(aQm[2], aQm[3]); *(u32x2*)(cl + 3 * 4096) = w2; asm volatile("" ::: "memory"); }
                }
                LBAR();
            }
#undef E0_LOAD
#undef MMA16
#undef MMA16H
#undef STORE_T
#undef TOFF
#undef LBAR
            SEAM(P + 2);
        }
        if (PHEN(15) && IN(P + 3)) {
            PHASE_PROLOGUE
            constexpr int LP = 72, MS = 16 * LP;
            LAS bf16* Sb = (LAS bf16*)lds;
            const int r16 = lane & 15, kq = lane >> 4, ty = wave & 3, role = wave >> 2;
            for (int wu = bx; wu < 256; wu += G) {
                const int chain = (wu & 7) + 8 * (wu >> 5), it = (wu >> 3) & 3;
                const int e = chain >> 5, b = (chain >> 2) & 7, hh = chain & 3;
                for (int i = tid; i < 2 * MS / 2; i += NWAVES * 64) ((LAS unsigned*)Sb)[i] = 0u;
                __syncthreads();
                const bf16* ch0 = CH + (size_t)chain * 64 * 16384;
                float* ysb = YS + ((size_t)(e * 8 + b) * T) * 256 + hh * 64 + it * 16 + r16;
#define SQ_LOAD(Aq, Cq, c) do { const bf16* _ab = ch0 + (size_t)(c) * 16384 + (role ? 0 : 4096) + (ty * 16 + r16) * 64 + kq * 8; \
        Aq[0] = *(const bf16x8*)_ab; Aq[1] = *(const bf16x8*)(_ab + 32); \
        Cq = *(const u32x2*)(ch0 + (size_t)(c) * 16384 + (role ? 8192 : 12288) + (it * 16 + r16) * 64 + ty * 16 + 4 * kq); } while (0)
#define SQ_STEP(Aq, Cq, c) do { const LAS bf16* _Sc = Sb + ((c) & 1) * MS; LAS bf16* _Sn = Sb + (((c) + 1) & 1) * MS; \
        const bf16x8 _b0 = *(const LAS bf16x8*)(_Sc + r16 * LP + kq * 8), _b1 = *(const LAS bf16x8*)(_Sc + r16 * LP + 32 + kq * 8); \
        f32x4 _acc = (f32x4){bflo(Cq.x), bfhi(Cq.x), bflo(Cq.y), bfhi(Cq.y)}; \
        _acc = __builtin_amdgcn_mfma_f32_16x16x32_bf16(Aq[0], _b0, _acc, 0, 0, 0); _acc = __builtin_amdgcn_mfma_f32_16x16x32_bf16(Aq[1], _b1, _acc, 0, 0, 0); \
        if (role == 0) { u32x2 _w; _w.x = pk2(_acc[0], _acc[1]); _w.y = pk2(_acc[2], _acc[3]); *(LAS u32x2*)(_Sn + r16 * LP + ty * 16 + 4 * kq) = _w; } \
        else { _Pragma("unroll") for (int _q = 0; _q < 4; ++_q) { const int _s = (c) * 64 + ty * 16 + 4 * kq + _q; const int _t = e ? (T - 1 - _s) : _s; ysb[(size_t)_t * 256] = _acc[_q]; } } \
        asm volatile("s_waitcnt lgkmcnt(0)" ::: "memory"); __builtin_amdgcn_s_barrier(); asm volatile("" ::: "memory"); } while (0)
                bf16x8 A0[2], A1[2], A2[2], A3[2], A4[2], A5[2], A6[2], A7[2]; u32x2 C0, C1, C2, C3, C4, C5, C6, C7;
                if constexpr (l == 0) {
                SQ_LOAD(A0, C0, 0); SQ_LOAD(A1, C1, 1); SQ_LOAD(A2, C2, 2); SQ_LOAD(A3, C3, 3); SQ_LOAD(A4, C4, 4); SQ_LOAD(A5, C5, 5); SQ_LOAD(A6, C6, 6);
                for (int c = 0; c < 64; c += 8) {
                    SQ_LOAD(A7, C7, c + 7);
                    SQ_STEP(A0, C0, c);
                    SQ_LOAD(A0, C0, min(c + 8, 63));
                    SQ_STEP(A1, C1, c + 1);
                    SQ_LOAD(A1, C1, min(c + 9, 63));
                    SQ_STEP(A2, C2, c + 2);
                    SQ_LOAD(A2, C2, min(c + 10, 63));
                    SQ_STEP(A3, C3, c + 3);
                    SQ_LOAD(A3, C3, min(c + 11, 63));
                    SQ_STEP(A4, C4, c + 4);
                    SQ_LOAD(A4, C4, min(c + 12, 63));
                    SQ_STEP(A5, C5, c + 5);
                    SQ_LOAD(A5, C5, min(c + 13, 63));
                    SQ_STEP(A6, C6, c + 6);
                    SQ_LOAD(A6, C6, min(c + 14, 63));
                    SQ_STEP(A7, C7, c + 7);
                }
                } else {
                LAS float* scr = (LAS float*)(lds + 8192 + wave * 8448);
                const float* mw1 = INP(IN_MW1); const float* mw3 = INP(IN_MW3); const float* mw2 = INP(IN_MW2);
                float rv[32];
#define CV_DECODE(j_) const int _g = gw + NGW * (j_), _e = _g / 5376, _r = _g % 5376, _wh = _r / 1792, _it = _r % 1792; \
        const int _nblk = (_wh == 2) ? 32 : 112, _kb = _it / _nblk, _nb = _it % _nblk, _N = (_wh == 2) ? D : FF, _K = (_wh == 2) ? FF : D; \
        const float* _src = ((_wh == 0) ? mw1 : (_wh == 1) ? mw3 : mw2) + (size_t)_e * D * FF
#define CV_LOAD(j_) do { CV_DECODE(j_); const float* _w = _src + (size_t)(64 * _kb + (lane >> 5)) * _N + 32 * _nb + (lane & 31); \
        _Pragma("unroll") for (int i = 0; i < 32; ++i) rv[i] = _w[(size_t)(2 * i) * _N]; } while (0)
#define CV_FINISH(j_) do { CV_DECODE(j_); const int _n0 = 32 * _nb, _k0 = 64 * _kb; const float _sc = (_wh == 2) ? SC_W2 : SC_W13; \
        const int _drow0 = (_wh == 2) ? _n0 : (256 * (_n0 >> 7) + (_n0 & 127) + (_wh == 1 ? 128 : 0)); \
        unsigned char* _dst = (_wh == 2) ? (ws + WS_WM2 + (size_t)_e * D * FF) : (ws + WS_WM13 + (size_t)_e * 2 * FF * D); \
        _Pragma("unroll") for (int i = 0; i < 32; ++i) scr[(2 * i + (lane >> 5)) * 33 + (lane & 31)] = rv[i]; \
        LDS_WAIT(); asm volatile("" ::: "memory"); \
        { const int c_ = lane & 7; \
          _Pragma("unroll") for (int j = 0; j < 4; ++j) { const int n = (lane >> 3) + 8 * j; const LAS float* s_ = scr + (8 * c_) * 33 + n; \
            u32x2 o; o.x = pg8::cvt4_fp8(s_[0 * 33] * _sc, s_[1 * 33] * _sc, s_[2 * 33] * _sc, s_[3 * 33] * _sc); o.y = pg8::cvt4_fp8(s_[4 * 33] * _sc, s_[5 * 33] * _sc, s_[6 * 33] * _sc, s_[7 * 33] * _sc); \
            *(u32x2*)(_dst + (size_t)(_drow0 + n) * _K + _k0 + 8 * c_) = o; } } \
        LDS_WAIT(); asm volatile("" ::: "memory"); } while (0)
                SQ_LOAD(A0, C0, 0); SQ_LOAD(A1, C1, 1); SQ_LOAD(A2, C2, 2); SQ_LOAD(A3, C3, 3); SQ_LOAD(A4, C4, 4);
                for (int c = 0; c < 60; c += 6) { const int j0 = (c / 6) * 2;
                    CV_LOAD(j0);
                    SQ_LOAD(A5, C5, c + 5);
                    SQ_STEP(A0, C0, c);     SQ_LOAD(A0, C0, min(c + 6, 63));
                    SQ_STEP(A1, C1, c + 1); SQ_LOAD(A1, C1, min(c + 7, 63));
                    CV_FINISH(j0); CV_LOAD(j0 + 1);
                    SQ_STEP(A2, C2, c + 2); SQ_LOAD(A2, C2, min(c + 8, 63));
                    SQ_STEP(A3, C3, c + 3); SQ_LOAD(A3, C3, min(c + 9, 63));
                    SQ_STEP(A4, C4, c + 4); SQ_LOAD(A4, C4, min(c + 10, 63));
                    CV_FINISH(j0 + 1);
                    SQ_STEP(A5, C5, c + 5);
                }
                CV_LOAD(20);
                SQ_STEP(A0, C0, 60); SQ_STEP(A1, C1, 61);
                CV_FINISH(20);
                SQ_STEP(A2, C2, 62); SQ_STEP(A3, C3, 63);
#undef CV_DECODE
#undef CV_LOAD
#undef CV_FINISH
                }
#undef SQ_LOAD
#undef SQ_STEP
                __syncthreads();
            }
            SEAM(P + 3);
        }
        if (PHEN(5) && IN(P + 4)) {
            PHASE_PROLOGUE
            LAS bf16* G2T = (LAS bf16*)lds;
            LAS bf16* SGB = G2T + 256 * 72;
            LAS float* GT = (LAS float*)(SGB + 16 * 72);
            const int c = tid & 255, hf = tid >> 8, r16 = lane & 15, kq = lane >> 4;
            { const float* g2p = INP(IN_G2) + (size_t)l * 64 * GW;
              for (int i = tid; i < 64 * 256; i += NWAVES * 64) G2T[(i & 255) * 72 + (i >> 8)] = (bf16)f2bf(g2p[i]); }
            const float lw = INP(IN_LNW)[(size_t)l * GW + c], lb = INP(IN_LNB)[(size_t)l * GW + c], rk = INP(IN_RK)[(size_t)l * GW + c];
            for (int it = vcu; it < M / 16; it += G) {
                const int m0 = it * 16;
                for (int i = tid; i < 1024; i += NWAVES * 64) SGB[(i >> 6) * 72 + (i & 63)] = (bf16)f2bf(sigmoidf_(bf2f(Z[(size_t)(m0 + (i >> 6)) * ZW + ZLG + (i & 63)])));
                __syncthreads();
                { const bf16x8 b0 = *(const LAS bf16x8*)(SGB + r16 * 72 + kq * 8), b1 = *(const LAS bf16x8*)(SGB + r16 * 72 + 32 + kq * 8);
#pragma unroll
                  for (int n2 = 0; n2 < 2; ++n2) { const int ct = wave * 2 + n2; const LAS bf16* ap = G2T + (ct * 16 + r16) * 72 + kq * 8;
                      f32x4 acc = __builtin_amdgcn_mfma_f32_16x16x32_bf16(*(const LAS bf16x8*)ap, b0, (f32x4){0.f, 0.f, 0.f, 0.f}, 0, 0, 0);
                      acc = __builtin_amdgcn_mfma_f32_16x16x32_bf16(*(const LAS bf16x8*)(ap + 32), b1, acc, 0, 0, 0);
                      *(LAS f32x4*)(GT + r16 * 260 + ct * 16 + 4 * kq) = acc; } }
                __syncthreads();
                float ya[8], yb[8], r0[8], k0[8], v0[8], res[8];
#pragma unroll
                for (int k = 0; k < 8; ++k) { const int m = m0 + hf * 8 + k; const bf16* zc = Z + (size_t)m * ZW + ZR;
                    ya[k] = YS[(size_t)m * 256 + c]; yb[k] = YS[(size_t)(M + m) * 256 + c]; r0[k] = bf2f(zc[c]); k0[k] = bf2f(zc[256 + c]); v0[k] = bf2f(zc[512 + c]); }
#pragma unroll
                for (int k = 0; k < 8; ++k) { const int tt = hf * 8 + k;
                    const float y = ya[k] + yb[k];
                    const float mean = wave_sum(y) * (1.0f / 64.0f); const float dv = y - mean;
                    const float var = wave_sum(dv * dv) * (1.0f / 64.0f);
                    float yn = dv * __builtin_amdgcn_rsqf(var + LNX_EPS) * lw + lb;
                    yn += wave_sum(r0[k] * k0[k] * rk) * v0[k];
                    res[k] = yn * GT[tt * 260 + c]; }
#pragma unroll
                for (int k = 0; k < 8; ++k) YCAT[(size_t)(m0 + hf * 8 + k) * D + 256 + c] = (bf16)f2bf(res[k]);
                __syncthreads();
            }
            SEAM(P + 4);
        }
        if (PHEN(6) && IN(P + 5)) {
            PHASE_PROLOGUE
            pg8::Gemm g{YCAT, (const bf16*)(ws + WS_WOUT) + (size_t)l * D * D, M, D, D, nullptr, 0}; pg8::StaticOrder S; S.init(M, D, G, bx);
            pg8::EpiBf16 E{Y, D, 1.0f};
            pg8::gemm_phase<pg8::EpiBf16, pg8::StaticOrder, false>(lds, g, S, E);
            SEAM(P + 5);
        }
        if (PHEN(7) && IN(P + 6)) {
            PHASE_PROLOGUE
            LAS float* rw = (LAS float*)lds;
            LAS int* lcnt = (LAS int*)(lds + 32768);
            if (l == 1) { const float* rwp = INP(IN_ROUTER); for (int i = tid; i < D * NE; i += NWAVES * 64) rw[i] = rwp[i]; if (tid < 8) lcnt[tid] = 0; __syncthreads(); }
            const float* xsrc = (l == 0) ? INP(IN_X) : X; const float* ng = INP(IN_NORMG) + (size_t)l * 4 * D;
            const int m0 = bx * 128 + wave;
            f32x4 a1[4], bvv[4], cvv[4];
            { const float* mod = mod_l + (size_t)(m0 / T) * 6 * D; load_rowvecs(ng + 1 * D, mod + 2 * D, ng + 2 * D, mod + 4 * D, mod + 3 * D, lane, a1, bvv, cvv); }
            f32x4 yn[4], xn[4];
            ld_row_bf16(Y + (size_t)m0 * D, lane, yn); ld_row_f32(xsrc + (size_t)m0 * D, lane, xn);
#pragma unroll 1
            for (int r = 0; r < 16; ++r) { const int m = m0 + 8 * r, mn = m0 + 8 * min(r + 1, 15);
                f32x4 yv[4], xv[4], hv[4];
#pragma unroll
                for (int j = 0; j < 4; ++j) { yv[j] = yn[j]; xv[j] = xn[j]; }
                ld_row_bf16(Y + (size_t)mn * D, lane, yn); ld_row_f32(xsrc + (size_t)mn * D, lane, xn);
                const float rs = row_rstd(yv);
#pragma unroll
                for (int j = 0; j < 4; ++j) xv[j] = xv[j] + a1[j] * (yv[j] * rs);
                st_row_f32(X + (size_t)m * D, lane, xv);
                { const float rs2 = row_rstd(xv);
#pragma unroll
                  for (int j = 0; j < 4; ++j) hv[j] = xv[j] * rs2 * bvv[j] + cvv[j]; }
                if (l == 0) st_row_bf16(H + (size_t)m * D, lane, hv);
                else {
#pragma unroll
                    for (int j = 0; j < 4; ++j) *(unsigned*)((unsigned char*)H + (size_t)m * D + 4 * lane + 256 * j) = pg8::cvt4_fp8(hv[j][0] * SC_H8, hv[j][1] * SC_H8, hv[j][2] * SC_H8, hv[j][3] * SC_H8); }
                if (l == 1) {
                    float lg[8];
#pragma unroll
                    for (int e = 0; e < 8; ++e) lg[e] = 0.f;
#pragma unroll
                    for (int j = 0; j < 4; ++j)
#pragma unroll
                        for (int x = 0; x < 4; ++x) { const LAS float* rr = rw + (4 * lane + 256 * j + x) * 8; const f32x4 w0 = *(const LAS f32x4*)rr, w1 = *(const LAS f32x4*)(rr + 4); const float hx = hv[j][x];
                            lg[0] += hx * w0[0]; lg[1] += hx * w0[1]; lg[2] += hx * w0[2]; lg[3] += hx * w0[3]; lg[4] += hx * w1[0]; lg[5] += hx * w1[1]; lg[6] += hx * w1[2]; lg[7] += hx * w1[3]; }
#pragma unroll
                    for (int e = 0; e < 8; ++e) lg[e] = wave_sum(lg[e]);
                    int i1 = 0; float v1 = lg[0];
#pragma unroll
                    for (int e = 1; e < 8; ++e) if (lg[e] > v1) { v1 = lg[e]; i1 = e; }
                    int i2 = -1; float v2 = -3.0e38f;
#pragma unroll
                    for (int e = 0; e < 8; ++e) if (e != i1 && lg[e] > v2) { v2 = lg[e]; i2 = e; }
                    if (lane == 0) { const float g2 = 1.0f / (1.0f + __expf(v1 - v2)); TOPI[2 * m] = i1; TOPI[2 * m + 1] = i2; GATE[2 * m] = 1.0f - g2; GATE[2 * m + 1] = g2;
                        __hip_atomic_fetch_add(lcnt + i1, 1, __ATOMIC_RELAXED, __HIP_MEMORY_SCOPE_WORKGROUP); __hip_atomic_fetch_add(lcnt + i2, 1, __ATOMIC_RELAXED, __HIP_MEMORY_SCOPE_WORKGROUP); }
                }
            }
            if (l == 1) { __syncthreads(); if (tid < 8) WGCNT[bx * 8 + tid] = lcnt[tid]; }
            SEAM(P + 6);
        }
        if (l == 0) {
            if (PHEN(8) && IN(P + 7)) {
            PHASE_PROLOGUE
                pg8::Gemm g{H, (const bf16*)(ws + WS_W13), M, 2 * FF, D, nullptr, 0}; pg8::StaticOrder S; S.init(M, 2 * FF, G, bx);
                pg8::EpiSwiGLU E{HID, FF};
                pg8::gemm_phase<pg8::EpiSwiGLU, pg8::StaticOrder, false>(lds, g, S, E);
                SEAM(P + 7);
            }
            if (PHEN(9) && IN(P + 8)) {
            PHASE_PROLOGUE
                pg8::Gemm g{HID, (const bf16*)(ws + WS_W2), M, D, FF, nullptr, 0}; pg8::StaticOrder S; S.init(M, D, G, bx);
                pg8::EpiBf16 E{Y, D, 1.0f};
                pg8::gemm_phase<pg8::EpiBf16, pg8::StaticOrder, false>(lds, g, S, E);
                SEAM(P + 8);
            }
            if (PHEN(10) && IN(P + 9)) {
            PHASE_PROLOGUE
                const float* ng = INP(IN_NORMG) + (size_t)l * 4 * D; const float* ng1 = INP(IN_NORMG) + 4 * D;
                const int m0 = bx * 128 + wave;
                f32x4 a1[4], bvv[4], cvv[4];
                { const float* mod = mod_l + (size_t)(m0 / T) * 6 * D; const float* mod1 = MOD + (size_t)(8 + m0 / T) * 6 * D; load_rowvecs(ng + 3 * D, mod + 5 * D, ng1, mod1 + D, mod1, lane, a1, bvv, cvv); }
                f32x4 yn[4], xn[4];
                ld_row_bf16(Y + (size_t)m0 * D, lane, yn); ld_row_f32(X + (size_t)m0 * D, lane, xn);
#pragma unroll 1
                for (int r = 0; r < 16; ++r) { const int m = m0 + 8 * r, mn = m0 + 8 * min(r + 1, 15);
                    f32x4 yv[4], xv[4], hv[4];
#pragma unroll
                    for (int j = 0; j < 4; ++j) { yv[j] = yn[j]; xv[j] = xn[j]; }
                    ld_row_bf16(Y + (size_t)mn * D, lane, yn); ld_row_f32(X + (size_t)mn * D, lane, xn);
                    const float rs = row_rstd(yv);
#pragma unroll
                    for (int j = 0; j < 4; ++j) xv[j] = xv[j] + a1[j] * (yv[j] * rs);
                    st_row_f32(X + (size_t)m * D, lane, xv);
                    const float rs2 = row_rstd(xv);
#pragma unroll
                    for (int j = 0; j < 4; ++j) hv[j] = xv[j] * rs2 * bvv[j] + cvv[j];
                    st_row_bf16(H + (size_t)m * D, lane, hv); }
                SEAM(P + 9);
            }
        } else {
            if (PHEN(11) && IN(P + 7)) {
            PHASE_PROLOGUE
                LAS int* sh = (LAS int*)lds;
                if (tid < 8) { int tot = 0, before = 0; for (int w = 0; w < G; ++w) { const int c = WGCNT[w * 8 + tid]; if (w < bx) before += c; tot += c; } sh[24 + tid] = tot; sh[tid] = before; sh[8 + tid] = 0; }
                __syncthreads();
                if (tid == 0) { int ps = 0; for (int e = 0; e < 8; ++e) { sh[16 + e] = ps; ps += (sh[24 + e] + 255) / 256 * 256; }
                    if (bx == 0) { MOEINFO[0] = ps / 256; { int pe = 0; for (int e = 0; e < 7; ++e) { pe += (sh[24 + e] + 255) / 256; MOEINFO[1 + e] = pe; } } int blk = 0; for (int e = 0; e < 8; ++e) { const int nb = (sh[24 + e] + 255) / 256; for (int q = 0; q < nb; ++q) MOEINFO[8 + blk++] = e; } for (; blk < MOE_BLKS; ++blk) MOEINFO[8 + blk] = 7; } }
                __syncthreads();
                if (tid < 256) { const int tok = bx * 128 + (tid >> 1), e = TOPI[bx * 256 + tid];
                    const int rank = __hip_atomic_fetch_add(sh + 8 + e, 1, __ATOMIC_RELAXED, __HIP_MEMORY_SCOPE_WORKGROUP); const int dest = sh[16 + e] + sh[e] + rank;
                    DEST[bx * 256 + tid] = dest; ROWTOK[dest] = tok; }
                if (bx < 8 && tid < 256) { const int e = bx, cnt = sh[24 + e], pe = sh[16 + e] + (cnt + 255) / 256 * 256; const int d = sh[16 + e] + cnt + tid; if (d < pe) ROWTOK[d] = 0; }
                __syncthreads();
                SEAM(P + 7);
            }
            for (int part = 0; part < NPART; ++part) {
                const int pm0 = part * PART_BLKS;
                if (PHEN(12) && IN(P + 8 + 2 * part)) {
            PHASE_PROLOGUE
                    const int nblk = MOEINFO[0]; const int nb = min(max(nblk - pm0, 0), PART_BLKS);
                    pg8::Gemm g{H, (const bf16*)(ws + WS_WM13), nb * 256, 2 * FF, D / 2, ROWTOK, 0}; pg8::MoeOrder S; S.init(nb * 256, 2 * FF, G, bx); S.ee.load(MOEINFO); S.pm0 = pm0; S.apm0 = pm0; S.estride = (size_t)2 * FF * D;
                    pg8::EpiSwiGLU8 E{ws + WS_HIDM, FF, 1.0f / (SC_H8 * SC_W13), SC_HID};
                    pg8::gemm_phase<pg8::EpiSwiGLU8, pg8::MoeOrder, true, true>(lds, g, S, E);
                    SEAM(P + 8 + 2 * part);
                }
                if (PHEN(13) && IN(P + 9 + 2 * part)) {
            PHASE_PROLOGUE
                    const int nblk = MOEINFO[0]; const int nb = min(max(nblk - pm0, 0), PART_BLKS);
                    const int fb = min(nb, 256);
                    { pg8::Gemm g{(const bf16*)(ws + WS_HIDM), (const bf16*)(ws + WS_WM2), fb * 256, D, FF / 2, nullptr, 0}; pg8::MoeOrder S; S.init(fb * 256, D, G, bx); S.ee.load(MOEINFO); S.pm0 = pm0; S.apm0 = 0; S.estride = (size_t)D * FF;
                      pg8::EpiBf16 E{(bf16*)(ws + WS_YB) + (size_t)pm0 * 256 * D, D, 1.0f / (SC_HID * SC_W2)};
                      pg8::gemm_phase<pg8::EpiBf16, pg8::MoeOrder, false, true>(lds, g, S, E); }
                    if (nb > 256) {
                        const int ntask = (nb - 256) * 4 * 7, tk = bx, unit = tk / 7, sl = tk % 7;
                        pg8::Gemm g{(const bf16*)(ws + WS_HIDM + (size_t)256 * 256 * FF + (size_t)sl * 512), (const bf16*)(ws + WS_WM2 + (size_t)sl * 512), (nb - 256) * 256, D, 256, nullptr, FF / 2};
                        pg8::TailOrder S; S.ee.load(MOEINFO); S.pm0 = 256; S.unit = unit; S.has = tk < ntask; S.estride = (size_t)D * FF;
                        pg8::EpiBf16 E{(bf16*)(ws + WS_SLAB) + (size_t)sl * 8 * 256 * D, D, 1.0f / (SC_HID * SC_W2)};
                        pg8::gemm_phase<pg8::EpiBf16, pg8::TailOrder, false, true>(lds, g, S, E); }
                    SEAM(P + 9 + 2 * part);
                }
            }
            if (PHEN(14) && IN(P + 8 + 2 * NPART)) {
            PHASE_PROLOGUE
                const bf16* YB = (const bf16*)(ws + WS_YB); const float* ng = INP(IN_NORMG) + (size_t)l * 4 * D;
                const int m0 = bx * 128 + wave;
                f32x4 a1[4];
                { const float* mod = mod_l + (size_t)(m0 / T) * 6 * D;
#pragma unroll
                  for (int j = 0; j < 4; ++j) a1[j] = *(const f32x4*)(ng + 3 * D + 4 * lane + 256 * j) * *(const f32x4*)(mod + 5 * D + 4 * lane + 256 * j); }
                const int dlane = DEST[2 * (m0 + 8 * ((lane & 31) >> 1)) + (lane & 1)]; const float glane = GATE[2 * (m0 + 8 * ((lane & 31) >> 1)) + (lane & 1)];
                f32x4 y0n[4], y1n[4], xn[4];
                const bf16* SLAB = (const bf16*)(ws + WS_SLAB);
                { const int d0 = __builtin_amdgcn_readlane(dlane, 0), d1 = __builtin_amdgcn_readlane(dlane, 1);
                  ld_moe_row(YB, SLAB, d0, lane, y0n); ld_moe_row(YB, SLAB, d1, lane, y1n); ld_row_f32(X + (size_t)m0 * D, lane, xn); }
#pragma unroll 1
                for (int r = 0; r < 16; ++r) { const int m = m0 + 8 * r, rn = min(r + 1, 15);
                    const float g0 = __builtin_bit_cast(float, __builtin_amdgcn_readlane(__builtin_bit_cast(int, glane), 2 * r)), g1 = __builtin_bit_cast(float, __builtin_amdgcn_readlane(__builtin_bit_cast(int, glane), 2 * r + 1));
                    f32x4 y0[4], y1[4], xv[4];
#pragma unroll
                    for (int j = 0; j < 4; ++j) { y0[j] = y0n[j]; y1[j] = y1n[j]; xv[j] = xn[j]; }
                    { const int d0 = __builtin_amdgcn_readlane(dlane, 2 * rn), d1 = __builtin_amdgcn_readlane(dlane, 2 * rn + 1);
                      ld_moe_row(YB, SLAB, d0, lane, y0n); ld_moe_row(YB, SLAB, d1, lane, y1n); ld_row_f32(X + (size_t)(m0 + 8 * rn) * D, lane, xn); }
#pragma unroll
                    for (int j = 0; j < 4; ++j) y0[j] = g0 * y0[j] + g1 * y1[j];
                    const float rs = row_rstd(y0);
#pragma unroll
                    for (int j = 0; j < 4; ++j) xv[j] = xv[j] + a1[j] * (y0[j] * rs);
                    st_row_f32(X + (size_t)m * D, lane, xv); }
            }
        }
}
__global__ void __launch_bounds__(NWAVES * 64, 2) skel_fwd(Args args) {
    extern __shared__ __attribute__((aligned(16))) unsigned char lds_raw[];
    LAS unsigned char* lds = (LAS unsigned char*)lds_raw;
    volatile LAS unsigned* MISC = (volatile LAS unsigned*)(lds + MISC_OFF);
    const int tid0 = threadIdx.x;
    const int G = gridDim.x, bx = blockIdx.x;
    const int vcu = (G % 8 == 0) ? (bx % 8) * (G / 8) + bx / 8 : bx;
    const int NGW = G * NWAVES;
    unsigned char* const ws0 = args.ws;
    unsigned* ctl = (unsigned*)(ws0 + WS_CTL);
    for (int u = tid0; u < 128; u += NWAVES * 64) ((LAS unsigned*)(lds + MISC_OFF))[u] = 0u;
    __syncthreads();
    XcdBarrier bar; bar.bar = ctl; bar.x = 0; bar.st = nullptr;
    if (MK_N_LAUNCHES == 1) bar = xcd_barrier_post(ctl, MISC + 8);
    const int lo = args.ph_lo, hi = args.ph_hi;


    if (PHEN(0) && IN(0)) {
            PHASE_PROLOGUE
        LAS float* scr = (LAS float*)(lds + wave * 16384);
        for (int l = 0; l < 2; ++l) {
            transpose_mat<0>(INP(IN_WIN) + (size_t)l * D * INW, D, INW, (bf16*)(ws + WS_WIN) + (size_t)l * ZW * D, gw, NGW, scr, lane);
            transpose_mat<0>(INP(IN_WOUT) + (size_t)l * D * D, D, D, (bf16*)(ws + WS_WOUT) + (size_t)l * D * D, gw, NGW, scr, lane);
            bf16* pad = (bf16*)(ws + WS_WIN) + (size_t)l * ZW * D + (size_t)INW * D;
            for (int i = gw * 64 + lane; i < (ZW - INW) * D / 8; i += NGW * 64) *(u32x4*)(pad + (size_t)i * 8) = (u32x4){0u, 0u, 0u, 0u};
        }
        transpose_mat<1>(INP(IN_FW1), D, FF, (bf16*)(ws + WS_W13), gw, NGW, scr, lane);
        transpose_mat<2>(INP(IN_FW3), D, FF, (bf16*)(ws + WS_W13), gw, NGW, scr, lane);
        transpose_mat<0>(INP(IN_FW2), FF, D, (bf16*)(ws + WS_W2), gw, NGW, scr, lane);
        __syncthreads();
        {
            LAS float* sc = (LAS float*)lds;
            LAS float* red = (LAS float*)(lds + 32768);
            bool have = false;
            for (int it = vcu; it < 2 * 96; it += G) {
                if (!have) { const float* cin = INP(IN_C); for (int i = tid; i < BATCH * D; i += NWAVES * 64) { const float c = cin[i]; sc[i] = c / (1.0f + __expf(-c)); } __syncthreads(); have = true; }
                const int l = it / 96, n = (it % 96) * 64 + (tid & 63), kg = tid >> 6;
                const float* w = INP(IN_ADAW) + (size_t)l * D * 6 * D + (size_t)(kg * 128) * 6 * D + n;
                float a[8];
#pragma unroll
                for (int b = 0; b < 8; ++b) a[b] = 0.f;
#pragma unroll 1
                for (int k0 = 0; k0 < 128; k0 += 16) { float wv[16];
#pragma unroll
                    for (int q = 0; q < 16; ++q) wv[q] = w[(size_t)(k0 + q) * 6 * D];
#pragma unroll
                    for (int q = 0; q < 16; ++q)
#pragma unroll
                        for (int b = 0; b < 8; ++b) a[b] += sc[b * D + kg * 128 + k0 + q] * wv[q]; }
#pragma unroll
                for (int b = 0; b < 8; ++b) red[(kg * 8 + b) * 64 + (tid & 63)] = a[b];
                __syncthreads();
                if (tid < 512) { const int b = tid >> 6, c = tid & 63; float s_ = 0.f;
#pragma unroll
                    for (int q = 0; q < 8; ++q) s_ += red[(q * 8 + b) * 64 + c];
                    const int nn = (it % 96) * 64 + c;
                    MOD[((size_t)l * 8 + b) * 6 * D + nn] = s_ + INP(IN_ADAB)[(size_t)l * 6 * D + nn]; }
                __syncthreads();
            }
        }
        SEAM(0);
    }
    if (PHEN(1) && IN(1)) {
            PHASE_PROLOGUE
        const float* x_in = INP(IN_X); const float* ng0 = INP(IN_NORMG);
        const int m0 = bx * 128 + wave;
        f32x4 bvv[4], cvv[4], xn[4];
        { const float* mod = MOD + (size_t)(m0 / T) * 6 * D;
#pragma unroll
          for (int j = 0; j < 4; ++j) { const int o = 4 * lane + 256 * j; bvv[j] = *(const f32x4*)(ng0 + o) * (1.0f + *(const f32x4*)(mod + D + o)); cvv[j] = *(const f32x4*)(mod + o); } }
        ld_row_f32(x_in + (size_t)m0 * D, lane, xn);
#pragma unroll 1
        for (int r = 0; r < 16; ++r) { const int m = m0 + 8 * r;
            f32x4 xv[4], hv[4];
#pragma unroll
            for (int j = 0; j < 4; ++j) xv[j] = xn[j];
            ld_row_f32(x_in + (size_t)(m0 + 8 * min(r + 1, 15)) * D, lane, xn);
            const float rs = row_rstd(xv);
#pragma unroll
            for (int j = 0; j < 4; ++j) hv[j] = xv[j] * rs * bvv[j] + cvv[j];
            st_row_bf16(H + (size_t)m * D, lane, hv); }
        SEAM(1);
    }
    layer_phases<0>(args, ws0, lds, vcu, G, bx, NGW, lo, hi, bar);
    layer_phases<1>(args, ws0, lds, vcu, G, bx, NGW, lo, hi, bar);
#undef IN
#undef SEAM
}
constexpr int N_PHASES = 18 + 8 + 2 * NPART + 1;

extern "C" void kernel_launch(void* const* d_in, const int* in_sizes, int n_in, void* d_out, int out_size, void* d_ws, size_t ws_size, hipStream_t stream) {
    static int grid = 0;
    if (grid == 0) {
        if (n_in != 29 || out_size != M * D || ws_size < WS_END) { fprintf(stderr, "kernel_launch: unexpected shapes (n_in %d out %d ws %zu)\n", n_in, out_size, ws_size); grid = -1; return; }
        int dev = 0, cus = 0;
        if (hipGetDevice(&dev) != hipSuccess || hipDeviceGetAttribute(&cus, hipDeviceAttributeMultiprocessorCount, dev) != hipSuccess) { grid = -1; return; }
        if (hipFuncSetAttribute((const void*)skel_fwd, hipFuncAttributeMaxDynamicSharedMemorySize, LDS_BYTES) != hipSuccess) { fprintf(stderr, "kernel_launch: hipFuncSetAttribute failed\n"); grid = -1; return; }
        int per_cu = 0;
        if (hipOccupancyMaxActiveBlocksPerMultiprocessor(&per_cu, (const void*)skel_fwd, NWAVES * 64, LDS_BYTES) != hipSuccess || per_cu < 1) fprintf(stderr, "kernel_launch: occupancy query reports %d\n", per_cu);
        (void)hipGetLastError();
        grid = cus;
        if (grid != 256) { fprintf(stderr, "kernel_launch: built for 256 CUs, found %d\n", grid); grid = 256; }
    }
    if (grid < 0) return;
    (void)hipMemsetAsync((char*)d_ws + WS_CTL, 0, CTL_ZERO_BYTES, stream);
    Args a{};
    for (int i = 0; i < 29; ++i) a.in[i] = (const float*)d_in[i];
    a.out = (float*)d_out; a.ws = (unsigned char*)d_ws; a.sub = 7;
    if (MK_N_LAUNCHES == 1) {
        a.ph_lo = 0; a.ph_hi = N_PHASES;
        hipLaunchKernelGGL(skel_fwd, dim3(grid), dim3(NWAVES * 64), LDS_BYTES, stream, a);
    } else {
        static const int phases[] = {0, 1, 2, 3, 4, 5, 6, 7, 8, 9, 10, 11, 18, 19, 20, 21, 22, 23, 24, 25, 26, 27, 28};
        for (int p : phases) { a.ph_lo = p % 100; a.ph_hi = p % 100 + 1; a.sub = p >= 100 ? p / 100 : 7; hipLaunchKernelGGL(skel_fwd, dim3(grid), dim3(NWAVES * 64), LDS_BYTES, stream, a); }
    }
}
```

```cpp
#include <hip/hip_runtime.h>
#include <cstdio>
#include <cstdint>

#ifndef MK_N_LAUNCHES
#define MK_N_LAUNCHES 1
#endif

#define GAS __attribute__((address_space(1)))
#define LAS __attribute__((address_space(3)))
typedef unsigned short bf16;
typedef float f32x4 __attribute__((ext_vector_type(4)));
typedef float f32x2 __attribute__((ext_vector_type(2)));
typedef unsigned u32x4 __attribute__((ext_vector_type(4)));
typedef unsigned u32x2 __attribute__((ext_vector_type(2)));
typedef short bf16x8 __attribute__((ext_vector_type(8)));
typedef __bf16 bfx2 __attribute__((ext_vector_type(2)));
typedef short s16x4 __attribute__((ext_vector_type(4)));
typedef int i32x8 __attribute__((ext_vector_type(8)));
typedef int i32x4 __attribute__((ext_vector_type(4)));

constexpr int BATCH = 8, T = 4096, D = 1024, M = BATCH * T;
constexpr int GRID_W = 64, GW = 256;
constexpr int INW = 2688, ZW = 2816;
constexpr int FF = 3584, NE = 8;
constexpr int ZQ = 0, ZK = 256, ZV = 512, ZR = 768, ZLG = 1600, ZP = 1664, ZCB = 1920, ZCC = 2176, ZCH = 2432;
constexpr int RWS = 832;
constexpr float RMS_EPS = 1e-6f, LNX_EPS = 64e-5f;
constexpr int MOE_ROWS = 2 * M + NE * 256, MOE_BLKS = MOE_ROWS / 256;
constexpr int NPART = 1, PART_BLKS = MOE_BLKS;
constexpr float SC_H8 = 8.f, SC_W13 = 32.f, SC_W2 = 64.f, SC_HID = 4.f;

namespace pg8 {
typedef unsigned short bf16_t;
constexpr int BM = 256, BK = 64, HALF = 128, HTB = HALF * BK * 2, STAGE_BYTES = 8 * HTB, NXCD = 8, WGM = 8;
__host__ __device__ __forceinline__ int lds_byte(int r, int c) { const int st = (r >> 4) * 2 + (c >> 5), rr = r & 15, cc = c & 31, ob = rr * 64 + cc * 2; return st * 1024 + (ob ^ (((ob >> 9) & 1) << 5)); }
__host__ __device__ __forceinline__ void stage_rc(int b, int& R, int& C) { const int st = b / 1024, sb = b % 1024, swz = sb ^ (((sb >> 9) & 1) << 5); R = (st >> 1) * 16 + swz / 64; C = (st & 1) * 32 + (swz % 64) / 2; }
__host__ __device__ __forceinline__ int perm32(int rho) { const int n = rho >> 4, i = rho & 15; return 8 * (i >> 2) + 4 * n + (i & 3); }

struct Unit { int pm, pn; };
struct Gemm { const bf16_t* A; const bf16_t* Bt; int M, N, K; const int* rowtok; int ld; };

struct StaticOrder {
    int nM, nN, nwg, G, c;
    __device__ void init(int M_, int N_, int G_, int c_) { nM = M_ / BM; nN = N_ / BM; nwg = nM * nN; G = G_; c = c_; }
    __device__ bool next(int i, Unit& u) const {
        const long L = (long)i * G + c; if (L >= nwg) return false;
        int wgid = (int)L; { const int q = nwg / NXCD, r = nwg % NXCD, xcd = wgid % NXCD, off = wgid / NXCD; wgid = (xcd < r ? xcd * (q + 1) : r * (q + 1) + (xcd - r) * q) + off; }
        const int nig = WGM * nN, gid = wgid / nig, fm = gid * WGM, gsz = (nM - fm) < WGM ? (nM - fm) : WGM;
        u.pm = fm + ((wgid % nig) % gsz); u.pn = (wgid % nig) / gsz; return true;
    }
    __device__ __forceinline__ size_t b_off(const Unit& u, size_t tstep) const { return (size_t)u.pn * tstep; }
    __device__ __forceinline__ int a_blk(const Unit& u) const { return u.pm; }
};
struct ExpertEnds { int e0, e1, e2, e3, e4, e5, e6;
    __device__ __forceinline__ void load(const int* info) { e0 = __builtin_amdgcn_readfirstlane(info[1]); e1 = __builtin_amdgcn_readfirstlane(info[2]); e2 = __builtin_amdgcn_readfirstlane(info[3]); e3 = __builtin_amdgcn_readfirstlane(info[4]);
        e4 = __builtin_amdgcn_readfirstlane(info[5]); e5 = __builtin_amdgcn_readfirstlane(info[6]); e6 = __builtin_amdgcn_readfirstlane(info[7]); }
    __device__ __forceinline__ int expert(int blk) const { return (blk >= e0) + (blk >= e1) + (blk >= e2) + (blk >= e3) + (blk >= e4) + (blk >= e5) + (blk >= e6); } };
struct MoeOrder : StaticOrder {
    ExpertEnds ee; int pm0, apm0; size_t estride;
    __device__ __forceinline__ size_t b_off(const Unit& u, size_t tstep) const { return (size_t)ee.expert(pm0 + u.pm) * estride + (size_t)u.pn * tstep; }
    __device__ __forceinline__ int a_blk(const Unit& u) const { return apm0 + u.pm; }
};

struct TailOrder {
    ExpertEnds ee; int pm0, unit; bool has; size_t estride;
    __device__ bool next(int i, Unit& u) const { if (i > 0 || !has) return false; u.pm = unit >> 2; u.pn = unit & 3; return true; }
    __device__ __forceinline__ size_t b_off(const Unit& u, size_t tstep) const { return (size_t)ee.expert(pm0 + u.pm) * estride + (size_t)u.pn * tstep; }
    __device__ __forceinline__ int a_blk(const Unit& u) const { return u.pm; }
};
__device__ __forceinline__ unsigned cvt_pk_bf16(float lo, float hi) { unsigned r; asm volatile("v_cvt_pk_bf16_f32 %0, %1, %2" : "=v"(r) : "v"(lo), "v"(hi)); return r; }

struct EpiBf16 {
    static constexpr bool PERM = true;
    bf16_t* O; int ldc; float scale;
    __device__ __forceinline__ void operator()(const f32x4 (&acc)[2][2][4][2], const Unit& u, int wr, int wc, int fr, int fq) const {
        const int row0 = u.pm * BM + wr * 64 + fr; const int col0 = u.pn * BM + wc * 32 + 8 * fq;
#pragma unroll
        for (int ai = 0; ai < 2; ++ai)
#pragma unroll
            for (int m = 0; m < 4; ++m) { bf16_t* rowp = O + (size_t)(row0 + ai * HALF + m * 16) * ldc + col0;
#pragma unroll
                for (int bj = 0; bj < 2; ++bj) { const f32x4 v0 = acc[ai][bj][m][0] * scale, v1 = acc[ai][bj][m][1] * scale;
                    u32x4 w; w.x = cvt_pk_bf16(v0[0], v0[1]); w.y = cvt_pk_bf16(v0[2], v0[3]); w.z = cvt_pk_bf16(v1[0], v1[1]); w.w = cvt_pk_bf16(v1[2], v1[3]);
                    *(u32x4*)(rowp + bj * HALF) = w; } }
    }
};
struct EpiSwiGLU {
    static constexpr bool PERM = true;
    bf16_t* O; int ldc;
    __device__ __forceinline__ void operator()(const f32x4 (&acc)[2][2][4][2], const Unit& u, int wr, int wc, int fr, int fq) const {
        const int row0 = u.pm * BM + wr * 64 + fr; const int col0 = u.pn * HALF + wc * 32 + 8 * fq;
#pragma unroll
        for (int ai = 0; ai < 2; ++ai)
#pragma unroll
            for (int m = 0; m < 4; ++m) { bf16_t* rowp = O + (size_t)(row0 + ai * HALF + m * 16) * ldc + col0;
                float h[8];
#pragma unroll
                for (int n = 0; n < 2; ++n)
#pragma unroll
                    for (int x = 0; x < 4; ++x) { const float a = acc[ai][0][m][n][x], b = acc[ai][1][m][n][x]; h[4 * n + x] = a * b * __builtin_amdgcn_rcpf(1.0f + __expf(-a)); }
                u32x4 w; w.x = cvt_pk_bf16(h[0], h[1]); w.y = cvt_pk_bf16(h[2], h[3]); w.z = cvt_pk_bf16(h[4], h[5]); w.w = cvt_pk_bf16(h[6], h[7]);
                *(u32x4*)rowp = w; }
    }
};

__device__ __forceinline__ unsigned cvt4_fp8(float a, float b, float c, float d) {
    a = fminf(fmaxf(a, -448.f), 448.f); b = fminf(fmaxf(b, -448.f), 448.f); c = fminf(fmaxf(c, -448.f), 448.f); d = fminf(fmaxf(d, -448.f), 448.f);
    int r = 0; r = __builtin_amdgcn_cvt_pk_fp8_f32(a, b, r, false); r = __builtin_amdgcn_cvt_pk_fp8_f32(c, d, r, true); return (unsigned)r; }
struct EpiSwiGLU8 {
    static constexpr bool PERM = true;
    unsigned char* O; int ldc; float in_scale, out_scale;
    __device__ __forceinline__ void operator()(const f32x4 (&acc)[2][2][4][2], const Unit& u, int wr, int wc, int fr, int fq) const {
        const int row0 = u.pm * BM + wr * 64 + fr; const int col0 = u.pn * HALF + wc * 32 + 8 * fq;
#pragma unroll
        for (int ai = 0; ai < 2; ++ai)
#pragma unroll
            for (int m = 0; m < 4; ++m) { unsigned char* rowp = O + (size_t)(row0 + ai * HALF + m * 16) * ldc + col0;
                float h[8];
#pragma unroll
                for (int n = 0; n < 2; ++n)
#pragma unroll
                    for (int x = 0; x < 4; ++x) { const float a = acc[ai][0][m][n][x] * in_scale, b = acc[ai][1][m][n][x] * in_scale; h[4 * n + x] = out_scale * a * b * __builtin_amdgcn_rcpf(1.0f + __expf(-a)); }
                u32x2 w; w.x = cvt4_fp8(h[0], h[1], h[2], h[3]); w.y = cvt4_fp8(h[4], h[5], h[6], h[7]);
                *(u32x2*)rowp = w; }
    }
};

template <class Epi, class Sched, bool GATHER, bool FP8 = false>
__device__ __forceinline__ void gemm_phase(LAS unsigned char* lds, const Gemm g, const Sched& S, const Epi& E) {
    int tid_ = threadIdx.x; asm volatile("" : "+v"(tid_));
    const int tid = tid_, wid = __builtin_amdgcn_readfirstlane(tid >> 6), lane = tid & 63, wr = wid >> 2, wc = wid & 3, fr = lane & 15, fq = lane >> 4;
    const int K = g.ld ? g.ld : g.K, nt = g.K / BK;
    const size_t kstep = (size_t)(BK * 2);
    const size_t hstep = (size_t)HALF * K * 2;
    const size_t tstep = 2 * hstep;
    unsigned voffB[2], voffA0[2];
#pragma unroll
    for (int i = 0; i < 2; ++i) { int R, C; stage_rc(tid * 16 + i * 8192, R, C); const int Rb = Epi::PERM ? ((R & ~31) + perm32(R & 31)) : R;
        voffA0[i] = (unsigned)(R * K + C) * 2u; voffB[i] = (unsigned)(Rb * K + C) * 2u; }
    const unsigned ldsw = (unsigned)wid * 1024u;
    const int aoff = lds_byte(wr * 64 + fr, fq * 8), boff = lds_byte(wc * 32 + fr, fq * 8);
#define PG8_SA(b, h) (((b) * 2 + (h)) * HTB)
#define PG8_SB(b, h) ((4 + (b) * 2 + (h)) * HTB)
#define PG8_STAGE(bufoff, gbase, voff) do { _Pragma("unroll") for (int _i = 0; _i < 2; ++_i) \
        __builtin_amdgcn_global_load_lds((const unsigned*)((const char*)(gbase) + (voff)[_i]), (LAS unsigned*)(lds + (bufoff) + ldsw + _i * 8192), 16, 0, 0); } while (0)
#define PG8_LDA(dst, b, h) do { _Pragma("unroll") for (int m = 0; m < 4; ++m) dst[m] = __builtin_shufflevector(*(const LAS i32x4*)(lds + PG8_SA(b, h) + aoff + m * 2048), *(const LAS i32x4*)(lds + PG8_SA(b, h) + aoff + m * 2048 + 1024), 0, 1, 2, 3, 4, 5, 6, 7); } while (0)
#define PG8_LDB(dst, b, h) do { _Pragma("unroll") for (int n = 0; n < 2; ++n) dst[n] = __builtin_shufflevector(*(const LAS i32x4*)(lds + PG8_SB(b, h) + boff + n * 2048), *(const LAS i32x4*)(lds + PG8_SB(b, h) + boff + n * 2048 + 1024), 0, 1, 2, 3, 4, 5, 6, 7); } while (0)
#define PG8_MMA(ai, bj, At, Bt) do { __builtin_amdgcn_s_setprio(1); _Pragma("unroll") for (int m = 0; m < 4; ++m) _Pragma("unroll") for (int n = 0; n < 2; ++n) { \
        if constexpr (FP8) { asm volatile("v_mfma_scale_f32_16x16x128_f8f6f4 %0, %1, %2, %0, %3, %3 op_sel_hi:[0,0,0]" : "+v"(acc[ai][bj][m][n]) : "v"(Bt[n]), "v"(At[m]), "v"(sc1)); } \
        else { acc[ai][bj][m][n] = __builtin_amdgcn_mfma_f32_16x16x32_bf16(__builtin_bit_cast(bf16x8, __builtin_shufflevector(Bt[n], Bt[n], 0, 1, 2, 3)), __builtin_bit_cast(bf16x8, __builtin_shufflevector(At[m], At[m], 0, 1, 2, 3)), acc[ai][bj][m][n], 0, 0, 0); \
               acc[ai][bj][m][n] = __builtin_amdgcn_mfma_f32_16x16x32_bf16(__builtin_bit_cast(bf16x8, __builtin_shufflevector(Bt[n], Bt[n], 4, 5, 6, 7)), __builtin_bit_cast(bf16x8, __builtin_shufflevector(At[m], At[m], 4, 5, 6, 7)), acc[ai][bj][m][n], 0, 0, 0); } } \
        __builtin_amdgcn_s_setprio(0); } while (0)
#define PG8_WAIT_V(n) asm volatile("s_waitcnt vmcnt(" #n ")" ::: "memory")
#define PG8_WAIT_L(n) asm volatile("s_waitcnt lgkmcnt(" #n ")" ::: "memory")
#define PG8_BAR __builtin_amdgcn_s_barrier()
#define PG8_SCHED __builtin_amdgcn_sched_barrier(0)
#define PG8_AOFFS(dst, u) do { if constexpr (GATHER) { const int _rb = S.a_blk(u) * BM; int _t2 = tid; asm volatile("" : "+v"(_t2)); \
            _Pragma("unroll") for (int _h = 0; _h < 2; ++_h) _Pragma("unroll") for (int _i = 0; _i < 2; ++_i) { int _R, _C; stage_rc(_t2 * 16 + _i * 8192, _R, _C); \
            dst[_h][_i] = (unsigned)(g.rowtok[_rb + _h * HALF + _R] * K + _C) * 2u; } } } while (0)
#define PG8_STAGEA(bufoff, gbase, h, NX) do { _Pragma("unroll") for (int _i = 0; _i < 2; ++_i) { \
        const unsigned _o = GATHER ? (((NX) && last) ? vAn[h][_i] : vA[h][_i]) : (voffA0[_i] + (unsigned)((h) * hstep)); \
        __builtin_amdgcn_global_load_lds((const unsigned*)((const char*)(gbase) + _o), (LAS unsigned*)(lds + (bufoff) + ldsw + _i * 8192), 16, 0, 0); } } while (0)
#define PG8_ABASE(u) ((const char*)g.A + (GATHER ? (size_t)0 : (size_t)S.a_blk(u) * tstep))
    LAS unsigned* rtl = (LAS unsigned*)(lds + STAGE_BYTES) + wid * 256;
#define PG8_AOFFS_ASYNC(u) do { if constexpr (GATHER) { const int _rb = S.a_blk(u) * BM; int _t2 = tid; asm volatile("" : "+v"(_t2)); \
            _Pragma("unroll") for (int _h = 0; _h < 2; ++_h) _Pragma("unroll") for (int _i = 0; _i < 2; ++_i) { int _R, _C; stage_rc(_t2 * 16 + _i * 8192, _R, _C); \
            __builtin_amdgcn_global_load_lds((const unsigned*)(g.rowtok + _rb + _h * HALF + _R), (LAS unsigned*)(rtl + (_h * 2 + _i) * 64), 4, 0, 0); } } } while (0)
#define PG8_AOFFS_FINISH(dst) do { if constexpr (GATHER) { int _t2 = tid; asm volatile("" : "+v"(_t2)); \
            _Pragma("unroll") for (int _h = 0; _h < 2; ++_h) _Pragma("unroll") for (int _i = 0; _i < 2; ++_i) { int _R, _C; stage_rc(_t2 * 16 + _i * 8192, _R, _C); \
            dst[_h][_i] = (unsigned)((int)rtl[(_h * 2 + _i) * 64 + lane] * K + _C) * 2u; } } } while (0)
    Unit cur, nxt; int ui = 0;
    if (!S.next(0, cur)) return;
    f32x4 acc[2][2][4][2];
#pragma unroll
    for (int a = 0; a < 2; ++a)
#pragma unroll
        for (int b = 0; b < 2; ++b)
#pragma unroll
            for (int m = 0; m < 4; ++m)
#pragma unroll
                for (int n = 0; n < 2; ++n) acc[a][b][m][n] = (f32x4){0.f, 0.f, 0.f, 0.f};
    i32x8 At[4], B0[2], B1[2]; const int sc1 = 0x7f7f7f7f; (void)sc1;
    unsigned vA[2][2], vAn[2][2]; const bool last = false;
    PG8_AOFFS(vA, cur);
    const char* cA = PG8_ABASE(cur); const char* cB = (const char*)g.Bt + S.b_off(cur, tstep);
    PG8_STAGE(PG8_SB(0, 0), cB, voffB); PG8_STAGE(PG8_SB(0, 1), cB + hstep, voffB); PG8_STAGEA(PG8_SA(0, 0), cA, 0, false); PG8_STAGEA(PG8_SA(0, 1), cA, 1, false);
    if (wr == 1) PG8_BAR;
    PG8_WAIT_V(2); PG8_BAR;
    PG8_STAGE(PG8_SB(1, 0), cB + kstep, voffB); PG8_STAGEA(PG8_SA(1, 0), cA + kstep, 0, false); PG8_STAGE(PG8_SB(1, 1), cB + hstep + kstep, voffB);
    PG8_WAIT_V(6); PG8_BAR;
    for (;;) {
        const bool has_next = S.next(ui + 1, nxt);
        const char* nA = cA; const char* nB = cB;
        if (has_next) { nA = PG8_ABASE(nxt); nB = (const char*)g.Bt + S.b_off(nxt, tstep); PG8_AOFFS_ASYNC(nxt); }
        for (int t = 0; t < nt; t += 2) {
            const bool last = (t == nt - 2);
            if constexpr (GATHER) { if (last) { if (has_next) PG8_AOFFS_FINISH(vAn); else {
#pragma unroll
                for (int h = 0; h < 2; ++h)
#pragma unroll
                    for (int i = 0; i < 2; ++i) vAn[h][i] = vA[h][i]; } } }
            const char* a1 = cA + (size_t)(t + 1) * kstep;
            const char* a2 = last ? nA : cA + (size_t)(t + 2) * kstep; const char* b2 = last ? nB : cB + (size_t)(t + 2) * kstep;
            const char* a3 = a2 + kstep; const char* b3 = b2 + kstep;
            PG8_LDB(B0, 0, 0); PG8_LDB(B1, 0, 1); PG8_SCHED; PG8_LDA(At, 0, 0); PG8_STAGEA(PG8_SA(1, 1), a1, 1, false);
            PG8_WAIT_V(8); PG8_WAIT_L(0); PG8_BAR; PG8_MMA(0, 0, At, B0); PG8_MMA(0, 1, At, B1); PG8_BAR; PG8_SCHED;
            PG8_LDA(At, 0, 1); PG8_STAGE(PG8_SB(0, 0), b2, voffB); PG8_STAGE(PG8_SB(0, 1), b2 + hstep, voffB); PG8_STAGEA(PG8_SA(0, 0), a2, 0, true);
            PG8_WAIT_V(8); PG8_WAIT_L(0); PG8_BAR; PG8_MMA(1, 0, At, B0); PG8_MMA(1, 1, At, B1); PG8_BAR; PG8_SCHED;
            PG8_LDB(B0, 1, 0); PG8_LDB(B1, 1, 1); PG8_SCHED; PG8_LDA(At, 1, 0); PG8_STAGEA(PG8_SA(0, 1), a2, 1, true);
            PG8_WAIT_V(8); PG8_WAIT_L(0); PG8_BAR; PG8_MMA(0, 0, At, B0); PG8_MMA(0, 1, At, B1); PG8_BAR; PG8_SCHED;
            PG8_LDA(At, 1, 1); PG8_STAGE(PG8_SB(1, 0), b3, voffB); PG8_STAGE(PG8_SB(1, 1), b3 + hstep, voffB); PG8_STAGEA(PG8_SA(1, 0), a3, 0, true);
            PG8_WAIT_V(8); PG8_WAIT_L(0); PG8_BAR; PG8_MMA(1, 0, At, B0); PG8_MMA(1, 1, At, B1); PG8_BAR; PG8_SCHED;
        }
        if (wr == 0) PG8_BAR;
        E(acc, cur, wr, wc, fr, fq);
        if (!has_next) break;
#pragma unroll
        for (int a = 0; a < 2; ++a)
#pragma unroll
            for (int b = 0; b < 2; ++b)
#pragma unroll
                for (int m = 0; m < 4; ++m)
#pragma unroll
                    for (int n = 0; n < 2; ++n) acc[a][b][m][n] = (f32x4){0.f, 0.f, 0.f, 0.f};
        cur = nxt; cA = nA; cB = nB; ++ui;
        if constexpr (GATHER) {
#pragma unroll
        for (int h = 0; h < 2; ++h)
#pragma unroll
            for (int i = 0; i < 2; ++i) vA[h][i] = vAn[h][i]; }
        if (wr == 1) PG8_BAR;
    }
    PG8_WAIT_V(0);
    PG8_BAR;
#undef PG8_SA
#undef PG8_SB
#undef PG8_STAGE
#undef PG8_LDA
#undef PG8_LDB
#undef PG8_MMA
#undef PG8_WAIT_V
#undef PG8_WAIT_L
#undef PG8_BAR
#undef PG8_SCHED
#undef PG8_AOFFS
#undef PG8_AOFFS_ASYNC
#undef PG8_AOFFS_FINISH
#undef PG8_STAGEA
#undef PG8_ABASE
}
}

constexpr size_t MiB = 1u << 20;
constexpr size_t WS_CTL = 0, CTL_ZERO_BYTES = 64 * 1024;
constexpr size_t WS_MOD = 1 * MiB;
constexpr size_t WS_TOPI = 2 * MiB;
constexpr size_t WS_GATE = 2 * MiB + 512 * 1024;
constexpr size_t WS_DEST = 3 * MiB;
constexpr size_t WS_ROWTOK = 3 * MiB + 512 * 1024;
constexpr size_t WS_WGCNT = 4 * MiB;
constexpr size_t WS_MOEINFO = 4 * MiB + 64 * 1024;
constexpr size_t WS_SLAB = 8 * MiB;
constexpr size_t WS_WIN = 8 * MiB;
constexpr size_t WS_WOUT = 20 * MiB;
constexpr size_t WS_W13 = 24 * MiB;
constexpr size_t WS_W2 = 38 * MiB;
constexpr size_t WS_H = 48 * MiB;
constexpr size_t ARENA = 112 * MiB;
constexpr size_t WS_Z = ARENA;
constexpr size_t WS_YCAT = ARENA + 176 * MiB;
constexpr size_t WS_SCAN = ARENA + 240 * MiB;
constexpr size_t WS_CH = ARENA + 240 * MiB;
constexpr size_t WS_BONUS = ARENA + 432 * MiB;
constexpr size_t WS_SLG = ARENA + 448 * MiB;
constexpr size_t WS_Y = ARENA;
constexpr size_t WS_HID = ARENA + 64 * MiB;
constexpr size_t WS_WM13 = ARENA + 368 * MiB;
constexpr size_t WS_WM2 = ARENA + 424 * MiB;
constexpr size_t WS_YB = ARENA;
constexpr size_t WS_HIDM = ARENA + 132 * MiB;
constexpr size_t WS_END = ARENA + 454 * MiB;
static_assert(WS_SCAN + (size_t)2 * 8 * 4 * T * 384 * 2 <= WS_END && WS_HID + (size_t)M * FF * 2 <= WS_END && WS_HIDM + (size_t)PART_BLKS * 256 * FF <= WS_END, "ws map");
static_assert(WS_YB + (size_t)MOE_ROWS * D * 2 <= WS_HIDM && WS_HIDM + (size_t)PART_BLKS * 256 * FF <= WS_WM13 && WS_WM13 + (size_t)NE * 2 * FF * D <= WS_WM2 && WS_WM2 + (size_t)NE * D * FF <= WS_END && WS_CH + (size_t)4096 * 16384 * 2 <= WS_WM13, "ws map 2");

constexpr int LDS_BYTES = 163840;
constexpr int SCR_BYTES = 163840 - 512;
constexpr int MISC_OFF = SCR_BYTES;
constexpr int NWAVES = 8;

#define LDS_WAIT() asm volatile("s_waitcnt lgkmcnt(0)" ::: "memory")
#define VM_WAIT() asm volatile("s_waitcnt vmcnt(0)" ::: "memory")
__device__ __forceinline__ unsigned f2bf(float f) { return (unsigned)__builtin_bit_cast(unsigned short, (__bf16)f); }
__device__ __forceinline__ unsigned pk2(float lo, float hi) { bfx2 v; v[0] = (__bf16)lo; v[1] = (__bf16)hi; return __builtin_bit_cast(unsigned, v); }
__device__ __forceinline__ float bf2f(unsigned b) { return __builtin_bit_cast(float, b << 16); }
__device__ __forceinline__ float bflo(unsigned u) { return __builtin_bit_cast(float, u << 16); }
__device__ __forceinline__ float bfhi(unsigned u) { return __builtin_bit_cast(float, u & 0xffff0000u); }
__device__ __forceinline__ float row16_sum(float v);
__device__ __forceinline__ float wave_sum(float v) {
    const int r = __builtin_bit_cast(int, row16_sum(v));
    const float s0 = __builtin_bit_cast(float, __builtin_amdgcn_readlane(r, 0)), s1 = __builtin_bit_cast(float, __builtin_amdgcn_readlane(r, 16)),
                s2 = __builtin_bit_cast(float, __builtin_amdgcn_readlane(r, 32)), s3 = __builtin_bit_cast(float, __builtin_amdgcn_readlane(r, 48));
    return (s0 + s1) + (s2 + s3);
}
__device__ __forceinline__ float row16_sum(float v) {
    v += __builtin_bit_cast(float, __builtin_amdgcn_update_dpp(0, __builtin_bit_cast(int, v), 0x128, 0xf, 0xf, false));
    v += __builtin_bit_cast(float, __builtin_amdgcn_update_dpp(0, __builtin_bit_cast(int, v), 0x124, 0xf, 0xf, false));
    v += __builtin_bit_cast(float, __builtin_amdgcn_update_dpp(0, __builtin_bit_cast(int, v), 0x122, 0xf, 0xf, false));
    v += __builtin_bit_cast(float, __builtin_amdgcn_update_dpp(0, __builtin_bit_cast(int, v), 0x121, 0xf, 0xf, false));
    return v;
}
__device__ __forceinline__ float sigmoidf_(float x) { return __builtin_amdgcn_rcpf(1.0f + __expf(-x)); }

#define XB_TMO      128
#define XB_XCNT(j)  (256  + 64 * (j))
#define XB_XSUB(j)  (1280 + 64 * (j))
#define XB_XGEN(j)  (2304 + 64 * (j))
#define XB_TOP      3328
#define XB_TOPGEN   3392
#define XCD_BAR_WORDS 3456
#define XB_SPIN_CAP (1u << 22)
__device__ __forceinline__ unsigned xb_ld(unsigned* p)              { return __hip_atomic_load(p, __ATOMIC_RELAXED, __HIP_MEMORY_SCOPE_AGENT); }
__device__ __forceinline__ unsigned xb_add(unsigned* p, unsigned v) { return __hip_atomic_fetch_add(p, v, __ATOMIC_RELAXED, __HIP_MEMORY_SCOPE_AGENT); }
__device__ __forceinline__ unsigned xb_xcc_id() { return (unsigned)__builtin_amdgcn_s_getreg((3 << 11) | 20) & 0xFu; }
#define XB_SPIN(cond, bar) do { unsigned _sp = 0; while (cond) { __builtin_amdgcn_s_sleep(1); \
    if ((++_sp & 255u) == 0u) { if (xb_ld(&(bar)[XB_TMO])) break; if (_sp > XB_SPIN_CAP) { atomicAdd(&(bar)[XB_TMO], 1u); break; } } } } while (0)
struct XcdBarrier { unsigned* bar; unsigned x; volatile LAS unsigned* st; };
__device__ __forceinline__ XcdBarrier xcd_barrier_post(unsigned* bar, volatile LAS unsigned* st) {
    XcdBarrier b; b.bar = bar; b.x = xb_xcc_id(); b.st = st;
    if (threadIdx.x == 0) (void)xb_add(&bar[XB_XCNT(b.x)], 1u);
    return b;
}
__device__ __forceinline__ void xcd_barrier_complete(unsigned* bar, unsigned x, unsigned& nloc, unsigned& nx) {
    const unsigned G = gridDim.x * gridDim.y * gridDim.z;
    unsigned sum, cnt, mine, sp = 0u;
    for (;;) {
        sum = 0u; cnt = 0u; mine = 0u;
#pragma unroll
        for (unsigned j = 0; j < 16; ++j) { const unsigned c = xb_ld(&bar[XB_XCNT(j)]); sum += c; cnt += (c > 0u) ? 1u : 0u; mine = (j == x) ? c : mine; }
        if (sum == G) break;
        __builtin_amdgcn_s_sleep(1);
        if ((++sp & 255u) == 0u) { if (xb_ld(&bar[XB_TMO])) break; if (sp > XB_SPIN_CAP) { atomicAdd(&bar[XB_TMO], 1u); break; } }
    }
    nloc = mine > 0u ? mine : 1u; nx = cnt > 0u ? cnt : 1u;
}
__device__ __forceinline__ void xcd_barrier(const XcdBarrier& b) {
    asm volatile("s_waitcnt vmcnt(0)" ::: "memory");
    __syncthreads();
    if (threadIdx.x == 0) {
        unsigned* bar = b.bar;
        __builtin_amdgcn_s_waitcnt(0);
        unsigned nloc = b.st[0], nx = b.st[1];
        if (nloc == 0u) { xcd_barrier_complete(bar, b.x, nloc, nx); b.st[0] = nloc; b.st[1] = nx; }
        const unsigned old = xb_add(&bar[XB_XSUB(b.x)], 1u);
        const unsigned gen = old / nloc;
        if (old + 1u == (gen + 1u) * nloc) {
            __builtin_amdgcn_fence(__ATOMIC_RELEASE, "agent");
            asm volatile("s_waitcnt vmcnt(0)" ::: "memory");
            const unsigned og = xb_add(&bar[XB_TOP], 1u);
            const unsigned tg = og / nx;
            if (og + 1u == (tg + 1u) * nx) xb_add(&bar[XB_TOPGEN], 1u);
            else XB_SPIN(xb_ld(&bar[XB_TOPGEN]) == tg, bar);
            __builtin_amdgcn_fence(__ATOMIC_ACQUIRE, "agent");
            xb_add(&bar[XB_XGEN(b.x)], 1u);
            asm volatile("s_waitcnt vmcnt(0)" ::: "memory");
        } else {
            XB_SPIN(xb_ld(&bar[XB_XGEN(b.x)]) == gen, bar);
            __builtin_amdgcn_fence(__ATOMIC_ACQUIRE, "agent");
            asm volatile("s_waitcnt vmcnt(0)" ::: "memory");
        }
    }
    __syncthreads();
}

struct Args { const float* in[29]; float* out; unsigned char* ws; int ph_lo, ph_hi, sub, pad; };
enum { IN_X = 0, IN_C, IN_ADAW, IN_ADAB, IN_NORMG, IN_WIN, IN_WOUT, IN_RPB, IN_MU, IN_W0, IN_W2L, IN_A0, IN_A2L, IN_KK, IN_KA, IN_RK, IN_LNW, IN_LNB, IN_G2,
       IN_POOLW, IN_POOLS, IN_CONVW, IN_FW1, IN_FW3, IN_FW2, IN_ROUTER, IN_MW1, IN_MW3, IN_MW2 };

__device__ __forceinline__ void transpose_item(const float* W, int K, int N, bf16* WT, int drow0, int k0, int n0, LAS float* scr, int lane) {
#pragma unroll 8
    for (int i = 0; i < 32; ++i) { const int kk = 2 * i + (lane >> 5); scr[kk * 33 + (lane & 31)] = __builtin_nontemporal_load(W + (size_t)(k0 + kk) * N + n0 + (lane & 31)); }
    LDS_WAIT(); asm volatile("" ::: "memory");
    const int c = lane & 7;
#pragma unroll
    for (int j = 0; j < 4; ++j) { const int n = (lane >> 3) + 8 * j; const LAS float* s = scr + (8 * c) * 33 + n;
        u32x4 o; o.x = pk2(s[0 * 33], s[1 * 33]); o.y = pk2(s[2 * 33], s[3 * 33]); o.z = pk2(s[4 * 33], s[5 * 33]); o.w = pk2(s[6 * 33], s[7 * 33]);
        *(u32x4*)(WT + (size_t)(drow0 + n) * K + k0 + 8 * c) = o; }
    LDS_WAIT(); asm volatile("" ::: "memory");
}
__device__ __forceinline__ void transpose_item8(const float* W, int K, int N, unsigned char* WT, int drow0, int k0, int n0, LAS float* scr, int lane, float sc) {
#pragma unroll 8
    for (int i = 0; i < 32; ++i) { const int kk = 2 * i + (lane >> 5); scr[kk * 33 + (lane & 31)] = __builtin_nontemporal_load(W + (size_t)(k0 + kk) * N + n0 + (lane & 31)); }
    LDS_WAIT(); asm volatile("" ::: "memory");
    const int c = lane & 7;
#pragma unroll
    for (int j = 0; j < 4; ++j) { const int n = (lane >> 3) + 8 * j; const LAS float* s = scr + (8 * c) * 33 + n;
        u32x2 o; o.x = pg8::cvt4_fp8(s[0 * 33] * sc, s[1 * 33] * sc, s[2 * 33] * sc, s[3 * 33] * sc); o.y = pg8::cvt4_fp8(s[4 * 33] * sc, s[5 * 33] * sc, s[6 * 33] * sc, s[7 * 33] * sc);
        *(u32x2*)(WT + (size_t)(drow0 + n) * K + k0 + 8 * c) = o; }
    LDS_WAIT(); asm volatile("" ::: "memory");
}
template <int MODE> __device__ __forceinline__ void transpose_mat8(const float* W, int K, int N, unsigned char* WT, int gw, int NGW, LAS float* scr, int lane, float sc) {
    const int nblk = N / 32, nitems = (K / 64) * nblk;
    for (int it = gw; it < nitems; it += NGW) { const int kb = it / nblk, nb = it % nblk, n0 = 32 * nb;
        const int drow0 = MODE == 0 ? n0 : (256 * (n0 >> 7) + (n0 & 127) + (MODE == 2 ? 128 : 0));
        transpose_item8(W, K, N, WT, drow0, 64 * kb, n0, scr, lane, sc); }
}
template <int MODE> __device__ __forceinline__ void transpose_mat(const float* W, int K, int N, bf16* WT, int gw, int NGW, LAS float* scr, int lane) {
    const int nblk = N / 32, nitems = (K / 64) * nblk;
    for (int it = gw; it < nitems; it += NGW) { const int kb = it / nblk, nb = it % nblk, n0 = 32 * nb;
        const int drow0 = MODE == 0 ? n0 : (256 * (n0 >> 7) + (n0 & 127) + (MODE == 2 ? 128 : 0));
        transpose_item(W, K, N, WT, drow0, 64 * kb, n0, scr, lane); }
}

__device__ __forceinline__ void ld_row_f32(const float* p, int lane, f32x4 (&v)[4]) {
#pragma unroll
    for (int j = 0; j < 4; ++j) v[j] = *(const f32x4*)(p + 4 * lane + 256 * j);
}
__device__ __forceinline__ void ld_row_f32_nt(const float* p, int lane, f32x4 (&v)[4]) {
#pragma unroll
    for (int j = 0; j < 4; ++j) v[j] = __builtin_nontemporal_load((const f32x4*)(p + 4 * lane + 256 * j));
}
__device__ __forceinline__ void st_row_f32_nt(float* p, int lane, const f32x4 (&v)[4]) {
#pragma unroll
    for (int j = 0; j < 4; ++j) __builtin_nontemporal_store(v[j], (f32x4*)(p + 4 * lane + 256 * j));
}
__device__ __forceinline__ void ld_row_bf16(const bf16* p, int lane, f32x4 (&v)[4]) {
#pragma unroll
    for (int j = 0; j < 4; ++j) { const u32x2 u = __builtin_nontemporal_load((const u32x2*)(p + 4 * lane + 256 * j)); v[j] = (f32x4){bflo(u.x), bfhi(u.x), bflo(u.y), bfhi(u.y)}; }
}
__device__ __forceinline__ void ld_moe_row(const bf16* YB, const bf16* SLAB, int d, int lane, f32x4 (&v)[4]) {
    if (d < 256 * 256) { ld_row_bf16(YB + (size_t)d * D, lane, v); }
    else { const bf16* p = SLAB + (size_t)(d - 256 * 256) * D; ld_row_bf16(p, lane, v);
#pragma unroll 1
        for (int sl = 1; sl < 7; ++sl) { f32x4 t[4]; ld_row_bf16(p + (size_t)sl * 8 * 256 * D, lane, t);
#pragma unroll
            for (int j = 0; j < 4; ++j) v[j] = v[j] + t[j]; } }
}
__device__ __forceinline__ void st_row_bf16(bf16* p, int lane, const f32x4 (&v)[4]) {
#pragma unroll
    for (int j = 0; j < 4; ++j) { u32x2 u; u.x = pk2(v[j][0], v[j][1]); u.y = pk2(v[j][2], v[j][3]); *(u32x2*)(p + 4 * lane + 256 * j) = u; }
}
__device__ __forceinline__ void st_row_f32(float* p, int lane, const f32x4 (&v)[4]) {
#pragma unroll
    for (int j = 0; j < 4; ++j) *(f32x4*)(p + 4 * lane + 256 * j) = v[j];
}
__device__ __forceinline__ float row_rstd(const f32x4 (&v)[4]) {
    float s = 0.f;
#pragma unroll
    for (int j = 0; j < 4; ++j) s += (v[j][0] * v[j][0] + v[j][1] * v[j][1]) + (v[j][2] * v[j][2] + v[j][3] * v[j][3]);
    return 1.0f / sqrtf(wave_sum(s) * (1.0f / D) + RMS_EPS);
}
__device__ __forceinline__ void modulate(const f32x4 (&x)[4], float rstd, const float* g, const float* sc, const float* sh, int lane, f32x4 (&h)[4]) {
    f32x4 gv[4], scv[4], shv[4]; ld_row_f32(g, lane, gv); ld_row_f32(sc, lane, scv); ld_row_f32(sh, lane, shv);
#pragma unroll
    for (int j = 0; j < 4; ++j) h[j] = x[j] * rstd * gv[j] * (1.0f + scv[j]) + shv[j];
}

__device__ __forceinline__ const float* inp_ptr(const Args& a, int i) { asm volatile("" : "+s"(i)); return a.in[i]; }
#define INP(i) inp_ptr(args, (i))
#define mod_l (MOD + (size_t)l * 8 * 6 * D)
#define PHASE_PROLOGUE \
    int tid_l = threadIdx.x; asm volatile("" : "+v"(tid_l)); const int tid = tid_l, lane = tid & 63, wave = __builtin_amdgcn_readfirstlane(tid >> 6), gw = vcu * NWAVES + wave; (void)lane; (void)wave; (void)gw; (void)tid; \
    size_t zofs_ = 0; asm volatile("" : "+s"(zofs_)); unsigned char* const ws = ws0 + zofs_; float* const X = (float*)((unsigned char*)args.out + zofs_);   \
    float* const MOD = (float*)(ws + WS_MOD); bf16* const H = (bf16*)(ws + WS_H); float* const YS = (float*)(ws + WS_H); bf16* const Z = (bf16*)(ws + WS_Z); bf16* const YCAT = (bf16*)(ws + WS_YCAT); \
    bf16* const SCAN = (bf16*)(ws + WS_SCAN); bf16* const Y = (bf16*)(ws + WS_Y); bf16* const HID = (bf16*)(ws + WS_HID); int* const TOPI = (int*)(ws + WS_TOPI); float* const GATE = (float*)(ws + WS_GATE); \
    int* const DEST = (int*)(ws + WS_DEST); int* const ROWTOK = (int*)(ws + WS_ROWTOK); int* const WGCNT = (int*)(ws + WS_WGCNT); int* const MOEINFO = (int*)(ws + WS_MOEINFO); \
    bf16* const CH = (bf16*)(ws + WS_CH); bf16* const BONUS = (bf16*)(ws + WS_BONUS); bf16* const SLG = (bf16*)(ws + WS_SLG); (void)CH; (void)BONUS; (void)SLG; \
    (void)X; (void)MOD; (void)H; (void)YS; (void)Z; (void)YCAT; (void)SCAN; (void)Y; (void)HID; (void)TOPI; (void)GATE; (void)DEST; (void)ROWTOK; (void)WGCNT; (void)MOEINFO;
#ifndef PH_MASK
#define PH_MASK 0xffff
#endif
#define PHEN(i) (((PH_MASK) >> (i)) & 1)
#ifndef SUB_MASK
#define SUB_MASK 7
#endif
#define SUBEN(i) (((SUB_MASK) >> (i)) & 1)
#define IN(k) (lo <= (k) && (k) < hi)
#define SEAM(k) do { if (MK_N_LAUNCHES == 1 && IN((k) + 1)) xcd_barrier(bar); } while (0)
__device__ __forceinline__ void load_rowvecs(const float* g_a, const float* gate, const float* g_b, const float* sc, const float* sh, int lane, f32x4 (&a1)[4], f32x4 (&bv)[4], f32x4 (&cv)[4]) {
#pragma unroll
    for (int j = 0; j < 4; ++j) { const int o = 4 * lane + 256 * j; const f32x4 ga = *(const f32x4*)(g_a + o), gt = *(const f32x4*)(gate + o), gb = *(const f32x4*)(g_b + o), s = *(const f32x4*)(sc + o);
        a1[j] = ga * gt; bv[j] = gb * (1.0f + s); cv[j] = *(const f32x4*)(sh + o); }
}
template <int l> __device__ __forceinline__ void layer_phases(const Args& args, unsigned char* const ws0, LAS unsigned char* lds, const int vcu, const int G, const int bx, const int NGW, const int lo, const int hi, const XcdBarrier& bar) {
        const int P = 2 + 16 * l;
        if (PHEN(2) && IN(P + 0)) {
            PHASE_PROLOGUE
            pg8::Gemm g{H, (const bf16*)(ws + WS_WIN) + (size_t)l * ZW * D, M, ZW, D, nullptr, 0}; pg8::StaticOrder S; S.init(M, ZW, G, bx);
            pg8::EpiBf16 E{Z, ZW, 1.0f};
            pg8::gemm_phase<pg8::EpiBf16, pg8::StaticOrder, false>(lds, g, S, E);
            SEAM(P + 0);
        }
        if (PHEN(3) && IN(P + 1)) {
            PHASE_PROLOGUE
            if (SUBEN(0) && (args.sub & 1)) {
                LAS unsigned char* Ks = lds; LAS unsigned char* Vs = lds + 65536;
                LAS float* rp = (LAS float*)(lds + 131072);
                LAS float* xch = (LAS float*)(lds + 131072 + 2048);
                const float* rpb = INP(IN_RPB) + (size_t)l * 4 * 15 * 31;
                const int qt = wave & 3, half = wave >> 2, r16 = lane & 15, kq = lane >> 4;
                const int q = qt * 16 + r16;
                const int c0 = (qt == 0) ? 0 : (qt == 1) ? 8 : (qt == 2) ? 24 : 32;
                const int cs = min(max(q - 8, 0), 48);
                for (int ub = vcu * 8; ub < BATCH * 4 * 64; ub += G * 8) {
                    const int bh = ub >> 6, b = bh >> 2, hh = bh & 3, r0u = ub & 63;
                    for (int i = tid; i < 465; i += NWAVES * 64) rp[i] = rpb[hh * 465 + i];
                    { const int rs0 = min(max(r0u - 4, 0), 56);
                      for (int i = tid; i < 8192; i += NWAVES * 64) { const int kv = i >> 12, krow = rs0 + ((i >> 9) & 7), col = (i >> 3) & 63, ch = i & 7;
                          const bf16* src = Z + (size_t)(b * T + krow * 64 + col) * ZW + (kv ? ZV : ZK) + hh * 64 + ch * 8;
                          *(LAS u32x4*)((kv ? Vs : Ks) + ((((krow & 7) * 64 + col) << 7) + ((ch ^ (col & 7)) << 4))) = *(const u32x4*)src; } }
                    bf16x8 q0, q1;
                    { const bf16* qp = Z + (size_t)(b * T + r0u * 64 + q) * ZW + ZQ + hh * 64; q0 = *(const bf16x8*)(qp + kq * 8); q1 = *(const bf16x8*)(qp + 32 + kq * 8); }
                    __syncthreads();
#pragma unroll 1
                    for (int k8 = 0; k8 < 8; ++k8) {
                        const int r = r0u + k8;
                        const int rs = min(max(r - 4, 0), 56);
                        const int rn = min(r + 1, 63), rsn = min(max(rn - 4, 0), 56); const bool newrow = (k8 < 7) && (rsn != rs); const int krn = rsn + 7;
                        bf16x8 nq0, nq1; u32x4 st0 = (u32x4){0u, 0u, 0u, 0u}, st1 = st0;
                        { const bf16* qp = Z + (size_t)(b * T + rn * 64 + q) * ZW + ZQ + hh * 64; nq0 = *(const bf16x8*)(qp + kq * 8); nq1 = *(const bf16x8*)(qp + 32 + kq * 8); }
                        { const int col = (tid >> 3) & 63, ch = tid & 7; const bf16* src = Z + (size_t)(b * T + min(krn, 63) * 64 + col) * ZW + hh * 64 + ch * 8;
                            st0 = *(const u32x4*)(src + ZK); st1 = *(const u32x4*)(src + ZV); }
                        float sc[8][4]; float mx = -1e30f;
#pragma unroll
                        for (int kt = 0; kt < 8; ++kt) { const int il = kt >> 1, ch2 = kt & 1, krow = rs + half * 4 + il, colA = c0 + 16 * ch2 + r16;
                            const LAS unsigned char* ka = Ks + ((((krow & 7) * 64 + colA) << 7));
                            const bf16x8 a0 = *(const LAS bf16x8*)(ka + ((kq ^ (colA & 7)) << 4)), a1 = *(const LAS bf16x8*)(ka + (((4 + kq) ^ (colA & 7)) << 4));
                            f32x4 acc = (f32x4){0.f, 0.f, 0.f, 0.f};
                            acc = __builtin_amdgcn_mfma_f32_16x16x32_bf16(a0, q0, acc, 0, 0, 0); acc = __builtin_amdgcn_mfma_f32_16x16x32_bf16(a1, q1, acc, 0, 0, 0);
                            const LAS float* brow = rp + (krow - r + 7) * 31 + (15 - q);
#pragma unroll
                            for (int g = 0; g < 4; ++g) { const int col = c0 + 16 * ch2 + 4 * kq + g; const bool valid = (col >= cs) && (col < cs + 16);
                                const float bias = brow[valid ? col : (q - 15)];
                                const float v = valid ? (acc[g] * 0.125f + bias) : -1e30f; sc[kt][g] = v; mx = fmaxf(mx, v); } }
                        mx = fmaxf(mx, __shfl_xor(mx, 16)); mx = fmaxf(mx, __shfl_xor(mx, 32));
                        float ls = 0.f;
#pragma unroll
                        for (int kt = 0; kt < 8; ++kt)
#pragma unroll
                            for (int g = 0; g < 4; ++g) { const float pv = __expf(sc[kt][g] - mx); sc[kt][g] = pv; ls += pv; }
                        ls += __shfl_xor(ls, 16); ls += __shfl_xor(ls, 32);
                        f32x4 o[4];
#pragma unroll
                        for (int dt = 0; dt < 4; ++dt) o[dt] = (f32x4){0.f, 0.f, 0.f, 0.f};
                        const int qq = r16 >> 2, pp = r16 & 3;
#pragma unroll
                        for (int m2 = 0; m2 < 4; ++m2) { const int krow = rs + half * 4 + m2;
                            u32x4 pb; pb.x = pk2(sc[2 * m2][0], sc[2 * m2][1]); pb.y = pk2(sc[2 * m2][2], sc[2 * m2][3]); pb.z = pk2(sc[2 * m2 + 1][0], sc[2 * m2 + 1][1]); pb.w = pk2(sc[2 * m2 + 1][2], sc[2 * m2 + 1][3]);
                            const bf16x8 bfrag = __builtin_bit_cast(bf16x8, pb);
                            const int col0 = c0 + 4 * kq + qq, col1 = col0 + 16;
                            const LAS unsigned char* v0b = Vs + ((((krow & 7) * 64 + col0) << 7)) + (pp & 1) * 8; const LAS unsigned char* v1b = Vs + ((((krow & 7) * 64 + col1) << 7)) + (pp & 1) * 8;
#pragma unroll
                            for (int dt = 0; dt < 4; ++dt) { const int chn = 2 * dt + (pp >> 1);
                                const s16x4 t0 = __builtin_amdgcn_ds_read_tr16_b64_v4i16((LAS s16x4*)(v0b + ((chn ^ (col0 & 7)) << 4)));
                                const s16x4 t1 = __builtin_amdgcn_ds_read_tr16_b64_v4i16((LAS s16x4*)(v1b + ((chn ^ (col1 & 7)) << 4)));
                                const bf16x8 afrag = (bf16x8){t0[0], t0[1], t0[2], t0[3], t1[0], t1[1], t1[2], t1[3]};
                                o[dt] = __builtin_amdgcn_mfma_f32_16x16x32_bf16(afrag, bfrag, o[dt], 0, 0, 0); } }
                        LAS float* px = xch + q * 68;
                        if (half == 1) {
#pragma unroll
                            for (int dt = 0; dt < 4; ++dt) *(LAS f32x4*)(px + 16 * dt + 4 * kq) = o[dt];
                            if (kq == 0) { px[64] = mx; px[65] = ls; } }
                        __syncthreads();
                        if (half == 0) { const float m1 = px[64], l1 = px[65]; const float mm = fmaxf(mx, m1), f0 = __expf(mx - mm), f1 = __expf(m1 - mm); const float inv = __builtin_amdgcn_rcpf(f0 * ls + f1 * l1);
                            bf16* op = YCAT + (size_t)(b * T + r * 64 + q) * D + hh * 64 + 4 * kq;
#pragma unroll
                            for (int dt = 0; dt < 4; ++dt) { const f32x4 o1 = *(const LAS f32x4*)(px + 16 * dt + 4 * kq); const f32x4 res = (o[dt] * f0 + o1 * f1) * inv;
                                u32x2 w; w.x = pk2(res[0], res[1]); w.y = pk2(res[2], res[3]); *(u32x2*)(op + 16 * dt) = w; } }
                        if (newrow) { const int col = (tid >> 3) & 63, ch = tid & 7; const int off = ((((krn & 7) * 64 + col) << 7) + ((ch ^ (col & 7)) << 4));
                            *(LAS u32x4*)(Ks + off) = st0; *(LAS u32x4*)(Vs + off) = st1; }
                        q0 = nq0; q1 = nq1;
                        __syncthreads();
                    }
                }
            }
            if (SUBEN(1) && (args.sub & 2)) {
                LAS bf16* PWT = (LAS bf16*)lds;
                LAS bf16* DB = PWT + 4 * 64 * 72;
                const int ch = tid & 255, hf = tid >> 8, gq = ch >> 6, hw = 1 << gq;
                { const float* pwp = INP(IN_POOLW) + (size_t)l * 4 * 64 * 64;
                  for (int i = tid; i < 4 * 64 * 64; i += NWAVES * 64) { const int g = i >> 12, c = (i >> 6) & 63, dd = i & 63; PWT[(g * 64 + dd) * 72 + c] = (bf16)f2bf(pwp[i]); } }
                const int r16 = lane & 15, kq = lane >> 4, mg = wave & 3, mtk = wave >> 2;
                f32x4 psc[4];
                { const float* psp = INP(IN_POOLS) + l * GW + mg * 64;
#pragma unroll
                  for (int dt = 0; dt < 4; ++dt) psc[dt] = *(const f32x4*)(psp + dt * 16 + 4 * kq); }
                const float cw0 = INP(IN_CONVW)[(size_t)l * 3 * GW + ch], cw1 = INP(IN_CONVW)[(size_t)l * 3 * GW + GW + ch], cw2 = INP(IN_CONVW)[(size_t)l * 3 * GW + 2 * GW + ch];
                __syncthreads();
                for (int it = vcu; it < M / 32; it += G) {
                    const int b = it >> 7, tb = (it & 127) * 32, t0 = tb + hf * 16;
                    const bf16* zb = Z + (size_t)b * T * ZW;
                    float ps[33]; ps[0] = 0.f;
#pragma unroll
                    for (int i = 0; i < 32; ++i) { const int tp = t0 - 8 + i; const int tc = min(max(tp, 0), T - 1); const float zv = bf2f(zb[(size_t)tc * ZW + ZP + ch]) * ((tp == tc) ? 1.f : 0.f); ps[i + 1] = ps[i] + zv; }
                    float uu[18], bg[16];
#pragma unroll
                    for (int i = 0; i < 18; ++i) { const int tp = t0 - 1 + i; const int tc = min(max(tp, 0), T - 1); uu[i] = bf2f(zb[(size_t)tc * ZW + ZCC + ch]) * bf2f(zb[(size_t)tc * ZW + ZCH + ch]) * ((tp == tc) ? 1.f : 0.f); }
#pragma unroll
                    for (int k = 0; k < 16; ++k) bg[k] = bf2f(zb[(size_t)(t0 + k) * ZW + ZCB + ch]);
#pragma unroll
                    for (int k = 0; k < 16; ++k) { const int t = t0 + k;
                        const int lo_ = max(t - hw, 0), hi_ = min(t + hw, T);
                        float sw;
                        if (gq == 0) sw = ps[k + 9] - ps[k + 7]; else if (gq == 1) sw = ps[k + 10] - ps[k + 6]; else if (gq == 2) sw = ps[k + 12] - ps[k + 4]; else sw = ps[k + 16] - ps[k];
                        const float uq = ps[k + 9] - ps[k + 8];
                        DB[(hf * 16 + k) * 264 + ch] = (bf16)f2bf(sw * __builtin_amdgcn_rcpf((float)(hi_ - lo_)) - uq); }
                    __syncthreads();
                    { const LAS bf16* bp = DB + (mtk * 16 + r16) * 264 + mg * 64 + kq * 8;
                      const bf16x8 b0 = *(const LAS bf16x8*)bp, b1 = *(const LAS bf16x8*)(bp + 32);
                      bf16* op = YCAT + (size_t)(b * T + tb + mtk * 16 + r16) * D + 512 + mg * 64 + 4 * kq;
#pragma unroll
                      for (int dt = 0; dt < 4; ++dt) { const LAS bf16* ap = PWT + (mg * 64 + dt * 16 + r16) * 72 + kq * 8;
                          f32x4 acc = __builtin_amdgcn_mfma_f32_16x16x32_bf16(*(const LAS bf16x8*)ap, b0, (f32x4){0.f, 0.f, 0.f, 0.f}, 0, 0, 0);
                          acc = __builtin_amdgcn_mfma_f32_16x16x32_bf16(*(const LAS bf16x8*)(ap + 32), b1, acc, 0, 0, 0);
                          acc = acc * psc[dt];
                          u32x2 w; w.x = pk2(acc[0], acc[1]); w.y = pk2(acc[2], acc[3]); *(u32x2*)(op + dt * 16) = w; } }
#pragma unroll
                    for (int k = 0; k < 16; ++k) YCAT[(size_t)(b * T + t0 + k) * D + 768 + ch] = (bf16)f2bf(bg[k] * (cw0 * uu[k] + cw1 * uu[k + 1] + cw2 * uu[k + 2]));
                    __syncthreads();
                }
            }
        }
        if (PHEN(4) && IN(P + 2)) {
            PHASE_PROLOGUE
            constexpr int LP = 64, MS = 64 * LP;
            LAS bf16* At = (LAS bf16*)lds; LAS bf16* Rt = At + MS; LAS bf16* Bt = Rt + MS; LAS bf16* Kt = Bt + MS;
            LAS bf16* XT = Kt + MS;
            LAS bf16* BhT = XT + 2 * MS; LAS bf16* KhT = BhT + MS; LAS bf16* VT = KhT + MS;
            LAS bf16* Nb = VT + MS;
            LAS bf16* Mk = Nb + 4 * MS; LAS bf16* Pb = Mk + MS; LAS bf16* Pk = Pb + MS;
            LAS float* tot = (LAS float*)(Pk + MS);
            const int r16 = lane & 15, kq = lane >> 4, sw = r16 & 7;
            const int fo0 = r16 * LP + ((kq ^ sw) << 3), fo1 = r16 * LP + (((4 + kq) ^ sw) << 3);
#define TOFF(y0) (r16 * LP + (((((y0) >> 3) + (kq >> 1)) ^ sw) << 3) + 4 * (kq & 1))
#define LBAR() do { asm volatile("s_waitcnt lgkmcnt(0)" ::: "memory"); __builtin_amdgcn_s_barrier(); asm volatile("" ::: "memory"); } while (0)
#define MMA16H(acc, Ap, Bp, h) do { const bf16x8 _a = *(const LAS bf16x8*)((Ap) + ((h) ? fo1 : fo0)); const bf16x8 _b = *(const LAS bf16x8*)((Bp) + ((h) ? fo1 : fo0)); \
        acc = __builtin_amdgcn_mfma_f32_16x16x32_bf16(_a, _b, acc, 0, 0, 0); } while (0)
#define MMA16(acc, Ap, Bp) do { MMA16H(acc, Ap, Bp, 0); MMA16H(acc, Ap, Bp, 1); } while (0)
#define STORE_T(dst, x0, y0, acc) do { u32x2 _w; _w.x = pk2((acc)[0], (acc)[1]); _w.y = pk2((acc)[2], (acc)[3]); *(LAS u32x2*)((dst) + (x0) * LP + TOFF(y0)) = _w; } while (0)
            const int e = (vcu & 7) >> 2, hh = vcu & 3, cch = hh * 64 + lane;
            LAS bf16* LWT = (LAS bf16*)(tot + 1024);
            LAS bf16* LATW = Pb; LAS bf16* LATA = Pk;
            LAS float* WPA = (LAS float*)Nb;
            { const float* w2p = INP(IN_W2L); const float* a2p = INP(IN_A2L);
              for (int i = tid; i < 4096; i += NWAVES * 64) { const int wh = i >> 11, q = (i >> 6) & 31, cc = i & 63;
                  LWT[(wh * 64 + cc) * 40 + q] = (bf16)f2bf((wh ? a2p : w2p)[((size_t)(l * 2 + e) * 32 + q) * GW + hh * 64 + cc]); } }
            const float w0c = INP(IN_W0)[(size_t)(l * 2 + e) * GW + cch], a0c = INP(IN_A0)[(size_t)(l * 2 + e) * GW + cch];
            const float kkc = INP(IN_KK)[(size_t)l * GW + cch], kac = INP(IN_KA)[(size_t)l * GW + cch];
            float mur, muk, muv, mulat;
            { const float* mu = INP(IN_MU) + (size_t)(l * 2 + e) * RWS; mur = mu[cch]; muk = mu[256 + cch]; muv = mu[512 + cch]; mulat = mu[768 + lane]; }
            __syncthreads();
            float rz[9], kz[9], vz[9], lz[9];
#define E0_LOAD(idx_) do { const int _b = (idx_) >> 6, _ck = (idx_) & 63; int cl_ = cch, jl_ = lane; asm volatile("" : "+v"(cl_), "+v"(jl_)); \
        _Pragma("unroll") for (int x = 0; x < 9; ++x) { const int sidx = _ck * 64 + wave * 8 + x - 1; const int t = e ? (T - 1 - sidx) : sidx; \
            const float okf = (sidx >= 0) ? 1.f : 0.f; const int tcl = min(max(t, 0), T - 1); \
            const bf16* zp = Z + (size_t)(_b * T + tcl) * ZW + ZR; rz[x] = bf2f(zp[cl_]) * okf; kz[x] = bf2f(zp[256 + cl_]) * okf; vz[x] = bf2f(zp[512 + cl_]) * okf; lz[x] = bf2f(zp[768 + jl_]) * okf; } } while (0)
            E0_LOAD(vcu >> 3);
            for (int idx = vcu >> 3; idx < 512; idx += (G >> 3)) {
                const int b = idx >> 6, ck = idx & 63, chain = (e * 8 + b) * 4 + hh, u = chain * 64 + ck;
                for (int rep_ = 0; rep_ <= ((args.sub >> 8) & 1); ++rep_) {
                    const int j = lane, s0 = wave * 8;
#pragma unroll
                    for (int x = 0; x < 8; ++x) { const float zd = lz[x + 1] + mulat * (lz[x] - lz[x + 1]);
                        const float tv = 1.0f - 2.0f * __builtin_amdgcn_rcpf(1.0f + __expf(2.0f * zd));
                        ((j < 32) ? LATW : LATA)[(s0 + x) * LP + ((((j & 31) >> 3) ^ x) << 3) + (j & 7)] = (bf16)f2bf((j < 32) ? tv : zd); }
                    LBAR();
                    { const int wh = wave >> 2, ty = wave & 3;
                      const bf16x8 af = *(const LAS bf16x8*)((wh ? LATA : LATW) + ty * 16 * LP + fo0);
#pragma unroll
                      for (int tx = 0; tx < 4; ++tx) { const bf16x8 bfr = *(const LAS bf16x8*)(LWT + (wh * 64 + tx * 16 + r16) * 40 + kq * 8);
                          const f32x4 acc = __builtin_amdgcn_mfma_f32_16x16x32_bf16(af, bfr, (f32x4){0.f, 0.f, 0.f, 0.f}, 0, 0, 0);
                          *(LAS f32x4*)(WPA + (wh * 64 + tx * 16 + r16) * 68 + ty * 16 + 4 * kq) = acc; } }
                    LBAR();
                    f32x4 wpv[2], apv[2];
                    wpv[0] = *(const LAS f32x4*)(WPA + j * 68 + s0); wpv[1] = *(const LAS f32x4*)(WPA + j * 68 + s0 + 4); apv[0] = *(const LAS f32x4*)(WPA + (64 + j) * 68 + s0); apv[1] = *(const LAS f32x4*)(WPA + (64 + j) * 68 + s0 + 4);
                    float cw[8], lwv[8], rr[8], kk_[8], aa[8], bb[8];
                    float run = 0.f;
#pragma unroll
                    for (int x = 0; x < 8; ++x) {
                        const float r_ = rz[x + 1] + mur * (rz[x] - rz[x + 1]), kk0 = kz[x + 1] + muk * (kz[x] - kz[x + 1]);
                        const float wp = w0c + wpv[x >> 2][x & 3], ap = a0c + apv[x >> 2][x & 3];
                        const float nx = -wp; const float sp = fmaxf(nx, 0.f) + __logf(1.0f + __expf(-fabsf(nx)));
                        lwv[x] = -__expf(-sp - 0.5f);
                        const float av = sigmoidf_(ap);
                        float kk = kk0 * kkc; const float ss = wave_sum(kk * kk); kk *= __builtin_amdgcn_rsqf(fmaxf(ss, 1e-12f));
                        rr[x] = r_; kk_[x] = kk0 * (1.0f + (av - 1.0f) * kac); aa[x] = -kk; bb[x] = kk * av;
                        run += lwv[x]; cw[x] = run; }
                    tot[wave * 64 + j] = run;
                    LBAR();
                    float pre = 0.f, all = 0.f;
#pragma unroll
                    for (int w = 0; w < 8; ++w) { const float v = tot[w * 64 + j]; all += v; pre += (w < wave) ? v : 0.f; }
                    unsigned xt[8], bh[8], kh[8], vt[8];
                    const int rm = (j >> 3) << 3, jl = j & 7;
                    const float wlall = __expf(all); float ewp = __expf(pre); if (wave == 0) tot[512 + j] = wlall;
#pragma unroll
                    for (int x = 0; x < 8; ++x) { const float c = cw[x] + pre; const float ew = __expf(c), ewx = ewp, einv = __builtin_amdgcn_rcpf(ew), eL = wlall * einv; ewp = ew;
                        xt[x] = f2bf(aa[x] * ewx); bh[x] = f2bf(bb[x] * eL); kh[x] = f2bf(kk_[x] * eL); vt[x] = f2bf(vz[x + 1] + muv * (vz[x] - vz[x + 1]));
                        const int ro = (s0 + x) * LP + ((rm ^ (x << 3))) + jl;
                        At[ro] = (bf16)xt[x]; Rt[ro] = (bf16)f2bf(rr[x] * ew); Bt[ro] = (bf16)f2bf(bb[x] * einv); Kt[ro] = (bf16)f2bf(kk_[x] * einv); }
                    const int to = j * LP + ((wave ^ (j & 7)) << 3);
                    u32x4 w4;
                    w4.x = xt[0] | (xt[1] << 16); w4.y = xt[2] | (xt[3] << 16); w4.z = xt[4] | (xt[5] << 16); w4.w = xt[6] | (xt[7] << 16); *(LAS u32x4*)(XT + to) = w4;
                    w4.x = bh[0] | (bh[1] << 16); w4.y = bh[2] | (bh[3] << 16); w4.z = bh[4] | (bh[5] << 16); w4.w = bh[6] | (bh[7] << 16); *(LAS u32x4*)(BhT + to) = w4;
                    w4.x = kh[0] | (kh[1] << 16); w4.y = kh[2] | (kh[3] << 16); w4.z = kh[4] | (kh[5] << 16); w4.w = kh[6] | (kh[7] << 16); *(LAS u32x4*)(KhT + to) = w4;
                    w4.x = vt[0] | (vt[1] << 16); w4.y = vt[2] | (vt[3] << 16); w4.z = vt[4] | (vt[5] << 16); w4.w = vt[6] | (vt[7] << 16); *(LAS u32x4*)(VT + to) = w4;
                    LBAR();
                    if (rep_ == ((args.sub >> 8) & 1)) E0_LOAD(min(idx + (G >> 3), 511));
                }
                for (int rep_ = 0; rep_ <= ((args.sub >> 9) & 1); ++rep_) {
#pragma unroll
                for (int n2 = 0; n2 < 2; ++n2) {
                    const int ty = n2 * 2 + (wave >> 2), tx = wave & 3;
                    const f32x4 z4 = (f32x4){0.f, 0.f, 0.f, 0.f};
                    f32x4 aN = z4, aNT = z4, aMk = z4, aPb = z4, aPk = z4;
                    const LAS bf16* yA = At + ty * 16 * LP; const LAS bf16* yB = Bt + ty * 16 * LP; const LAS bf16* yK = Kt + ty * 16 * LP;
                    const LAS bf16* xA = At + tx * 16 * LP; const LAS bf16* xB = Bt + tx * 16 * LP; const LAS bf16* xR = Rt + tx * 16 * LP;
                    if (ty <= tx) {
                        const bf16x8 yb0 = *(const LAS bf16x8*)(yB + fo0), yb1 = *(const LAS bf16x8*)(yB + fo1), yk0 = *(const LAS bf16x8*)(yK + fo0), yk1 = *(const LAS bf16x8*)(yK + fo1);
                        const bf16x8 xa0 = *(const LAS bf16x8*)(xA + fo0), xa1 = *(const LAS bf16x8*)(xA + fo1), xr0 = *(const LAS bf16x8*)(xR + fo0), xr1 = *(const LAS bf16x8*)(xR + fo1);
                        aN = __builtin_amdgcn_mfma_f32_16x16x32_bf16(yb0, xa0, aN, 0, 0, 0); aMk = __builtin_amdgcn_mfma_f32_16x16x32_bf16(yk0, xa0, aMk, 0, 0, 0);
                        aPb = __builtin_amdgcn_mfma_f32_16x16x32_bf16(yb0, xr0, aPb, 0, 0, 0); aPk = __builtin_amdgcn_mfma_f32_16x16x32_bf16(yk0, xr0, aPk, 0, 0, 0);
                        aN = __builtin_amdgcn_mfma_f32_16x16x32_bf16(yb1, xa1, aN, 0, 0, 0); aMk = __builtin_amdgcn_mfma_f32_16x16x32_bf16(yk1, xa1, aMk, 0, 0, 0);
                        aPb = __builtin_amdgcn_mfma_f32_16x16x32_bf16(yb1, xr1, aPb, 0, 0, 0); aPk = __builtin_amdgcn_mfma_f32_16x16x32_bf16(yk1, xr1, aPk, 0, 0, 0); }
                    if (tx <= ty) {
                        const bf16x8 ya0 = *(const LAS bf16x8*)(yA + fo0), ya1 = *(const LAS bf16x8*)(yA + fo1), xb0 = *(const LAS bf16x8*)(xB + fo0), xb1 = *(const LAS bf16x8*)(xB + fo1);
                        aNT = __builtin_amdgcn_mfma_f32_16x16x32_bf16(ya0, xb0, aNT, 0, 0, 0); aNT = __builtin_amdgcn_mfma_f32_16x16x32_bf16(ya1, xb1, aNT, 0, 0, 0); }
                    if (ty == tx) {
#pragma unroll
                        for (int q = 0; q < 4; ++q) { const int yy = 4 * kq + q; const bool lt = yy < r16, le = yy <= r16;
                            aN[q] = lt ? aN[q] : 0.f; aMk[q] = lt ? aMk[q] : 0.f; aPb[q] = le ? aPb[q] : 0.f; aPk[q] = le ? aPk[q] : 0.f; aNT[q] = (r16 < yy) ? aNT[q] : 0.f; } }
                    STORE_T(Nb, tx * 16, ty * 16, aN); STORE_T(Nb + MS, tx * 16, ty * 16, aNT); STORE_T(Mk, tx * 16, ty * 16, aMk); STORE_T(Pb, tx * 16, ty * 16, aPb); STORE_T(Pk, tx * 16, ty * 16, aPk); asm volatile("" ::: "memory"); }
                LBAR();
                for (int id = wave; id < 16; id += 8) { const int ty = id >> 2, tx = id & 3;
                    f32x4 acc = (f32x4){0.f, 0.f, 0.f, 0.f};
                    MMA16H(acc, Mk + ty * 16 * LP, VT + tx * 16 * LP, 0); if (ty >= 2) MMA16H(acc, Mk + ty * 16 * LP, VT + tx * 16 * LP, 1);
                    STORE_T(XT + MS, tx * 16, ty * 16, acc); }
                LBAR();
                }
                {
                    LAS bf16* Nc = Nb; LAS bf16* NcT = Nb + MS; LAS bf16* Nn = Nb + 2 * MS; LAS bf16* NnT = Nb + 3 * MS;
                    const int which = wave >> 2, wq = wave & 3;
                    const int tt0 = (wq == 0) ? 0 : (wq == 1) ? 3 : (wq == 2) ? 1 : 2, st0 = (wq == 0) ? 0 : (wq == 1) ? 0 : (wq == 2) ? 1 : 2;
                    const int tt1 = (wq == 0) ? 1 : (wq == 1) ? 3 : (wq == 2) ? 2 : 3, st1 = (wq == 0) ? 0 : (wq == 1) ? 1 : (wq == 2) ? 1 : 3;
                    const int tt2 = (wq == 0) ? 2 : (wq == 1) ? 3 : (wq == 2) ? 3 : 1, st2 = (wq == 0) ? 0 : (wq == 1) ? 2 : (wq == 2) ? 3 : 1;
                    const int ty0 = which ? tt0 : st0, tx0 = which ? st0 : tt0, ty1 = which ? tt1 : st1, tx1 = which ? st1 : tt1, ty2 = which ? tt2 : st2, tx2 = which ? st2 : tt2;
                    for (int k = 0; k < 6; ++k) {
                        LAS bf16* Xw = XT + wave * 16 * LP;
                        const bf16x8 b0 = *(const LAS bf16x8*)(Xw + fo0), b1 = *(const LAS bf16x8*)(Xw + fo1);
                        u32x2 c0[4]; bf16x8 a0[4], a1[4];
#pragma unroll
                        for (int ty = 0; ty < 4; ++ty) { c0[ty] = *(const LAS u32x2*)(Xw + TOFF(ty * 16)); a0[ty] = *(const LAS bf16x8*)(Nc + ty * 16 * LP + fo0); a1[ty] = *(const LAS bf16x8*)(Nc + ty * 16 * LP + fo1); }
                        const LAS bf16* sA = which ? Nc : NcT; const LAS bf16* sB = which ? NcT : Nc;
                        const bf16x8 p0 = *(const LAS bf16x8*)(sA + ty0 * 16 * LP + fo0), p1 = *(const LAS bf16x8*)(sA + ty0 * 16 * LP + fo1), q0 = *(const LAS bf16x8*)(sB + tx0 * 16 * LP + fo0), q1 = *(const LAS bf16x8*)(sB + tx0 * 16 * LP + fo1);
                        const bf16x8 p2 = *(const LAS bf16x8*)(sA + ty1 * 16 * LP + fo0), p3 = *(const LAS bf16x8*)(sA + ty1 * 16 * LP + fo1), q2 = *(const LAS bf16x8*)(sB + tx1 * 16 * LP + fo0), q3 = *(const LAS bf16x8*)(sB + tx1 * 16 * LP + fo1);
                        const bf16x8 p4 = *(const LAS bf16x8*)(sA + ty2 * 16 * LP + fo0), p5 = *(const LAS bf16x8*)(sA + ty2 * 16 * LP + fo1), q4 = *(const LAS bf16x8*)(sB + tx2 * 16 * LP + fo0), q5 = *(const LAS bf16x8*)(sB + tx2 * 16 * LP + fo1);
                        f32x4 acc[4];
#pragma unroll
                        for (int ty = 0; ty < 4; ++ty) { acc[ty] = (f32x4){bflo(c0[ty].x), bfhi(c0[ty].x), bflo(c0[ty].y), bfhi(c0[ty].y)};
                            acc[ty] = __builtin_amdgcn_mfma_f32_16x16x32_bf16(a0[ty], b0, acc[ty], 0, 0, 0); acc[ty] = __builtin_amdgcn_mfma_f32_16x16x32_bf16(a1[ty], b1, acc[ty], 0, 0, 0); }
                        const f32x4 z4 = (f32x4){0.f, 0.f, 0.f, 0.f};
                        f32x4 s0a = __builtin_amdgcn_mfma_f32_16x16x32_bf16(p0, q0, z4, 0, 0, 0), s1a = __builtin_amdgcn_mfma_f32_16x16x32_bf16(p2, q2, z4, 0, 0, 0), s2a = __builtin_amdgcn_mfma_f32_16x16x32_bf16(p4, q4, z4, 0, 0, 0);
                        s0a = __builtin_amdgcn_mfma_f32_16x16x32_bf16(p1, q1, s0a, 0, 0, 0); s1a = __builtin_amdgcn_mfma_f32_16x16x32_bf16(p3, q3, s1a, 0, 0, 0); s2a = __builtin_amdgcn_mfma_f32_16x16x32_bf16(p5, q5, s2a, 0, 0, 0);
#pragma unroll
                        for (int ty = 0; ty < 4; ++ty) STORE_T(Xw, 0, ty * 16, acc[ty]);
                        if (k < 5) { LAS bf16* dst = which ? NnT : Nn;
                            STORE_T(dst, tx0 * 16, ty0 * 16, s0a); STORE_T(dst, tx1 * 16, ty1 * 16, s1a); STORE_T(dst, tx2 * 16, ty2 * 16, s2a);
                            if (k == 0) {
                                if (wq < 3) { for (int st = wq + 1; st < 4; ++st) { const int tt = wq; const int tyz = which ? tt : st, txz = which ? st : tt; STORE_T(dst, txz * 16, tyz * 16, z4); } } } }
                        LBAR();
                        { LAS bf16* t0 = Nc; Nc = Nn; Nn = t0; t0 = NcT; NcT = NnT; NnT = t0; }
                    }
                }
                for (int rep_ = 0; rep_ <= ((args.sub >> 10) & 1); ++rep_) {
                    bf16* cho = CH + (size_t)u * 16384;
#pragma unroll
                    for (int n2 = 0; n2 < 2; ++n2) {
                        const int ty = n2 * 2 + (wave >> 2), tx = wave & 3;
                        const int xg = tx * 16 + r16, yg = ty * 16 + 4 * kq;
                        const f32x4 z4 = (f32x4){0.f, 0.f, 0.f, 0.f};
                        f32x4 aRp = z4, aPm = z4, aYl = z4, aQm = z4;
#pragma unroll
                        for (int h = 0; h < 2; ++h) { const int fo = h ? fo1 : fo0;
                            const bf16x8 yU = *(const LAS bf16x8*)(XT + ty * 16 * LP + fo), yPb = *(const LAS bf16x8*)(Pb + ty * 16 * LP + fo), yPk = *(const LAS bf16x8*)(Pk + ty * 16 * LP + fo),
                                         yBh = *(const LAS bf16x8*)(BhT + ty * 16 * LP + fo), yKh = *(const LAS bf16x8*)(KhT + ty * 16 * LP + fo);
                            const bf16x8 xPb = *(const LAS bf16x8*)(Pb + tx * 16 * LP + fo), xBh = *(const LAS bf16x8*)(BhT + tx * 16 * LP + fo), xUv = *(const LAS bf16x8*)(XT + MS + tx * 16 * LP + fo), xV = *(const LAS bf16x8*)(VT + tx * 16 * LP + fo);
                            aRp = __builtin_amdgcn_mfma_f32_16x16x32_bf16(yU, xPb, aRp, 0, 0, 0);
                            aPm = __builtin_amdgcn_mfma_f32_16x16x32_bf16(yU, xBh, aPm, 0, 0, 0);
                            aYl = __builtin_amdgcn_mfma_f32_16x16x32_bf16(yPb, xUv, aYl, 0, 0, 0);
                            aYl = __builtin_amdgcn_mfma_f32_16x16x32_bf16(yPk, xV, aYl, 0, 0, 0);
                            aQm = __builtin_amdgcn_mfma_f32_16x16x32_bf16(yBh, xUv, aQm, 0, 0, 0);
                            aQm = __builtin_amdgcn_mfma_f32_16x16x32_bf16(yKh, xV, aQm, 0, 0, 0); }
                        { const u32x2 c0 = *(const LAS u32x2*)(Rt + tx * 16 * LP + TOFF(ty * 16)); aRp[0] += bflo(c0.x); aRp[1] += bfhi(c0.x); aRp[2] += bflo(c0.y); aRp[3] += bfhi(c0.y); }
                        { const float wl = tot[512 + xg];
#pragma unroll
                          for (int q = 0; q < 4; ++q) aPm[q] += (yg + q == xg) ? wl : 0.f; }
                        u32x2 w2; int lofs = xg * 64 + yg; asm volatile("" : "+v"(lofs));
                        bf16* const cl = cho + lofs;
                        w2.x = pk2(aRp[0], aRp[1]); w2.y = pk2(aRp[2], aRp[3]); *(u32x2*)(cl + 0 * 4096) = w2;
                        w2.x = pk2(aPm[0], aPm[1]); w2.y = pk2(aPm[2], aPm[3]); *(u32x2*)(cl + 1 * 4096) = w2;
                        w2.x = pk2(aYl[0], aYl[1]); w2.y = pk2(aYl[2], aYl[3]); *(u32x2*)(cl + 2 * 4096) = w2;
                        w2.x = pk2(aQm[0], aQm[1]); w2.y = pk2(aQm[2], aQm[3]); *(u32x2*)(cl + 3 * 4096) = w2; asm volatile("" ::: "memory"); }
                }
                LBAR();
            }
#undef E0_LOAD
#undef MMA16
#undef MMA16H
#undef STORE_T
#undef TOFF
#undef LBAR
            SEAM(P + 2);
        }
        if (PHEN(15) && IN(P + 3)) {
            PHASE_PROLOGUE
            constexpr int LP = 72, MS = 16 * LP;
            LAS bf16* Sb = (LAS bf16*)lds;
            const int r16 = lane & 15, kq = lane >> 4, ty = wave & 3, role = wave >> 2;
            for (int wu = bx; wu < 256; wu += G) {
                const int chain = (wu & 7) + 8 * (wu >> 5), it = (wu >> 3) & 3;
                const int e = chain >> 5, b = (chain >> 2) & 7, hh = chain & 3;
                for (int i = tid; i < 2 * MS / 2; i += NWAVES * 64) ((LAS unsigned*)Sb)[i] = 0u;
                __syncthreads();
                const bf16* ch0 = CH + (size_t)chain * 64 * 16384;
                float* ysb = YS + ((size_t)(e * 8 + b) * T) * 256 + hh * 64 + it * 16 + r16;
#define SQ_LOAD(Aq, Cq, c) do { const bf16* _ab = ch0 + (size_t)(c) * 16384 + (role ? 0 : 4096) + (ty * 16 + r16) * 64 + kq * 8; \
        Aq[0] = *(const bf16x8*)_ab; Aq[1] = *(const bf16x8*)(_ab + 32); \
        Cq = *(const u32x2*)(ch0 + (size_t)(c) * 16384 + (role ? 8192 : 12288) + (it * 16 + r16) * 64 + ty * 16 + 4 * kq); } while (0)
#define SQ_STEP(Aq, Cq, c) do { const LAS bf16* _Sc = Sb + ((c) & 1) * MS; LAS bf16* _Sn = Sb + (((c) + 1) & 1) * MS; \
        const bf16x8 _b0 = *(const LAS bf16x8*)(_Sc + r16 * LP + kq * 8), _b1 = *(const LAS bf16x8*)(_Sc + r16 * LP + 32 + kq * 8); \
        f32x4 _acc = (f32x4){bflo(Cq.x), bfhi(Cq.x), bflo(Cq.y), bfhi(Cq.y)}; \
        _acc = __builtin_amdgcn_mfma_f32_16x16x32_bf16(Aq[0], _b0, _acc, 0, 0, 0); _acc = __builtin_amdgcn_mfma_f32_16x16x32_bf16(Aq[1], _b1, _acc, 0, 0, 0); \
        if (role == 0) { u32x2 _w; _w.x = pk2(_acc[0], _acc[1]); _w.y = pk2(_acc[2], _acc[3]); *(LAS u32x2*)(_Sn + r16 * LP + ty * 16 + 4 * kq) = _w; } \
        else { _Pragma("unroll") for (int _q = 0; _q < 4; ++_q) { const int _s = (c) * 64 + ty * 16 + 4 * kq + _q; const int _t = e ? (T - 1 - _s) : _s; __builtin_nontemporal_store(_acc[_q], ysb + (size_t)_t * 256); } } \
        asm volatile("s_waitcnt lgkmcnt(0)" ::: "memory"); __builtin_amdgcn_s_barrier(); asm volatile("" ::: "memory"); } while (0)
                bf16x8 A0[2], A1[2], A2[2], A3[2], A4[2], A5[2], A6[2], A7[2]; u32x2 C0, C1, C2, C3, C4, C5, C6, C7;
                if constexpr (l == 0) {
                SQ_LOAD(A0, C0, 0); SQ_LOAD(A1, C1, 1); SQ_LOAD(A2, C2, 2); SQ_LOAD(A3, C3, 3); SQ_LOAD(A4, C4, 4); SQ_LOAD(A5, C5, 5); SQ_LOAD(A6, C6, 6);
                for (int c = 0; c < 64; c += 8) {
                    SQ_LOAD(A7, C7, c + 7);
                    SQ_STEP(A0, C0, c);
                    SQ_LOAD(A0, C0, min(c + 8, 63));
                    SQ_STEP(A1, C1, c + 1);
                    SQ_LOAD(A1, C1, min(c + 9, 63));
                    SQ_STEP(A2, C2, c + 2);
                    SQ_LOAD(A2, C2, min(c + 10, 63));
                    SQ_STEP(A3, C3, c + 3);
                    SQ_LOAD(A3, C3, min(c + 11, 63));
                    SQ_STEP(A4, C4, c + 4);
                    SQ_LOAD(A4, C4, min(c + 12, 63));
                    SQ_STEP(A5, C5, c + 5);
                    SQ_LOAD(A5, C5, min(c + 13, 63));
                    SQ_STEP(A6, C6, c + 6);
                    SQ_LOAD(A6, C6, min(c + 14, 63));
                    SQ_STEP(A7, C7, c + 7);
                }
                } else {
                LAS float* scr = (LAS float*)(lds + 8192 + wave * 8448);
                const float* mw1 = INP(IN_MW1); const float* mw3 = INP(IN_MW3); const float* mw2 = INP(IN_MW2);
                float rv[32];
#define CV_DECODE(j_) const int _g = gw + NGW * (j_), _e = _g / 5376, _r = _g % 5376, _wh = _r / 1792, _it = _r % 1792; \
        const int _nblk = (_wh == 2) ? 32 : 112, _kb = _it / _nblk, _nb = _it % _nblk, _N = (_wh == 2) ? D : FF, _K = (_wh == 2) ? FF : D; \
        const float* _src = ((_wh == 0) ? mw1 : (_wh == 1) ? mw3 : mw2) + (size_t)_e * D * FF
#define CV_LOAD(j_) do { CV_DECODE(j_); const float* _w = _src + (size_t)(64 * _kb + (lane >> 5)) * _N + 32 * _nb + (lane & 31); \
        _Pragma("unroll") for (int i = 0; i < 32; ++i) rv[i] = __builtin_nontemporal_load(_w + (size_t)(2 * i) * _N); } while (0)
#define CV_FINISH(j_) do { CV_DECODE(j_); const int _n0 = 32 * _nb, _k0 = 64 * _kb; const float _sc = (_wh == 2) ? SC_W2 : SC_W13; \
        const int _drow0 = (_wh == 2) ? _n0 : (256 * (_n0 >> 7) + (_n0 & 127) + (_wh == 1 ? 128 : 0)); \
        unsigned char* _dst = (_wh == 2) ? (ws + WS_WM2 + (size_t)_e * D * FF) : (ws + WS_WM13 + (size_t)_e * 2 * FF * D); \
        _Pragma("unroll") for (int i = 0; i < 32; ++i) scr[(2 * i + (lane >> 5)) * 33 + (lane & 31)] = rv[i]; \
        LDS_WAIT(); asm volatile("" ::: "memory"); \
        { const int c_ = lane & 7; \
          _Pragma("unroll") for (int j = 0; j < 4; ++j) { const int n = (lane >> 3) + 8 * j; const LAS float* s_ = scr + (8 * c_) * 33 + n; \
            u32x2 o; o.x = pg8::cvt4_fp8(s_[0 * 33] * _sc, s_[1 * 33] * _sc, s_[2 * 33] * _sc, s_[3 * 33] * _sc); o.y = pg8::cvt4_fp8(s_[4 * 33] * _sc, s_[5 * 33] * _sc, s_[6 * 33] * _sc, s_[7 * 33] * _sc); \
            *(u32x2*)(_dst + (size_t)(_drow0 + n) * _K + _k0 + 8 * c_) = o; } } \
        LDS_WAIT(); asm volatile("" ::: "memory"); } while (0)
                SQ_LOAD(A0, C0, 0); SQ_LOAD(A1, C1, 1); SQ_LOAD(A2, C2, 2); SQ_LOAD(A3, C3, 3); SQ_LOAD(A4, C4, 4);
                for (int c = 0; c < 60; c += 6) { const int j0 = (c / 6) * 2;
                    CV_LOAD(j0);
                    SQ_LOAD(A5, C5, c + 5);
                    SQ_STEP(A0, C0, c);     SQ_LOAD(A0, C0, min(c + 6, 63));
                    SQ_STEP(A1, C1, c + 1); SQ_LOAD(A1, C1, min(c + 7, 63));
                    CV_FINISH(j0); CV_LOAD(j0 + 1);
                    SQ_STEP(A2, C2, c + 2); SQ_LOAD(A2, C2, min(c + 8, 63));
                    SQ_STEP(A3, C3, c + 3); SQ_LOAD(A3, C3, min(c + 9, 63));
                    SQ_STEP(A4, C4, c + 4); SQ_LOAD(A4, C4, min(c + 10, 63));
                    CV_FINISH(j0 + 1);
                    SQ_STEP(A5, C5, c + 5);
                }
                CV_LOAD(20);
                SQ_STEP(A0, C0, 60); SQ_STEP(A1, C1, 61);
                CV_FINISH(20);
                SQ_STEP(A2, C2, 62); SQ_STEP(A3, C3, 63);
#undef CV_DECODE
#undef CV_LOAD
#undef CV_FINISH
                }
#undef SQ_LOAD
#undef SQ_STEP
                __syncthreads();
            }
            SEAM(P + 3);
        }
        if (PHEN(5) && IN(P + 4)) {
            PHASE_PROLOGUE
            LAS bf16* G2T = (LAS bf16*)lds;
            LAS bf16* SGB = G2T + 256 * 72;
            LAS float* GT = (LAS float*)(SGB + 16 * 72);
            const int c = tid & 255, hf = tid >> 8, r16 = lane & 15, kq = lane >> 4;
            { const float* g2p = INP(IN_G2) + (size_t)l * 64 * GW;
              for (int i = tid; i < 64 * 256; i += NWAVES * 64) G2T[(i & 255) * 72 + (i >> 8)] = (bf16)f2bf(g2p[i]); }
            const float lw = INP(IN_LNW)[(size_t)l * GW + c], lb = INP(IN_LNB)[(size_t)l * GW + c], rk = INP(IN_RK)[(size_t)l * GW + c];
            for (int it = vcu; it < M / 16; it += G) {
                const int m0 = it * 16;
                for (int i = tid; i < 1024; i += NWAVES * 64) SGB[(i >> 6) * 72 + (i & 63)] = (bf16)f2bf(sigmoidf_(bf2f(Z[(size_t)(m0 + (i >> 6)) * ZW + ZLG + (i & 63)])));
                __syncthreads();
                { const bf16x8 b0 = *(const LAS bf16x8*)(SGB + r16 * 72 + kq * 8), b1 = *(const LAS bf16x8*)(SGB + r16 * 72 + 32 + kq * 8);
#pragma unroll
                  for (int n2 = 0; n2 < 2; ++n2) { const int ct = wave * 2 + n2; const LAS bf16* ap = G2T + (ct * 16 + r16) * 72 + kq * 8;
                      f32x4 acc = __builtin_amdgcn_mfma_f32_16x16x32_bf16(*(const LAS bf16x8*)ap, b0, (f32x4){0.f, 0.f, 0.f, 0.f}, 0, 0, 0);
                      acc = __builtin_amdgcn_mfma_f32_16x16x32_bf16(*(const LAS bf16x8*)(ap + 32), b1, acc, 0, 0, 0);
                      *(LAS f32x4*)(GT + r16 * 260 + ct * 16 + 4 * kq) = acc; } }
                __syncthreads();
                float ya[8], yb[8], r0[8], k0[8], v0[8], res[8];
#pragma unroll
                for (int k = 0; k < 8; ++k) { const int m = m0 + hf * 8 + k; const bf16* zc = Z + (size_t)m * ZW + ZR;
                    ya[k] = __builtin_nontemporal_load(YS + (size_t)m * 256 + c); yb[k] = __builtin_nontemporal_load(YS + (size_t)(M + m) * 256 + c); r0[k] = bf2f(zc[c]); k0[k] = bf2f(zc[256 + c]); v0[k] = bf2f(zc[512 + c]); }
#pragma unroll
                for (int k = 0; k < 8; ++k) { const int tt = hf * 8 + k;
                    const float y = ya[k] + yb[k];
                    const float mean = wave_sum(y) * (1.0f / 64.0f); const float dv = y - mean;
                    const float var = wave_sum(dv * dv) * (1.0f / 64.0f);
                    float yn = dv * __builtin_amdgcn_rsqf(var + LNX_EPS) * lw + lb;
                    yn += wave_sum(r0[k] * k0[k] * rk) * v0[k];
                    res[k] = yn * GT[tt * 260 + c]; }
#pragma unroll
                for (int k = 0; k < 8; ++k) YCAT[(size_t)(m0 + hf * 8 + k) * D + 256 + c] = (bf16)f2bf(res[k]);
                __syncthreads();
            }
            SEAM(P + 4);
        }
        if (PHEN(6) && IN(P + 5)) {
            PHASE_PROLOGUE
            pg8::Gemm g{YCAT, (const bf16*)(ws + WS_WOUT) + (size_t)l * D * D, M, D, D, nullptr, 0}; pg8::StaticOrder S; S.init(M, D, G, bx);
            pg8::EpiBf16 E{Y, D, 1.0f};
            pg8::gemm_phase<pg8::EpiBf16, pg8::StaticOrder, false>(lds, g, S, E);
            SEAM(P + 5);
        }
        if (PHEN(7) && IN(P + 6)) {
            PHASE_PROLOGUE
            LAS float* rw = (LAS float*)lds;
            LAS int* lcnt = (LAS int*)(lds + 32768);
            if (l == 1) { const float* rwp = INP(IN_ROUTER); for (int i = tid; i < D * NE; i += NWAVES * 64) rw[i] = rwp[i]; if (tid < 8) lcnt[tid] = 0; __syncthreads(); }
            const float* xsrc = (l == 0) ? INP(IN_X) : X; const float* ng = INP(IN_NORMG) + (size_t)l * 4 * D;
            const int m0 = bx * 128 + wave;
            f32x4 a1[4], bvv[4], cvv[4];
            { const float* mod = mod_l + (size_t)(m0 / T) * 6 * D; load_rowvecs(ng + 1 * D, mod + 2 * D, ng + 2 * D, mod + 4 * D, mod + 3 * D, lane, a1, bvv, cvv); }
            f32x4 yn[4], xn[4];
            ld_row_bf16(Y + (size_t)m0 * D, lane, yn); ld_row_f32_nt(xsrc + (size_t)m0 * D, lane, xn);
#pragma unroll 1
            for (int r = 0; r < 16; ++r) { const int m = m0 + 8 * r, mn = m0 + 8 * min(r + 1, 15);
                f32x4 yv[4], xv[4], hv[4];
#pragma unroll
                for (int j = 0; j < 4; ++j) { yv[j] = yn[j]; xv[j] = xn[j]; }
                ld_row_bf16(Y + (size_t)mn * D, lane, yn); ld_row_f32_nt(xsrc + (size_t)mn * D, lane, xn);
                const float rs = row_rstd(yv);
#pragma unroll
                for (int j = 0; j < 4; ++j) xv[j] = xv[j] + a1[j] * (yv[j] * rs);
                st_row_f32_nt(X + (size_t)m * D, lane, xv);
                { const float rs2 = row_rstd(xv);
#pragma unroll
                  for (int j = 0; j < 4; ++j) hv[j] = xv[j] * rs2 * bvv[j] + cvv[j]; }
                if (l == 0) st_row_bf16(H + (size_t)m * D, lane, hv);
                else {
#pragma unroll
                    for (int j = 0; j < 4; ++j) *(unsigned*)((unsigned char*)H + (size_t)m * D + 4 * lane + 256 * j) = pg8::cvt4_fp8(hv[j][0] * SC_H8, hv[j][1] * SC_H8, hv[j][2] * SC_H8, hv[j][3] * SC_H8); }
                if (l == 1) {
                    float lg[8];
#pragma unroll
                    for (int e = 0; e < 8; ++e) lg[e] = 0.f;
#pragma unroll
                    for (int j = 0; j < 4; ++j)
#pragma unroll
                        for (int x = 0; x < 4; ++x) { const LAS float* rr = rw + (4 * lane + 256 * j + x) * 8; const f32x4 w0 = *(const LAS f32x4*)rr, w1 = *(const LAS f32x4*)(rr + 4); const float hx = hv[j][x];
                            lg[0] += hx * w0[0]; lg[1] += hx * w0[1]; lg[2] += hx * w0[2]; lg[3] += hx * w0[3]; lg[4] += hx * w1[0]; lg[5] += hx * w1[1]; lg[6] += hx * w1[2]; lg[7] += hx * w1[3]; }
#pragma unroll
                    for (int e = 0; e < 8; ++e) lg[e] = wave_sum(lg[e]);
                    int i1 = 0; float v1 = lg[0];
#pragma unroll
                    for (int e = 1; e < 8; ++e) if (lg[e] > v1) { v1 = lg[e]; i1 = e; }
                    int i2 = -1; float v2 = -3.0e38f;
#pragma unroll
                    for (int e = 0; e < 8; ++e) if (e != i1 && lg[e] > v2) { v2 = lg[e]; i2 = e; }
                    if (lane == 0) { const float g2 = 1.0f / (1.0f + __expf(v1 - v2)); TOPI[2 * m] = i1; TOPI[2 * m + 1] = i2; GATE[2 * m] = 1.0f - g2; GATE[2 * m + 1] = g2;
                        __hip_atomic_fetch_add(lcnt + i1, 1, __ATOMIC_RELAXED, __HIP_MEMORY_SCOPE_WORKGROUP); __hip_atomic_fetch_add(lcnt + i2, 1, __ATOMIC_RELAXED, __HIP_MEMORY_SCOPE_WORKGROUP); }
                }
            }
            if (l == 1) { __syncthreads(); if (tid < 8) WGCNT[bx * 8 + tid] = lcnt[tid]; }
            SEAM(P + 6);
        }
        if (l == 0) {
            if (PHEN(8) && IN(P + 7)) {
            PHASE_PROLOGUE
                pg8::Gemm g{H, (const bf16*)(ws + WS_W13), M, 2 * FF, D, nullptr, 0}; pg8::StaticOrder S; S.init(M, 2 * FF, G, bx);
                pg8::EpiSwiGLU E{HID, FF};
                pg8::gemm_phase<pg8::EpiSwiGLU, pg8::StaticOrder, false>(lds, g, S, E);
                SEAM(P + 7);
            }
            if (PHEN(9) && IN(P + 8)) {
            PHASE_PROLOGUE
                pg8::Gemm g{HID, (const bf16*)(ws + WS_W2), M, D, FF, nullptr, 0}; pg8::StaticOrder S; S.init(M, D, G, bx);
                pg8::EpiBf16 E{Y, D, 1.0f};
                pg8::gemm_phase<pg8::EpiBf16, pg8::StaticOrder, false>(lds, g, S, E);
                SEAM(P + 8);
            }
            if (PHEN(10) && IN(P + 9)) {
            PHASE_PROLOGUE
                const float* ng = INP(IN_NORMG) + (size_t)l * 4 * D; const float* ng1 = INP(IN_NORMG) + 4 * D;
                const int m0 = bx * 128 + wave;
                f32x4 a1[4], bvv[4], cvv[4];
                { const float* mod = mod_l + (size_t)(m0 / T) * 6 * D; const float* mod1 = MOD + (size_t)(8 + m0 / T) * 6 * D; load_rowvecs(ng + 3 * D, mod + 5 * D, ng1, mod1 + D, mod1, lane, a1, bvv, cvv); }
                f32x4 yn[4], xn[4];
                ld_row_bf16(Y + (size_t)m0 * D, lane, yn); ld_row_f32_nt(X + (size_t)m0 * D, lane, xn);
#pragma unroll 1
                for (int r = 0; r < 16; ++r) { const int m = m0 + 8 * r, mn = m0 + 8 * min(r + 1, 15);
                    f32x4 yv[4], xv[4], hv[4];
#pragma unroll
                    for (int j = 0; j < 4; ++j) { yv[j] = yn[j]; xv[j] = xn[j]; }
                    ld_row_bf16(Y + (size_t)mn * D, lane, yn); ld_row_f32_nt(X + (size_t)mn * D, lane, xn);
                    const float rs = row_rstd(yv);
#pragma unroll
                    for (int j = 0; j < 4; ++j) xv[j] = xv[j] + a1[j] * (yv[j] * rs);
                    st_row_f32_nt(X + (size_t)m * D, lane, xv);
                    const float rs2 = row_rstd(xv);
#pragma unroll
                    for (int j = 0; j < 4; ++j) hv[j] = xv[j] * rs2 * bvv[j] + cvv[j];
                    st_row_bf16(H + (size_t)m * D, lane, hv); }
                SEAM(P + 9);
            }
        } else {
            if (PHEN(11) && IN(P + 7)) {
            PHASE_PROLOGUE
                LAS int* sh = (LAS int*)lds;
                if (tid < 8) { int tot = 0, before = 0; for (int w = 0; w < G; ++w) { const int c = WGCNT[w * 8 + tid]; if (w < bx) before += c; tot += c; } sh[24 + tid] = tot; sh[tid] = before; sh[8 + tid] = 0; }
                __syncthreads();
                if (tid == 0) { int ps = 0; for (int e = 0; e < 8; ++e) { sh[16 + e] = ps; ps += (sh[24 + e] + 255) / 256 * 256; }
                    if (bx == 0) { MOEINFO[0] = ps / 256; { int pe = 0; for (int e = 0; e < 7; ++e) { pe += (sh[24 + e] + 255) / 256; MOEINFO[1 + e] = pe; } } int blk = 0; for (int e = 0; e < 8; ++e) { const int nb = (sh[24 + e] + 255) / 256; for (int q = 0; q < nb; ++q) MOEINFO[8 + blk++] = e; } for (; blk < MOE_BLKS; ++blk) MOEINFO[8 + blk] = 7; } }
                __syncthreads();
                if (tid < 256) { const int tok = bx * 128 + (tid >> 1), e = TOPI[bx * 256 + tid];
                    const int rank = __hip_atomic_fetch_add(sh + 8 + e, 1, __ATOMIC_RELAXED, __HIP_MEMORY_SCOPE_WORKGROUP); const int dest = sh[16 + e] + sh[e] + rank;
                    DEST[bx * 256 + tid] = dest; ROWTOK[dest] = tok; }
                if (bx < 8 && tid < 256) { const int e = bx, cnt = sh[24 + e], pe = sh[16 + e] + (cnt + 255) / 256 * 256; const int d = sh[16 + e] + cnt + tid; if (d < pe) ROWTOK[d] = 0; }
                __syncthreads();
                SEAM(P + 7);
            }
            for (int part = 0; part < NPART; ++part) {
                const int pm0 = part * PART_BLKS;
                if (PHEN(12) && IN(P + 8 + 2 * part)) {
            PHASE_PROLOGUE
                    const int nblk = MOEINFO[0]; const int nb = min(max(nblk - pm0, 0), PART_BLKS);
                    pg8::Gemm g{H, (const bf16*)(ws + WS_WM13), nb * 256, 2 * FF, D / 2, ROWTOK, 0}; pg8::MoeOrder S; S.init(nb * 256, 2 * FF, G, bx); S.ee.load(MOEINFO); S.pm0 = pm0; S.apm0 = pm0; S.estride = (size_t)2 * FF * D;
                    pg8::EpiSwiGLU8 E{ws + WS_HIDM, FF, 1.0f / (SC_H8 * SC_W13), SC_HID};
                    pg8::gemm_phase<pg8::EpiSwiGLU8, pg8::MoeOrder, true, true>(lds, g, S, E);
                    SEAM(P + 8 + 2 * part);
                }
                if (PHEN(13) && IN(P + 9 + 2 * part)) {
            PHASE_PROLOGUE
                    const int nblk = MOEINFO[0]; const int nb = min(max(nblk - pm0, 0), PART_BLKS);
                    const int fb = min(nb, 256);
                    { pg8::Gemm g{(const bf16*)(ws + WS_HIDM), (const bf16*)(ws + WS_WM2), fb * 256, D, FF / 2, nullptr, 0}; pg8::MoeOrder S; S.init(fb * 256, D, G, bx); S.ee.load(MOEINFO); S.pm0 = pm0; S.apm0 = 0; S.estride = (size_t)D * FF;
                      pg8::EpiBf16 E{(bf16*)(ws + WS_YB) + (size_t)pm0 * 256 * D, D, 1.0f / (SC_HID * SC_W2)};
                      pg8::gemm_phase<pg8::EpiBf16, pg8::MoeOrder, false, true>(lds, g, S, E); }
                    if (nb > 256) {
                        const int ntask = (nb - 256) * 4 * 7, tk = bx, unit = tk / 7, sl = tk % 7;
                        pg8::Gemm g{(const bf16*)(ws + WS_HIDM + (size_t)256 * 256 * FF + (size_t)sl * 512), (const bf16*)(ws + WS_WM2 + (size_t)sl * 512), (nb - 256) * 256, D, 256, nullptr, FF / 2};
                        pg8::TailOrder S; S.ee.load(MOEINFO); S.pm0 = 256; S.unit = unit; S.has = tk < ntask; S.estride = (size_t)D * FF;
                        pg8::EpiBf16 E{(bf16*)(ws + WS_SLAB) + (size_t)sl * 8 * 256 * D, D, 1.0f / (SC_HID * SC_W2)};
                        pg8::gemm_phase<pg8::EpiBf16, pg8::TailOrder, false, true>(lds, g, S, E); }
                    SEAM(P + 9 + 2 * part);
                }
            }
            if (PHEN(14) && IN(P + 8 + 2 * NPART)) {
            PHASE_PROLOGUE
                const bf16* YB = (const bf16*)(ws + WS_YB); const float* ng = INP(IN_NORMG) + (size_t)l * 4 * D;
                const int m0 = bx * 128 + wave;
                f32x4 a1[4];
                { const float* mod = mod_l + (size_t)(m0 / T) * 6 * D;
#pragma unroll
                  for (int j = 0; j < 4; ++j) a1[j] = *(const f32x4*)(ng + 3 * D + 4 * lane + 256 * j) * *(const f32x4*)(mod + 5 * D + 4 * lane + 256 * j); }
                const int dlane = DEST[2 * (m0 + 8 * ((lane & 31) >> 1)) + (lane & 1)]; const float glane = GATE[2 * (m0 + 8 * ((lane & 31) >> 1)) + (lane & 1)];
                f32x4 y0n[4], y1n[4], xn[4];
                const bf16* SLAB = (const bf16*)(ws + WS_SLAB);
                { const int d0 = __builtin_amdgcn_readlane(dlane, 0), d1 = __builtin_amdgcn_readlane(dlane, 1);
                  ld_moe_row(YB, SLAB, d0, lane, y0n); ld_moe_row(YB, SLAB, d1, lane, y1n); ld_row_f32_nt(X + (size_t)m0 * D, lane, xn); }
#pragma unroll 1
                for (int r = 0; r < 16; ++r) { const int m = m0 + 8 * r, rn = min(r + 1, 15);
                    const float g0 = __builtin_bit_cast(float, __builtin_amdgcn_readlane(__builtin_bit_cast(int, glane), 2 * r)), g1 = __builtin_bit_cast(float, __builtin_amdgcn_readlane(__builtin_bit_cast(int, glane), 2 * r + 1));
                    f32x4 y0[4], y1[4], xv[4];
#pragma unroll
                    for (int j = 0; j < 4; ++j) { y0[j] = y0n[j]; y1[j] = y1n[j]; xv[j] = xn[j]; }
                    { const int d0 = __builtin_amdgcn_readlane(dlane, 2 * rn), d1 = __builtin_amdgcn_readlane(dlane, 2 * rn + 1);
                      ld_moe_row(YB, SLAB, d0, lane, y0n); ld_moe_row(YB, SLAB, d1, lane, y1n); ld_row_f32_nt(X + (size_t)(m0 + 8 * rn) * D, lane, xn); }
#pragma unroll
                    for (int j = 0; j < 4; ++j) y0[j] = g0 * y0[j] + g1 * y1[j];
                    const float rs = row_rstd(y0);
#pragma unroll
                    for (int j = 0; j < 4; ++j) xv[j] = xv[j] + a1[j] * (y0[j] * rs);
                    st_row_f32_nt(X + (size_t)m * D, lane, xv); }
            }
        }
}
__global__ void __launch_bounds__(NWAVES * 64, 2) skel_fwd(Args args) {
    extern __shared__ __attribute__((aligned(16))) unsigned char lds_raw[];
    LAS unsigned char* lds = (LAS unsigned char*)lds_raw;
    volatile LAS unsigned* MISC = (volatile LAS unsigned*)(lds + MISC_OFF);
    const int tid0 = threadIdx.x;
    const int G = gridDim.x, bx = blockIdx.x;
    const int vcu = (G % 8 == 0) ? (bx % 8) * (G / 8) + bx / 8 : bx;
    const int NGW = G * NWAVES;
    unsigned char* const ws0 = args.ws;
    unsigned* ctl = (unsigned*)(ws0 + WS_CTL);
    for (int u = tid0; u < 128; u += NWAVES * 64) ((LAS unsigned*)(lds + MISC_OFF))[u] = 0u;
    __syncthreads();
    XcdBarrier bar; bar.bar = ctl; bar.x = 0; bar.st = nullptr;
    if (MK_N_LAUNCHES == 1) bar = xcd_barrier_post(ctl, MISC + 8);
    const int lo = args.ph_lo, hi = args.ph_hi;


    if (PHEN(0) && IN(0)) {
            PHASE_PROLOGUE
        LAS float* scr = (LAS float*)(lds + wave * 16384);
        for (int l = 0; l < 2; ++l) {
            transpose_mat<0>(INP(IN_WIN) + (size_t)l * D * INW, D, INW, (bf16*)(ws + WS_WIN) + (size_t)l * ZW * D, gw, NGW, scr, lane);
            transpose_mat<0>(INP(IN_WOUT) + (size_t)l * D * D, D, D, (bf16*)(ws + WS_WOUT) + (size_t)l * D * D, gw, NGW, scr, lane);
            bf16* pad = (bf16*)(ws + WS_WIN) + (size_t)l * ZW * D + (size_t)INW * D;
            for (int i = gw * 64 + lane; i < (ZW - INW) * D / 8; i += NGW * 64) *(u32x4*)(pad + (size_t)i * 8) = (u32x4){0u, 0u, 0u, 0u};
        }
        transpose_mat<1>(INP(IN_FW1), D, FF, (bf16*)(ws + WS_W13), gw, NGW, scr, lane);
        transpose_mat<2>(INP(IN_FW3), D, FF, (bf16*)(ws + WS_W13), gw, NGW, scr, lane);
        transpose_mat<0>(INP(IN_FW2), FF, D, (bf16*)(ws + WS_W2), gw, NGW, scr, lane);
        __syncthreads();
        {
            LAS float* sc = (LAS float*)lds;
            LAS float* red = (LAS float*)(lds + 32768);
            bool have = false;
            for (int it = vcu; it < 2 * 96; it += G) {
                if (!have) { const float* cin = INP(IN_C); for (int i = tid; i < BATCH * D; i += NWAVES * 64) { const float c = cin[i]; sc[i] = c / (1.0f + __expf(-c)); } __syncthreads(); have = true; }
                const int l = it / 96, n = (it % 96) * 64 + (tid & 63), kg = tid >> 6;
                const float* w = INP(IN_ADAW) + (size_t)l * D * 6 * D + (size_t)(kg * 128) * 6 * D + n;
                float a[8];
#pragma unroll
                for (int b = 0; b < 8; ++b) a[b] = 0.f;
#pragma unroll 1
                for (int k0 = 0; k0 < 128; k0 += 16) { float wv[16];
#pragma unroll
                    for (int q = 0; q < 16; ++q) wv[q] = w[(size_t)(k0 + q) * 6 * D];
#pragma unroll
                    for (int q = 0; q < 16; ++q)
#pragma unroll
                        for (int b = 0; b < 8; ++b) a[b] += sc[b * D + kg * 128 + k0 + q] * wv[q]; }
#pragma unroll
                for (int b = 0; b < 8; ++b) red[(kg * 8 + b) * 64 + (tid & 63)] = a[b];
                __syncthreads();
                if (tid < 512) { const int b = tid >> 6, c = tid & 63; float s_ = 0.f;
#pragma unroll
                    for (int q = 0; q < 8; ++q) s_ += red[(q * 8 + b) * 64 + c];
                    const int nn = (it % 96) * 64 + c;
                    MOD[((size_t)l * 8 + b) * 6 * D + nn] = s_ + INP(IN_ADAB)[(size_t)l * 6 * D + nn]; }
                __syncthreads();
            }
        }
        SEAM(0);
    }
    if (PHEN(1) && IN(1)) {
            PHASE_PROLOGUE
        const float* x_in = INP(IN_X); const float* ng0 = INP(IN_NORMG);
        const int m0 = bx * 128 + wave;
        f32x4 bvv[4], cvv[4], xn[4];
        { const float* mod = MOD + (size_t)(m0 / T) * 6 * D;
#pragma unroll
          for (int j = 0; j < 4; ++j) { const int o = 4 * lane + 256 * j; bvv[j] = *(const f32x4*)(ng0 + o) * (1.0f + *(const f32x4*)(mod + D + o)); cvv[j] = *(const f32x4*)(mod + o); } }
        ld_row_f32_nt(x_in + (size_t)m0 * D, lane, xn);
#pragma unroll 1
        for (int r = 0; r < 16; ++r) { const int m = m0 + 8 * r;
            f32x4 xv[4], hv[4];
#pragma unroll
            for (int j = 0; j < 4; ++j) xv[j] = xn[j];
            ld_row_f32_nt(x_in + (size_t)(m0 + 8 * min(r + 1, 15)) * D, lane, xn);
            const float rs = row_rstd(xv);
#pragma unroll
            for (int j = 0; j < 4; ++j) hv[j] = xv[j] * rs * bvv[j] + cvv[j];
            st_row_bf16(H + (size_t)m * D, lane, hv); }
        SEAM(1);
    }
    layer_phases<0>(args, ws0, lds, vcu, G, bx, NGW, lo, hi, bar);
    layer_phases<1>(args, ws0, lds, vcu, G, bx, NGW, lo, hi, bar);
#undef IN
#undef SEAM
}
constexpr int N_PHASES = 18 + 8 + 2 * NPART + 1;

extern "C" void kernel_launch(void* const* d_in, const int* in_sizes, int n_in, void* d_out, int out_size, void* d_ws, size_t ws_size, hipStream_t stream) {
    static int grid = 0;
    if (grid == 0) {
        if (n_in != 29 || out_size != M * D || ws_size < WS_END) { fprintf(stderr, "kernel_launch: unexpected shapes (n_in %d out %d ws %zu)\n", n_in, out_size, ws_size); grid = -1; return; }
        int dev = 0, cus = 0;
        if (hipGetDevice(&dev) != hipSuccess || hipDeviceGetAttribute(&cus, hipDeviceAttributeMultiprocessorCount, dev) != hipSuccess) { grid = -1; return; }
        if (hipFuncSetAttribute((const void*)skel_fwd, hipFuncAttributeMaxDynamicSharedMemorySize, LDS_BYTES) != hipSuccess) { fprintf(stderr, "kernel_launch: hipFuncSetAttribute failed\n"); grid = -1; return; }
        int per_cu = 0;
        if (hipOccupancyMaxActiveBlocksPerMultiprocessor(&per_cu, (const void*)skel_fwd, NWAVES * 64, LDS_BYTES) != hipSuccess || per_cu < 1) fprintf(stderr, "kernel_launch: occupancy query reports %d\n", per_cu);
        (void)hipGetLastError();
        grid = cus;
        if (grid != 256) { fprintf(stderr, "kernel_launch: built for 256 CUs, found %d\n", grid); grid = 256; }
    }
    if (grid < 0) return;
    (void)hipMemsetAsync((char*)d_ws + WS_CTL, 0, CTL_ZERO_BYTES, stream);
    Args a{};
    for (int i = 0; i < 29; ++i) a.in[i] = (const float*)d_in[i];
    a.out = (float*)d_out; a.ws = (unsigned char*)d_ws; a.sub = 7;
    if (MK_N_LAUNCHES == 1) {
        a.ph_lo = 0; a.ph_hi = N_PHASES;
        hipLaunchKernelGGL(skel_fwd, dim3(grid), dim3(NWAVES * 64), LDS_BYTES, stream, a);
    } else {
        static const int phases[] = {0, 1, 2, 3, 4, 5, 6, 7, 8, 9, 10, 11, 18, 19, 20, 21, 22, 23, 24, 25, 26, 27, 28};
        for (int p : phases) { a.ph_lo = p % 100; a.ph_hi = p % 100 + 1; a.sub = p >= 100 ? p / 100 : 7; hipLaunchKernelGGL(skel_fwd, dim3(grid), dim3(NWAVES * 64), LDS_BYTES, stream, a); }
    }
}
```
